# Optimizing an MI355X kernel written in HIP

```python
import jax, jax.numpy as jnp
from jax import lax
import numpy as np

D_MODEL = 1024
BATCH = 32
SEQ = 2048
DEPTH = 4

N_MIXERS = 2
N_FOX = (DEPTH + 1) // 2
N_HGRN = DEPTH // 2
FOX_HEADS = 16
FOX_HEAD_DIM = D_MODEL // FOX_HEADS
FOX_Q_BLOCK = 128
MASK_VALUE = -1e30
HGRN_EXPAND = 128
HGRN_HEADS = D_MODEL // HGRN_EXPAND
HGRN_KEY_DIM = HGRN_EXPAND
HGRN_VAL_DIM = D_MODEL // HGRN_HEADS
HGRN_KEY_WIDTH = HGRN_HEADS * HGRN_KEY_DIM
HGRN_CHUNK = 32
N_EXPERTS = 32
TOP_K = 4
D_FF = D_MODEL
SWIGLU_LIMIT = 7.0
SWIGLU_ALPHA = 1.702
MOE_ROW_BLOCK = 512
N_MOD = 6
EPS = 1e-6

kernel_name = 'fox_hgrn2_moe_adaln_hybrid'


def rms_norm(x, w):
    xf = x.astype(jnp.float32)
    y = xf * lax.rsqrt(jnp.mean(xf * xf, axis=-1, keepdims=True) + EPS)
    return (y * w.astype(jnp.float32)).astype(x.dtype)


def fox_attention(h, w_in, b_f, q_norm, k_norm, w_out):
    B, S, D = h.shape
    H, Dh, QB = FOX_HEADS, FOX_HEAD_DIM, FOX_Q_BLOCK
    f32 = jnp.float32
    proj = h @ w_in
    q = proj[..., 0 * D:1 * D].reshape(B, S, H, Dh)
    k = proj[..., 1 * D:2 * D].reshape(B, S, H, Dh)
    v = proj[..., 2 * D:3 * D].reshape(B, S, H, Dh)
    g = proj[..., 3 * D:4 * D]
    f_logit = proj[..., 4 * D:] + b_f
    q = rms_norm(q, q_norm)
    k = rms_norm(k, k_norm)
    log_f = jax.nn.log_sigmoid(f_logit.astype(f32))
    cum = jnp.cumsum(log_f, axis=1).transpose(0, 2, 1)
    q, k, v = (t.transpose(0, 2, 1, 3) for t in (q, k, v))
    scale = Dh ** -0.5
    outs = []
    for blk in range(S // QB):
        q0, q1 = blk * QB, (blk + 1) * QB
        s = jnp.einsum('bhqd,bhkd->bhqk', q[:, :, q0:q1], k[:, :, :q1]).astype(f32) * scale
        s = s + cum[:, :, q0:q1, None] - cum[:, :, None, :q1]
        causal = jnp.arange(q0, q1)[:, None] >= jnp.arange(q1)[None, :]
        s = jnp.where(causal, s, MASK_VALUE)
        p = jax.nn.softmax(s, axis=-1).astype(v.dtype)
        outs.append(jnp.einsum('bhqk,bhkd->bhqd', p, v[:, :, :q1]))
    o = jnp.concatenate(outs, axis=2).transpose(0, 2, 1, 3).reshape(B, S, D)
    o = o * jax.nn.sigmoid(g)
    return o @ w_out


def hgrn2_mixer(h, w_in, lower_bound, g_norm, w_out):
    B, S, D = h.shape
    H, DK, DV, C = HGRN_HEADS, HGRN_KEY_DIM, HGRN_VAL_DIM, HGRN_CHUNK
    KW = HGRN_KEY_WIDTH
    n = S // C
    f32 = jnp.float32
    proj = h @ w_in
    q = jax.nn.silu(proj[..., :KW].astype(f32))
    f_raw = proj[..., KW:2 * KW].astype(f32)
    v = proj[..., 2 * KW:2 * KW + H * DV].astype(f32)
    g = proj[..., 2 * KW + H * DV:].astype(f32)
    lb = lower_bound.astype(f32)
    f = lb + (1.0 - lb) * jax.nn.sigmoid(f_raw)
    log_f = jnp.log(f)
    k = (1.0 - lb) * jax.nn.sigmoid(-f_raw)

    def chunks(t, d):
        return t.reshape(B, n, C, H, d).transpose(1, 0, 3, 2, 4)

    xs = (chunks(q, DK), chunks(k, DK), chunks(v, DV), chunks(log_f, DK))
    causal = jnp.tril(jnp.ones((C, C), dtype=bool))[:, :, None]

    def step(state, inp):
        qc, kc, vc, lfc = inp
        b = jnp.cumsum(lfc, axis=2)
        diff = b[:, :, :, None, :] - b[:, :, None, :, :]
        decay = jnp.where(causal, jnp.exp(jnp.where(causal, diff, 0.0)), 0.0)
        scores = jnp.einsum('bhtd,bhsd,bhtsd->bhts', qc, kc, decay)
        o = (jnp.einsum('bhts,bhsv->bhtv', scores, vc)
             + jnp.einsum('bhtd,bhdv->bhtv', qc * jnp.exp(b), state))
        b_end = b[:, :, -1:, :]
        state = (jnp.exp(b_end[:, :, 0, :, None]) * state
                 + jnp.einsum('bhsd,bhsv->bhdv', kc * jnp.exp(b_end - b), vc))
        return state, o

    state0 = jnp.zeros((B, H, DK, DV), f32)
    _, o = lax.scan(step, state0, xs)
    o = o.transpose(1, 0, 3, 2, 4).reshape(B, S, H, DV)
    o = rms_norm(o, g_norm) * jax.nn.silu(g).reshape(B, S, H, DV)
    return o.reshape(B, S, H * DV).astype(h.dtype) @ w_out


def clamped_swiglu(gu):
    gate = jnp.minimum(gu[..., 0::2], SWIGLU_LIMIT)
    up = jnp.clip(gu[..., 1::2], -SWIGLU_LIMIT, SWIGLU_LIMIT)
    return (up + 1.0) * gate * jax.nn.sigmoid(SWIGLU_ALPHA * gate)


def moe_ffn(h, w_router, b_router, w_gu, b_gu, w_down, b_down):
    B, S, D = h.shape
    E, K, R = N_EXPERTS, TOP_K, MOE_ROW_BLOCK
    xf = h.reshape(B * S, D)
    T = xf.shape[0]
    logits = (xf @ w_router + b_router).astype(jnp.float32)
    top_logit, top_idx = lax.top_k(logits, K)
    top_w = jax.nn.softmax(top_logit, axis=-1)
    flat_e = top_idx.reshape(-1)
    flat_w = top_w.reshape(-1)
    flat_tok = jnp.arange(T * K, dtype=jnp.int32) // K
    order = jnp.argsort(flat_e)
    e_sorted = flat_e[order]
    counts = jnp.bincount(flat_e, length=E)
    padded = (counts + R - 1) // R * R
    pad_end = jnp.cumsum(padded)
    pad_start = pad_end - padded
    start = jnp.cumsum(counts) - counts
    dest = pad_start[e_sorted] + (jnp.arange(T * K) - start[e_sorted])
    n_blocks = -(-(T * K) // R) + E
    tok_buf = jnp.zeros((n_blocks * R,), jnp.int32).at[dest].set(flat_tok[order])
    w_buf = jnp.zeros((n_blocks * R,), xf.dtype).at[dest].set(flat_w[order].astype(xf.dtype))
    blk_e = jnp.minimum(jnp.searchsorted(pad_end, jnp.arange(n_blocks) * R, side='right'), E - 1)

    def expert_block(args):
        tok, wgt, e = args
        xb = xf[tok]
        y = clamped_swiglu(xb @ w_gu[e] + b_gu[e]) @ w_down[e] + b_down[e]
        return y * wgt[:, None]

    rows = lax.map(expert_block, (tok_buf.reshape(n_blocks, R), w_buf.reshape(n_blocks, R), blk_e))
    out = jnp.zeros_like(xf).at[tok_buf].add(rows.reshape(n_blocks * R, D))
    return out.reshape(B, S, D)


def setup_inputs(seed: int = 0) -> dict:
    key = jax.random.key(seed)
    ks = jax.random.split(key, 22)
    D, H, Dh = D_MODEL, FOX_HEADS, FOX_HEAD_DIM
    KW, DV = HGRN_KEY_WIDTH, HGRN_VAL_DIM
    E, F = N_EXPERTS, D_FF

    def nrm(k, shape, std):
        return jax.random.normal(k, shape, jnp.float32) * std

    return {
        'x': nrm(ks[0], (BATCH, SEQ, D), 1.0),
        'c': nrm(ks[1], (BATCH, D), 1.0),
        'fox_w_in': nrm(ks[2], (N_FOX, D, 4 * D + H), D ** -0.5),
        'fox_b_f': 2.0 + nrm(ks[3], (N_FOX, H), 0.5),
        'fox_q_norm': 1.0 + nrm(ks[4], (N_FOX, Dh), 0.02),
        'fox_k_norm': 1.0 + nrm(ks[5], (N_FOX, Dh), 0.02),
        'fox_w_out': nrm(ks[6], (N_FOX, D, D), D ** -0.5),
        'hgrn_w_in': nrm(ks[7], (N_HGRN, D, 2 * KW + HGRN_HEADS * DV + D), D ** -0.5),
        'hgrn_lb': nrm(ks[8], (N_HGRN, KW), 0.5),
        'hgrn_g_norm': 1.0 + nrm(ks[9], (N_HGRN, DV), 0.02),
        'hgrn_w_out': nrm(ks[10], (N_HGRN, HGRN_HEADS * DV, D), D ** -0.5),
        'ada_w': nrm(ks[11], (DEPTH, D, N_MOD * D), 0.5 * D ** -0.5),
        'ada_b': nrm(ks[12], (DEPTH, N_MOD * D), 0.02),
        'norm1_w': 1.0 + nrm(ks[13], (DEPTH, D), 0.02),
        'norm2_w': 1.0 + nrm(ks[14], (DEPTH, D), 0.02),
        'router_w': nrm(ks[15], (DEPTH, D, E), D ** -0.5),
        'router_b': nrm(ks[16], (DEPTH, E), 0.01),
        'exp_w_gu': nrm(ks[17], (DEPTH, E, D, 2 * F), D ** -0.5),
        'exp_b_gu': nrm(ks[18], (DEPTH, E, 2 * F), 0.02),
        'exp_w_down': nrm(ks[19], (DEPTH, E, F, D), F ** -0.5),
        'exp_b_down': nrm(ks[20], (DEPTH, E, D), 0.02),
    }


def reference(x, c, fox_w_in, fox_b_f, fox_q_norm, fox_k_norm, fox_w_out,
              hgrn_w_in, hgrn_lb, hgrn_g_norm, hgrn_w_out,
              ada_w, ada_b, norm1_w, norm2_w,
              router_w, router_b, exp_w_gu, exp_b_gu, exp_w_down, exp_b_down):
    lb_soft = jax.nn.softmax(hgrn_lb.astype(jnp.float32), axis=0)
    lower = jnp.cumsum(lb_soft, axis=0) - lb_soft[0]
    c_act = jax.nn.silu(c)
    for i in range(DEPTH):
        mod = c_act @ ada_w[i] + ada_b[i]
        sh1, sc1, g1, sh2, sc2, g2 = (m[:, None, :] for m in jnp.split(mod, N_MOD, axis=-1))
        h = rms_norm(x, norm1_w[i]) * (1.0 + sc1) + sh1
        j = i // N_MIXERS
        if i % N_MIXERS == 0:
            y = fox_attention(h, fox_w_in[j], fox_b_f[j], fox_q_norm[j], fox_k_norm[j], fox_w_out[j])
        else:
            y = hgrn2_mixer(h, hgrn_w_in[j], lower[j], hgrn_g_norm[j], hgrn_w_out[j])
        x = x + g1 * y
        h = rms_norm(x, norm2_w[i]) * (1.0 + sc2) + sh2
        x = x + g2 * moe_ffn(h, router_w[i], router_b[i], exp_w_gu[i], exp_b_gu[i],
                             exp_w_down[i], exp_b_down[i])
    return x
```

```cpp
#include <hip/hip_runtime.h>
#include <cstdio>
#include <cstdint>
__device__ __forceinline__ int mk_lane() { return (int)__builtin_amdgcn_mbcnt_hi(~0u, __builtin_amdgcn_mbcnt_lo(~0u, 0u)); }
namespace pg8 {
#define PG8_LAS __attribute__((address_space(3)))
typedef unsigned short bf16_t;
typedef short bf16x8 __attribute__((ext_vector_type(8)));
typedef float f32x4 __attribute__((ext_vector_type(4)));
typedef unsigned u32x4 __attribute__((ext_vector_type(4)));
constexpr int BM = 256, BK = 64, HALF = 128, HTB = HALF * BK * 2  , STAGE_BYTES = 8 * HTB, NXCD = 8, WGM = 8;

__host__ __device__ __forceinline__ int lds_byte(int r, int c) { const int st = (r >> 4) * 2 + (c >> 5), rr = r & 15, cc = c & 31, ob = rr * 64 + cc * 2; return st * 1024 + (ob ^ (((ob >> 9) & 1) << 5)); }
__host__ __device__ __forceinline__ void stage_rc(int b, int& R, int& C) { const int st = b / 1024, sb = b % 1024, swz = sb ^ (((sb >> 9) & 1) << 5); R = (st >> 1) * 16 + swz / 64; C = (st & 1) * 32 + (swz % 64) / 2; }
__host__ __device__ __forceinline__ int perm32(int rho) { const int n = rho >> 4, i = rho & 15; return 8 * (i >> 2) + 4 * n + (i & 3); }

struct Unit { int pm, pn, pb, e; };
struct Gemm { const bf16_t* A; const bf16_t* Bt; int M, N, K; };

struct StaticOrder {
    int nM, nN, nwg, G, c;
    __host__ __device__ void init(int M, int N, int G_, int c_) { nM = M / BM; nN = N / BM; nwg = nM * nN; G = G_; c = c_; }
    __host__ __device__ bool next(int i, Unit& u) const {
        const long L = (long)i * G + c; if (L >= nwg) return false;
        int wgid = (int)L; { const int q = nwg / NXCD, r = nwg % NXCD, xcd = wgid % NXCD, off = wgid / NXCD; wgid = (xcd < r ? xcd * (q + 1) : r * (q + 1) + (xcd - r) * q) + off; }
        const int nig = WGM * nN, gid = wgid / nig, fm = gid * WGM, gsz = (nM - fm) < WGM ? (nM - fm) : WGM;
        u.pm = fm + ((wgid % nig) % gsz); u.pn = (wgid % nig) / gsz; u.pb = u.pn; u.e = 0; return true;
    }
    __device__ __forceinline__ void a_ready(const Unit&) const {}
    __device__ __forceinline__ void done(const Unit&) const {}
};

__device__ __forceinline__ unsigned cvt_pk_bf16(float lo, float hi) { unsigned r; asm volatile("v_cvt_pk_bf16_f32 %0, %1, %2" : "=v"(r) : "v"(lo), "v"(hi)); return r; }
__device__ __forceinline__ float sigm(float x) { return __builtin_amdgcn_rcpf(1.0f + __expf(-x)); }
__device__ __forceinline__ u32x4 pack8(const f32x4 v0, const f32x4 v1) { u32x4 w; w.x = cvt_pk_bf16(v0[0], v0[1]); w.y = cvt_pk_bf16(v0[2], v0[3]); w.z = cvt_pk_bf16(v1[0], v1[1]); w.w = cvt_pk_bf16(v1[2], v1[3]); return w; }

struct EpiFox {
    static constexpr bool PERM = true, AFTER_DRAIN = false;
    bf16_t* P; size_t pstride; float* FL; const float* qw; const float* kw; const float* bfv; float qscale;
    __device__ __forceinline__ void operator()(const f32x4 (&acc)[2][2][4][2], const Unit& u, int wr, int wc, int fr, int fq) const {
        const int type = u.pn >> 2; const int row0 = u.pm * BM + wr * 64 + fr;
        if (type == 4) {
            if (wc == 0 && fq < 2) {
                const f32x4 b0 = *(const f32x4*)(bfv + 8 * fq), b1 = *(const f32x4*)(bfv + 8 * fq + 4);
#pragma unroll
                for (int ai = 0; ai < 2; ++ai)
#pragma unroll
                    for (int m = 0; m < 4; ++m) { const size_t row = (size_t)(row0 + ai * HALF + m * 16);
                        f32x4 v0 = acc[ai][0][m][0] + b0, v1 = acc[ai][0][m][1] + b1;
#pragma unroll
                        for (int i = 0; i < 4; ++i) { { const float z = v0[i]; v0[i] = (fminf(z, 0.f) - log1pf(__expf(-fabsf(z)))) * 1.4426950408889634f; }
                                                      { const float z = v1[i]; v1[i] = (fminf(z, 0.f) - log1pf(__expf(-fabsf(z)))) * 1.4426950408889634f; } }
                        *(f32x4*)(FL + row * 16 + 8 * fq) = v0; *(f32x4*)(FL + row * 16 + 8 * fq + 4) = v1; }
            }
            return;
        }
        bf16_t* base = P + (size_t)type * pstride;
        const int colh = (u.pn & 3) * 256 + 64 * wc + 8 * fq;
        if (type < 2) {
            const float* w = (type == 0) ? qw : kw; const float sc = (type == 0) ? qscale : 1.0f;
            f32x4 wv[2][2];
#pragma unroll
            for (int bj = 0; bj < 2; ++bj)
#pragma unroll
                for (int n = 0; n < 2; ++n) wv[bj][n] = *(const f32x4*)(w + 32 * bj + 8 * fq + 4 * n) * sc;
#pragma unroll
            for (int ai = 0; ai < 2; ++ai)
#pragma unroll
                for (int m = 0; m < 4; ++m) {
                    float ss = 0.f;
#pragma unroll
                    for (int bj = 0; bj < 2; ++bj)
#pragma unroll
                        for (int n = 0; n < 2; ++n) { const f32x4 x = acc[ai][bj][m][n]; ss += (x[0] * x[0] + x[1] * x[1]) + (x[2] * x[2] + x[3] * x[3]); }
                    ss += __shfl_xor(ss, 16); ss += __shfl_xor(ss, 32);
                    const float rs = __builtin_amdgcn_rsqf(ss * (1.0f / 64.0f) + 1e-6f);
                    bf16_t* rowp = base + (size_t)(row0 + ai * HALF + m * 16) * 1024 + colh;
#pragma unroll
                    for (int bj = 0; bj < 2; ++bj) { const f32x4 v0 = acc[ai][bj][m][0] * rs * wv[bj][0], v1 = acc[ai][bj][m][1] * rs * wv[bj][1]; *(u32x4*)(rowp + 32 * bj) = pack8(v0, v1); }
                }
        } else {
#pragma unroll
            for (int ai = 0; ai < 2; ++ai)
#pragma unroll
                for (int m = 0; m < 4; ++m) { bf16_t* rowp = base + (size_t)(row0 + ai * HALF + m * 16) * 1024 + colh;
#pragma unroll
                    for (int bj = 0; bj < 2; ++bj) { f32x4 v0 = acc[ai][bj][m][0], v1 = acc[ai][bj][m][1];
                        if (type == 3) {
#pragma unroll
                            for (int i = 0; i < 4; ++i) { v0[i] = sigm(v0[i]); v1[i] = sigm(v1[i]); } }
                        *(u32x4*)(rowp + 32 * bj) = pack8(v0, v1); } }
        }
    }
};

struct EpiHgrn {
    static constexpr bool PERM = true, AFTER_DRAIN = false;
    bf16_t* P; size_t pstride; float* LF; const float* lb0; const float* lb1; int jh;
    __device__ __forceinline__ void operator()(const f32x4 (&acc)[2][2][4][2], const Unit& u, int wr, int wc, int fr, int fq) const {
        const int type = u.pn >> 2; const int row0 = u.pm * BM + wr * 64 + fr;
        const int col0 = (u.pn & 3) * 256 + wc * 32 + 8 * fq;
        bf16_t* base = P + (size_t)type * pstride;
        if (type == 1) {
            f32x4 lbv[2][2];
#pragma unroll
            for (int bj = 0; bj < 2; ++bj)
#pragma unroll
                for (int n = 0; n < 2; ++n) { f32x4 l = (f32x4){0.f, 0.f, 0.f, 0.f};
                    if (jh != 0) { const f32x4 a = *(const f32x4*)(lb0 + col0 + bj * HALF + 4 * n), b = *(const f32x4*)(lb1 + col0 + bj * HALF + 4 * n);
#pragma unroll
                        for (int i = 0; i < 4; ++i) l[i] = __builtin_amdgcn_rcpf(1.0f + __expf(a[i] - b[i])); }
                    lbv[bj][n] = l; }
#pragma unroll
            for (int ai = 0; ai < 2; ++ai)
#pragma unroll
                for (int m = 0; m < 4; ++m) { const size_t off = (size_t)(row0 + ai * HALF + m * 16) * 1024 + col0;
#pragma unroll
                    for (int bj = 0; bj < 2; ++bj) { f32x4 lf[2], kk[2];
#pragma unroll
                        for (int n = 0; n < 2; ++n)
#pragma unroll
                            for (int i = 0; i < 4; ++i) { const float x = acc[ai][bj][m][n][i], lb = lbv[bj][n][i], om = 1.0f - lb;
                                const float sg = sigm(x); lf[n][i] = __logf(lb + om * sg); kk[n][i] = om * __builtin_amdgcn_rcpf(1.0f + __expf(x)); }
                        *(f32x4*)(LF + off + bj * HALF) = lf[0]; *(f32x4*)(LF + off + bj * HALF + 4) = lf[1];
                        *(u32x4*)(base + off + bj * HALF) = pack8(kk[0], kk[1]); } }
        } else {
#pragma unroll
            for (int ai = 0; ai < 2; ++ai)
#pragma unroll
                for (int m = 0; m < 4; ++m) { bf16_t* rowp = base + (size_t)(row0 + ai * HALF + m * 16) * 1024 + col0;
#pragma unroll
                    for (int bj = 0; bj < 2; ++bj) { f32x4 v0 = acc[ai][bj][m][0], v1 = acc[ai][bj][m][1];
                        if (type != 2) {
#pragma unroll
                            for (int i = 0; i < 4; ++i) { v0[i] = v0[i] * sigm(v0[i]); v1[i] = v1[i] * sigm(v1[i]); } }
                        *(u32x4*)(rowp + bj * HALF) = pack8(v0, v1); } }
        }
    }
};

struct EpiResid {
    static constexpr bool PERM = true, AFTER_DRAIN = false;
    const float* base; float* out; const float* gate;
    __device__ __forceinline__ void operator()(const f32x4 (&acc)[2][2][4][2], const Unit& u, int wr, int wc, int fr, int fq) const {
        const int row0 = u.pm * BM + wr * 64 + fr; const int col0 = u.pn * BM + wc * 32 + 8 * fq;
        const float* gp = gate + (size_t)(u.pm >> 3) * 6144 + col0;
        f32x4 gv[2][2];
#pragma unroll
        for (int bj = 0; bj < 2; ++bj)
#pragma unroll
            for (int n = 0; n < 2; ++n) gv[bj][n] = *(const f32x4*)(gp + bj * HALF + 4 * n);
#pragma unroll
        for (int ai = 0; ai < 2; ++ai)
#pragma unroll
            for (int m = 0; m < 4; ++m) { const size_t off = (size_t)(row0 + ai * HALF + m * 16) * 1024 + col0;
#pragma unroll
                for (int bj = 0; bj < 2; ++bj)
#pragma unroll
                    for (int n = 0; n < 2; ++n) { const f32x4 b = *(const f32x4*)(base + off + bj * HALF + 4 * n); *(f32x4*)(out + off + bj * HALF + 4 * n) = b + gv[bj][n] * acc[ai][bj][m][n]; } }
    }
};

struct EpiSwiglu {
    static constexpr bool PERM = true, AFTER_DRAIN = false;
    bf16_t* ACT; const float* bgu;
    __device__ __forceinline__ void operator()(const f32x4 (&acc)[2][2][4][2], const Unit& u, int wr, int wc, int fr, int fq) const {
        const int row0 = u.pm * BM + wr * 64 + fr; const int a0 = u.pn * 128 + wc * 32 + 8 * fq;
        const float* bp = bgu + (size_t)u.e * 2048 + 2 * a0;
        f32x4 bv[4];
#pragma unroll
        for (int q = 0; q < 4; ++q) bv[q] = *(const f32x4*)(bp + 4 * q);
#pragma unroll
        for (int ai = 0; ai < 2; ++ai)
#pragma unroll
            for (int m = 0; m < 4; ++m) { f32x4 o[2];
#pragma unroll
                for (int n = 0; n < 2; ++n)
#pragma unroll
                    for (int i = 0; i < 4; ++i) { const int ip = 4 * n + i; float g = acc[ai][0][m][n][i] + bv[ip >> 1][(ip & 1) * 2], up = acc[ai][1][m][n][i] + bv[ip >> 1][(ip & 1) * 2 + 1];
                        g = fminf(g, 7.0f); up = fminf(fmaxf(up, -7.0f), 7.0f); o[n][i] = (up + 1.0f) * g * sigm(1.702f * g); }
                *(u32x4*)(ACT + (size_t)(row0 + ai * HALF + m * 16) * 1024 + a0) = pack8(o[0], o[1]); }
    }
};

struct EpiDown {
    static constexpr bool PERM = true, AFTER_DRAIN = false;
    bf16_t* Y; const float* bd;
    __device__ __forceinline__ void operator()(const f32x4 (&acc)[2][2][4][2], const Unit& u, int wr, int wc, int fr, int fq) const {
        const int row0 = u.pm * BM + wr * 64 + fr; const int col0 = u.pn * BM + wc * 32 + 8 * fq;
        const float* bp = bd + (size_t)u.e * 1024 + col0;
        f32x4 bv[2][2];
#pragma unroll
        for (int bj = 0; bj < 2; ++bj)
#pragma unroll
            for (int n = 0; n < 2; ++n) bv[bj][n] = *(const f32x4*)(bp + bj * HALF + 4 * n);
#pragma unroll
        for (int ai = 0; ai < 2; ++ai)
#pragma unroll
            for (int m = 0; m < 4; ++m) { bf16_t* rowp = Y + (size_t)(row0 + ai * HALF + m * 16) * 1024 + col0;
#pragma unroll
                for (int bj = 0; bj < 2; ++bj) *(u32x4*)(rowp + bj * HALF) = pack8(acc[ai][bj][m][0] + bv[bj][0], acc[ai][bj][m][1] + bv[bj][1]); }
    }
};

struct GroupedOrder {
    const int* texp; int nunits, nn, G, v;
    __device__ void init(const int* ntiles_p, const int* texp_, int nn_, int G_, int c_) { texp = texp_; nn = nn_; G = G_; v = (G_ % 8 == 0) ? (c_ % 8) * (G_ / 8) + c_ / 8 : c_;
        nunits = __builtin_amdgcn_readfirstlane(*ntiles_p) * nn_; }
    __device__ bool next(int i, Unit& u) const {
        const int U = i * G + v; if (U >= nunits) return false;
        const int tile = U / nn, pn = U - tile * nn; const int e = __builtin_amdgcn_readfirstlane(texp[tile]);
        u.pm = tile; u.pn = pn; u.e = e; u.pb = e * nn + pn; return true;
    }
    __device__ __forceinline__ void a_ready(const Unit&) const {}
    __device__ __forceinline__ void done(const Unit&) const {}
};
template <class Epi, class Sched, bool ALIGN_EPI = false, bool SP2 = false>
__device__ __forceinline__ void gemm_phase(PG8_LAS unsigned char* lds, const Gemm g, const Sched& S, const Epi& E, const int mk_wave) {
    const int lane = mk_lane(), wid = mk_wave, tid = wid * 64 + lane, wr = wid >> 2, wc = wid & 3, fr = lane & 15, fq = lane >> 4;
    const int K = g.K, nt = K / BK;
    unsigned voffA[2], voffB[2];
#pragma unroll
    for (int i = 0; i < 2; ++i) { int R, C; stage_rc(tid * 16 + i * 8192, R, C); const int Rb = Epi::PERM ? ((R & ~31) + perm32(R & 31)) : R;
        voffA[i] = (unsigned)(R * K + C) * 2u; voffB[i] = (unsigned)(Rb * K + C) * 2u; }
    const size_t kstep = (size_t)(BK * 2);
    const size_t hstep = (size_t)HALF * K * 2;
    const size_t tstep = 2 * hstep;
    const unsigned ldsw = (unsigned)wid * 1024u;
    const int aoff = lds_byte(wr * 64 + fr, fq * 8), boff = lds_byte(wc * 32 + fr, fq * 8);
#define PG8_SA(b, h) (((b) * 2 + (h)) * HTB)
#define PG8_SB(b, h) ((4 + (b) * 2 + (h)) * HTB)
#define PG8_STAGE(bufoff, gbase, voff) do { _Pragma("unroll") for (int _i = 0; _i < 2; ++_i) \
        __builtin_amdgcn_global_load_lds((const unsigned*)((const char*)(gbase) + (voff)[_i]), (PG8_LAS unsigned*)(lds + (bufoff) + ldsw + _i * 8192), 16, 0, 0); } while (0)
#define PG8_LDA(dst, b, h) do { _Pragma("unroll") for (int m = 0; m < 4; ++m) _Pragma("unroll") for (int k = 0; k < 2; ++k) dst[m][k] = *(const PG8_LAS bf16x8*)(lds + PG8_SA(b, h) + aoff + m * 2048 + k * 1024); } while (0)
#define PG8_LDB(dst, b, h) do { _Pragma("unroll") for (int n = 0; n < 2; ++n) _Pragma("unroll") for (int k = 0; k < 2; ++k) dst[n][k] = *(const PG8_LAS bf16x8*)(lds + PG8_SB(b, h) + boff + n * 2048 + k * 1024); } while (0)
#define PG8_MMA(ai, bj, At, Bt) do { __builtin_amdgcn_s_setprio(1); _Pragma("unroll") for (int m = 0; m < 4; ++m) _Pragma("unroll") for (int n = 0; n < 2; ++n) _Pragma("unroll") for (int k = 0; k < 2; ++k) \
        acc[ai][bj][m][n] = __builtin_amdgcn_mfma_f32_16x16x32_bf16(Bt[n][k], At[m][k], acc[ai][bj][m][n], 0, 0, 0); __builtin_amdgcn_s_setprio(0); } while (0)
#define PG8_WAIT_V(n) asm volatile("s_waitcnt vmcnt(" #n ")" ::: "memory")
#define PG8_WAIT_L(n) asm volatile("s_waitcnt lgkmcnt(" #n ")" ::: "memory")
#define PG8_BAR __builtin_amdgcn_s_barrier()
#define PG8_SCHED __builtin_amdgcn_sched_barrier(0)
    Unit cur, nxt; int ui = 0;
    if (!S.next(0, cur)) return;
    f32x4 acc[2][2][4][2];
#pragma unroll
    for (int a = 0; a < 2; ++a)
#pragma unroll
        for (int b = 0; b < 2; ++b)
#pragma unroll
            for (int m = 0; m < 4; ++m)
#pragma unroll
                for (int n = 0; n < 2; ++n) acc[a][b][m][n] = (f32x4){0.f, 0.f, 0.f, 0.f};
    bf16x8 At[4][2], B0[2][2], B1[2][2];
    const char* cA = (const char*)g.A + (size_t)cur.pm * tstep; const char* cB = (const char*)g.Bt + (size_t)cur.pb * tstep;
    S.a_ready(cur);
    if constexpr (SP2) {
        PG8_STAGE(PG8_SB(0, 0), cB, voffB); PG8_STAGE(PG8_SB(0, 1), cB + hstep, voffB); PG8_STAGE(PG8_SA(0, 0), cA, voffA); PG8_STAGE(PG8_SA(0, 1), cA + hstep, voffA);
        if (wr == 1) PG8_BAR;
        PG8_WAIT_V(2); PG8_BAR;
        PG8_STAGE(PG8_SB(1, 0), cB + kstep, voffB); PG8_STAGE(PG8_SA(1, 0), cA + kstep, voffA); PG8_STAGE(PG8_SB(1, 1), cB + hstep + kstep, voffB);
        PG8_WAIT_V(6); PG8_BAR;
    } else {
        PG8_STAGE(PG8_SB(0, 0), cB, voffB); PG8_STAGE(PG8_SA(0, 0), cA, voffA); PG8_STAGE(PG8_SB(0, 1), cB + hstep, voffB); PG8_STAGE(PG8_SA(0, 1), cA + hstep, voffA);
        if (wr == 1) PG8_BAR;
        PG8_WAIT_V(4); PG8_BAR;
        PG8_STAGE(PG8_SB(1, 0), cB + kstep, voffB); PG8_STAGE(PG8_SA(1, 0), cA + kstep, voffA); PG8_STAGE(PG8_SB(1, 1), cB + hstep + kstep, voffB);
        PG8_WAIT_V(6); PG8_BAR;
    }
    for (;;) {
        const bool has_next = S.next(ui + 1, nxt);
        const char* nA = has_next ? (const char*)g.A + (size_t)nxt.pm * tstep : cA; const char* nB = has_next ? (const char*)g.Bt + (size_t)nxt.pb * tstep : cB;
        for (int t = 0; t < nt; t += 2) {
            const bool last = (t == nt - 2);
            const char* a1 = cA + (size_t)(t + 1) * kstep;
            const char* a2 = last ? nA : cA + (size_t)(t + 2) * kstep; const char* b2 = last ? nB : cB + (size_t)(t + 2) * kstep;
            const char* a3 = a2 + kstep; const char* b3 = b2 + kstep;
            if (last && has_next) S.a_ready(nxt);
            if constexpr (SP2) {
            PG8_LDB(B0, 0, 0); PG8_LDB(B1, 0, 1); PG8_SCHED; PG8_LDA(At, 0, 0); PG8_STAGE(PG8_SA(1, 1), a1 + hstep, voffA);
            PG8_WAIT_V(8); PG8_WAIT_L(0); PG8_BAR; PG8_MMA(0, 0, At, B0); PG8_MMA(0, 1, At, B1); PG8_BAR; PG8_SCHED;
            PG8_LDA(At, 0, 1); PG8_STAGE(PG8_SB(0, 0), b2, voffB); PG8_STAGE(PG8_SB(0, 1), b2 + hstep, voffB); PG8_STAGE(PG8_SA(0, 0), a2, voffA);
            PG8_WAIT_V(8); PG8_WAIT_L(0); PG8_BAR; PG8_MMA(1, 0, At, B0); PG8_MMA(1, 1, At, B1); PG8_BAR; PG8_SCHED;
            PG8_LDB(B0, 1, 0); PG8_LDB(B1, 1, 1); PG8_SCHED; PG8_LDA(At, 1, 0); PG8_STAGE(PG8_SA(0, 1), a2 + hstep, voffA);
            PG8_WAIT_V(8); PG8_WAIT_L(0); PG8_BAR; PG8_MMA(0, 0, At, B0); PG8_MMA(0, 1, At, B1); PG8_BAR; PG8_SCHED;
            PG8_LDA(At, 1, 1); PG8_STAGE(PG8_SB(1, 0), b3, voffB); PG8_STAGE(PG8_SB(1, 1), b3 + hstep, voffB); PG8_STAGE(PG8_SA(1, 0), a3, voffA);
            PG8_WAIT_V(8); PG8_WAIT_L(0); PG8_BAR; PG8_MMA(1, 0, At, B0); PG8_MMA(1, 1, At, B1); PG8_BAR; PG8_SCHED;
            } else {
            PG8_LDB(B0, 0, 0); PG8_SCHED; PG8_LDA(At, 0, 0); PG8_STAGE(PG8_SA(1, 1), a1 + hstep, voffA);
            PG8_WAIT_L(8); PG8_BAR; PG8_WAIT_L(0); PG8_MMA(0, 0, At, B0); PG8_BAR; PG8_SCHED;
            PG8_LDB(B1, 0, 1); PG8_STAGE(PG8_SB(0, 0), b2, voffB);
            PG8_BAR; PG8_WAIT_L(0); PG8_MMA(0, 1, At, B1); PG8_BAR;
            PG8_LDA(At, 0, 1); PG8_STAGE(PG8_SA(0, 0), a2, voffA);
            PG8_BAR; PG8_WAIT_L(0); PG8_MMA(1, 0, At, B0); PG8_BAR; PG8_SCHED;
            PG8_STAGE(PG8_SB(0, 1), b2 + hstep, voffB);
            PG8_WAIT_V(6); PG8_BAR; PG8_MMA(1, 1, At, B1); PG8_BAR;
            PG8_LDB(B0, 1, 0); PG8_SCHED; PG8_LDA(At, 1, 0); PG8_STAGE(PG8_SA(0, 1), a2 + hstep, voffA);
            PG8_WAIT_L(8); PG8_BAR; PG8_WAIT_L(0); PG8_MMA(0, 0, At, B0); PG8_BAR; PG8_SCHED;
            PG8_LDB(B1, 1, 1); PG8_STAGE(PG8_SB(1, 0), b3, voffB);
            PG8_BAR; PG8_WAIT_L(0); PG8_MMA(0, 1, At, B1); PG8_BAR;
            PG8_LDA(At, 1, 1); PG8_STAGE(PG8_SA(1, 0), a3, voffA);
            PG8_BAR; PG8_WAIT_L(0); PG8_MMA(1, 0, At, B0); PG8_BAR; PG8_SCHED;
            PG8_STAGE(PG8_SB(1, 1), b3 + hstep, voffB);
            PG8_WAIT_V(6); PG8_BAR; PG8_MMA(1, 1, At, B1); PG8_BAR;
            }
        }
        if constexpr (ALIGN_EPI) { if (wr == 0) PG8_BAR; }
        if constexpr (!Epi::AFTER_DRAIN) { E(acc, cur, wr, wc, fr, fq); S.done(cur); }
        if (!has_next) break;
#pragma unroll
        for (int a = 0; a < 2; ++a)
#pragma unroll
            for (int b = 0; b < 2; ++b)
#pragma unroll
                for (int m = 0; m < 4; ++m)
#pragma unroll
                    for (int n = 0; n < 2; ++n) acc[a][b][m][n] = (f32x4){0.f, 0.f, 0.f, 0.f};
        cur = nxt; cA = nA; cB = nB; ++ui;
        if constexpr (ALIGN_EPI) { if (wr == 1) PG8_BAR; }
    }
    PG8_WAIT_V(0);
    if constexpr (!ALIGN_EPI) { if (wr == 0) PG8_BAR; }
    PG8_BAR;
    if constexpr (Epi::AFTER_DRAIN) { E.fused(acc, cur, wr, wc, fr, fq, lds, wid, lane); S.done(cur); }
#undef PG8_SA
#undef PG8_SB
#undef PG8_STAGE
#undef PG8_LDA
#undef PG8_LDB
#undef PG8_MMA
#undef PG8_WAIT_V
#undef PG8_WAIT_L
#undef PG8_BAR
#undef PG8_SCHED
}
}

#include <hip/hip_bf16.h>
#include <cmath>
namespace attn_body {
using bf16=__hip_bfloat16;
using bf16x8=__attribute__((ext_vector_type(8)))short;
using s16x4=__attribute__((ext_vector_type(4)))short;
using f32x16=__attribute__((ext_vector_type(16)))float;
using u32x4=__attribute__((ext_vector_type(4)))unsigned;
constexpr int BATCH=32,NHEAD=16,SEQ=2048,D=64,DM=NHEAD*D;
constexpr int NW=8,QBLK=32,QB=QBLK*NW,KVBLK=64,NQB=SEQ/QB;
constexpr int ATTN_PITCH=DM, ATTN_UNIT_ROWS=QB;
__device__ __forceinline__ int crow(int r,int hi){return (r&3)+8*(r>>2)+4*hi;}
#define SBAR() __builtin_amdgcn_sched_barrier(0)
__device__ __forceinline__ void cmask(f32x16&p0,f32x16&p1,int jb,int qrel,int hi){
  const float NEG=-INFINITY; int kb=64*jb+4*hi;
  #pragma unroll
  for(int r=0;r<16;++r){int kv=kb+(r&3)+8*(r>>2); if(kv>qrel)p0[r]=NEG; if(kv+32>qrel)p1[r]=NEG;}
}

constexpr int NSLOT=3, SLOTB=8192;
constexpr int LDS_K=0, LDS_V=NSLOT*SLOTB, LDS_WS=2*NSLOT*SLOTB, LDS_OST=LDS_WS+NW*64*4, LDS_BT=LDS_OST+NW*4096, LDS_BYTES=LDS_BT+SEQ*16;
constexpr float C2=0.125f*1.4426950408889634f;
__device__ __forceinline__ void glds16(const void*gsrc,unsigned lds_dst){unsigned keep;
  asm volatile("s_mov_b32 %0, m0\n\ts_mov_b32 m0, %2\n\ts_nop 0\n\tglobal_load_lds_dwordx4 %1, off\n\ts_mov_b32 m0, %0":"=&s"(keep):"v"(gsrc),"s"(lds_dst):"memory");}
__device__ __forceinline__ float max3f(float a,float b,float c){float r;asm("v_max3_f32 %0, %1, %2, %3":"=v"(r):"v"(a),"v"(b),"v"(c));return r;}
__device__ __forceinline__ float max2f(float a,float b){float r;asm("v_max_f32_e32 %0, %1, %2":"=v"(r):"v"(a),"v"(b));return r;}
__device__ __forceinline__ float fadd_s(float a,float b){float r;asm("v_add_f32_e32 %0, %1, %2":"=v"(r):"v"(a),"v"(b));return r;}
__device__ __forceinline__ float fsub_s(float a,float b){float r;asm("v_sub_f32_e32 %0, %1, %2":"=v"(r):"v"(a),"v"(b));return r;}
typedef float f32x2_t __attribute__((ext_vector_type(2))); typedef __bf16 bf16x2_t __attribute__((ext_vector_type(2)));
__device__ __forceinline__ unsigned cvtpk_s(float lo,float hi){f32x2_t v={lo,hi};bf16x2_t b=__builtin_convertvector(v,bf16x2_t);return __builtin_bit_cast(unsigned,b);}
#define WAIT_BAR(N) asm volatile("s_waitcnt vmcnt(" #N ") lgkmcnt(0)\n\ts_barrier":::"memory")

__device__ __forceinline__ void qkt(f32x16&p0,f32x16&p1,const char*Kslot,const bf16x8*qr,int r32,int hi,bf16x8 ba0,bf16x8 ba1,bf16x8 qaug){
  const char*kb=Kslot+hi*1024+r32*16;
  #pragma unroll
  for(int d0=0;d0<4;++d0){
    const bf16x8 b0=*reinterpret_cast<const bf16x8*>(kb+d0*2048);
    const bf16x8 b1=*reinterpret_cast<const bf16x8*>(kb+d0*2048+512);
    if(d0==0){p0=__builtin_amdgcn_mfma_f32_32x32x16_bf16(b0,qr[0],f32x16{},0,0,0);p1=__builtin_amdgcn_mfma_f32_32x32x16_bf16(b1,qr[0],f32x16{},0,0,0);}
    else{p0=__builtin_amdgcn_mfma_f32_32x32x16_bf16(b0,qr[d0],p0,0,0,0);p1=__builtin_amdgcn_mfma_f32_32x32x16_bf16(b1,qr[d0],p1,0,0,0);}}
  p0=__builtin_amdgcn_mfma_f32_32x32x16_bf16(ba0,qaug,p0,0,0,0);p1=__builtin_amdgcn_mfma_f32_32x32x16_bf16(ba1,qaug,p1,0,0,0);
}
typedef __attribute__((address_space(3))) const char* lds_cptr;
typedef short v4i16_t __attribute__((ext_vector_type(4)));
__device__ __forceinline__ void kload8(bf16x8*kf,lds_cptr kp){
  kf[0]=*(const __attribute__((address_space(3))) bf16x8*)(kp);      kf[1]=*(const __attribute__((address_space(3))) bf16x8*)(kp+512);
  kf[2]=*(const __attribute__((address_space(3))) bf16x8*)(kp+2048); kf[3]=*(const __attribute__((address_space(3))) bf16x8*)(kp+2560);
  kf[4]=*(const __attribute__((address_space(3))) bf16x8*)(kp+4096); kf[5]=*(const __attribute__((address_space(3))) bf16x8*)(kp+4608);
  kf[6]=*(const __attribute__((address_space(3))) bf16x8*)(kp+6144); kf[7]=*(const __attribute__((address_space(3))) bf16x8*)(kp+6656);
}
__device__ __forceinline__ void kload2(bf16x8*kf,lds_cptr kp,int j){ kf[2*j]=*(const __attribute__((address_space(3))) bf16x8*)(kp+j*2048); kf[2*j+1]=*(const __attribute__((address_space(3))) bf16x8*)(kp+j*2048+512); }
__device__ __forceinline__ s16x4 vtr(lds_cptr p){ return __builtin_bit_cast(s16x4,__builtin_amdgcn_ds_read_tr16_b64_v4i16((__attribute__((address_space(3))) v4i16_t*)p)); }
__device__ __forceinline__ float rowmax(const f32x16&p0,const f32x16&p1){
  float a=max3f(p0[0],p0[1],p1[0]),b=max3f(p0[2],p0[3],p1[1]);a=max3f(a,p1[2],p1[3]);
  #pragma unroll
  for(int r=4;r<16;r+=4){a=max3f(a,p0[r],p0[r+1]);b=max3f(b,p0[r+2],p0[r+3]);a=max3f(a,p1[r],p1[r+1]);b=max3f(b,p1[r+2],p1[r+3]);}
  const float m=max2f(a,b);
  auto rr=__builtin_amdgcn_permlane32_swap(__float_as_uint(m),__float_as_uint(m),false,false);
  return max2f(__uint_as_float(rr[0]),__uint_as_float(rr[1]));
}
__device__ __forceinline__ void pv(f32x16*o,int vb,bf16x8 pa0,bf16x8 pa1,bf16x8 pa2,bf16x8 pa3){
  #pragma unroll
  for(int d0=0;d0<2;++d0){s16x4 lo[4],hi[4];
    #pragma unroll
    for(int ks=0;ks<4;++ks){
      asm volatile("ds_read_b64_tr_b16 %0,%1 offset:%c2":"=&v"(lo[ks]):"v"(vb),"i"(d0*4096+ks*1024):"memory");
      asm volatile("ds_read_b64_tr_b16 %0,%1 offset:%c2":"=&v"(hi[ks]):"v"(vb),"i"(d0*4096+ks*1024+512):"memory");}
    asm volatile("s_waitcnt lgkmcnt(0)":::"memory");SBAR();
    #define PK(k) (bf16x8){lo[k][0],lo[k][1],lo[k][2],lo[k][3],hi[k][0],hi[k][1],hi[k][2],hi[k][3]}
    o[d0]=__builtin_amdgcn_mfma_f32_32x32x16_bf16(pa0,PK(0),o[d0],0,0,0);
    o[d0]=__builtin_amdgcn_mfma_f32_32x32x16_bf16(pa1,PK(1),o[d0],0,0,0);
    o[d0]=__builtin_amdgcn_mfma_f32_32x32x16_bf16(pa2,PK(2),o[d0],0,0,0);
    o[d0]=__builtin_amdgcn_mfma_f32_32x32x16_bf16(pa3,PK(3),o[d0],0,0,0);
    #undef PK
  }
}

#ifndef ATTN_STORE16
#define ATTN_STORE16(p,v) (*(u32x4*)(p)=(v))
#endif
template<int THRL> __device__ __forceinline__ void attn_unit(int b,int h,int qb,const bf16*Q,const bf16*__restrict__ K,const bf16*__restrict__ V,bf16*O,const bf16*__restrict__ SG,char*shm,const int mk_wave){
  const int lane=mk_lane(),r32=lane&31,hi=lane>>5; const int wid=mk_wave; const int tid=wid*64+lane; (void)tid;
  const long rowbase=(long)b*SEQ; const int q0=qb*QB;
  const bf16*Qw=Q+(rowbase+q0+wid*QBLK)*DM+h*D;
  const bf16*Kh=K+rowbase*DM+h*D,*Vh=V+rowbase*DM+h*D;
  const unsigned lds0=(unsigned)(uintptr_t)shm;
  float*wsf=(float*)(shm+LDS_WS)+wid*64;
  const bf16*ksrc=Kh+(long)lane*DM+wid*8;
  const bf16*vsrc=Vh+(long)(16*(wid&3)+(lane>>2))*DM+(wid>>2)*32+(lane&3)*8;
  const unsigned kdst=lds0+LDS_K+wid*1024, vdst=lds0+LDS_V+wid*1024;
  #define DMA_K(t,slot) glds16(ksrc+(long)(t)*KVBLK*DM,(unsigned)__builtin_amdgcn_readfirstlane(kdst+(slot)))
  #define DMA_V(t,slot) glds16(vsrc+(long)(t)*KVBLK*DM,(unsigned)__builtin_amdgcn_readfirstlane(vdst+(slot)))
  const int vb0=(int)(lds0+LDS_V)+((lane>>4)&1)*32+(lane&3)*8+(4*hi+((lane&15)>>2))*64;
  const char*Kbase=shm+LDS_K; bf16x8 kf[8];
  const lds_cptr shm3=(lds_cptr)shm; const lds_cptr kp0=shm3+LDS_K+hi*1024+r32*16; const lds_cptr vp0=shm3+LDS_V+((lane>>4)&1)*32+(lane&3)*8+(4*hi+((lane&15)>>2))*64;
  const int NT=(q0+QB)/KVBLK;
  const lds_cptr btp=shm3+LDS_BT+r32*16;
  unsigned qref1=(hi==0)?0x00003F80u:0u, qref2=0u;
  #define SETREF() do{ const float x_=-mhat; const unsigned h0_=cvtpk_s(x_,0.f)&0xffffu; const float r1_=x_-__uint_as_float(h0_<<16); const unsigned h1_=cvtpk_s(r1_,0.f)&0xffffu; const float r2_=r1_-__uint_as_float(h1_<<16); const unsigned h2_=cvtpk_s(r2_,0.f)&0xffffu; \
      qref1=(hi==0)?(0x3F80u|(h0_<<16)):0u; qref2=(hi==0)?(h1_|(h2_<<16)):0u; }while(0)
  #define qaug __builtin_bit_cast(bf16x8,((u32x4){(hi==0)?0x3F803F80u:0u,qref1,qref2,0u}))
  #define BIASF(t,half) (*(const __attribute__((address_space(3))) bf16x8*)(btp+((t)*KVBLK+(half)*32)*16))
  DMA_K(0,0);DMA_V(0,0);DMA_K(1,SLOTB);
  bf16x8 qr[4];
  #pragma unroll
  for(int d0=0;d0<4;++d0)qr[d0]=*reinterpret_cast<const bf16x8*>(&Qw[(long)r32*DM+d0*16+hi*8]);
  const lds_cptr qpk=(lds_cptr)shm+LDS_OST+wid*4096+lane*16;
  *(__attribute__((address_space(3))) bf16x8*)(qpk)=qr[2]; *(__attribute__((address_space(3))) bf16x8*)(qpk+1024)=qr[3];
  #define QLD(i) (*(const __attribute__((address_space(3))) bf16x8*)(qpk+((i)-2)*1024))
  float mhat=0.f,l_reg=0.f;f32x16 o[2];o[0]=f32x16{};o[1]=f32x16{};
  const int qrel=wid*QBLK+r32;
  #define CMASK(P0,P1,t) do{int jb_=(t)-(NT-4); if(jb_>=0)cmask(P0,P1,jb_,qrel,hi);}while(0)
  bool resc=false;
  #define START(P0,P1) do{ const float rm=rowmax(P0,P1); resc=false; \
    { const float dl=rm; mhat=fadd_s(mhat,dl); \
      _Pragma("unroll") for(int r=0;r<16;++r){P0[r]=fsub_s(P0[r],dl);P1[r]=fsub_s(P1[r],dl);} \
      SETREF(); } \
    _Pragma("unroll") for(int r=0;r<16;++r)P0[r]=__builtin_amdgcn_exp2f(P0[r]); }while(0)
  #define RESC() do{ if(resc){ asm volatile("s_waitcnt lgkmcnt(0)":::"memory"); \
      _Pragma("unroll") for(int d_=0;d_<2;++d_) _Pragma("unroll") for(int r=0;r<16;++r)o[d_][r]*=wsf[crow(r,hi)]; } }while(0)
  f32x16 pA0,pA1,pB0,pB1;
  int sl_prev=0,sl_cur=0,sl_next=SLOTB;
  #define ROT() do{sl_prev=sl_cur;sl_cur=sl_next;sl_next=(sl_next==(NSLOT-1)*SLOTB)?0:sl_next+SLOTB;}while(0)
  DMA_K(2,2*SLOTB);
  WAIT_BAR(3);
  { const bf16x8 ba0_=BIASF(0,0),ba1_=BIASF(0,1); qkt(pA0,pA1,Kbase,qr,r32,hi,ba0_,ba1_,qaug); }asm volatile("s_nop 15\n\ts_nop 7":"+v"(pA0),"+v"(pA1));CMASK(pA0,pA1,0);
  START(pA0,pA1);
  _Pragma("unroll") for(int r=0;r<16;++r)pA1[r]=__builtin_amdgcn_exp2f(pA1[r]);
  WAIT_BAR(0);
  DMA_K(3,0);DMA_V(1,SLOTB);
  ROT();
  kload8(kf,kp0+sl_cur);
  WAIT_BAR(2);
  s16x4 vlo[8],vhi[8]; u32x4 pw0,pw1,pw2,pw3;
  #define PKW(P,B) cvtpk_s(P[B],P[B+1])
  #define PAF(k) __builtin_bit_cast(bf16x8,pw##k)
  #define VFR(i) (bf16x8){vlo[i][0],vlo[i][1],vlo[i][2],vlo[i][3],vhi[i][0],vhi[i][1],vhi[i][2],vhi[i][3]}
  #define PIN(x) asm volatile("":"+v"(x))
  #define MX3(a,b,c) __builtin_fmaxf(__builtin_fmaxf((a),(b)),(c))
  #define GAPA(MF,A0,A1,A2,A3,W0,W1,PW) do{ MF; sacc+=A0; sacc+=A1; sacc+=A2; sacc+=A3; PIN(sacc); W0; W1; PIN(PW); SBAR(); }while(0)
  #define EX(v) __builtin_amdgcn_exp2f(v)
  #define GAPB(MF,X,B) do{ MF; X[B]=EX(X[B]); X[B+1]=EX(X[B+1]); X[B+2]=EX(X[B+2]); X[B+3]=EX(X[B+3]); PIN(X); SBAR(); }while(0)
  #define VRD(i) do{ vlo[i]=vtr(vp_+(((i)>>2)*4096+((i)&3)*1024)); vhi[i]=vtr(vp_+(((i)>>2)*4096+((i)&3)*1024+512)); }while(0)
  #define KRD(G,j) do{ if(G){ kload2(kf,kp0+sl_next,j); SBAR(); } }while(0)
  #define STEP(C0,C1,P0,P1,t,GK,GV,GL) do{ SBAR(); \
    const lds_cptr vp_=vp0+sl_prev; \
    VRD(0); SBAR(); float sacc=(P0[0]+P0[1]); \
    GAPA(C0=__builtin_amdgcn_mfma_f32_32x32x16_bf16(kf[0],qr[0],f32x16{},0,0,0), P0[2],P0[3],P0[4],P0[5],     pw0[0]=PKW(P0,0), pw0[1]=PKW(P0,2), pw0); \
    VRD(4); SBAR(); GAPA(C1=__builtin_amdgcn_mfma_f32_32x32x16_bf16(kf[1],qr[0],f32x16{},0,0,0), P0[6],P0[7],P0[8],P0[9],     pw0[2]=PKW(P0,4), pw0[3]=PKW(P0,6), pw0); \
    const bf16x8 q2_=QLD(2); VRD(1); SBAR(); GAPA(C0=__builtin_amdgcn_mfma_f32_32x32x16_bf16(kf[2],qr[1],C0,0,0,0),   P0[10],P0[11],P0[12],P0[13], pw1[0]=PKW(P0,8), pw1[1]=PKW(P0,10), pw1); \
    VRD(5); SBAR(); GAPA(C1=__builtin_amdgcn_mfma_f32_32x32x16_bf16(kf[3],qr[1],C1,0,0,0),   P0[14],P0[15],P1[0],P1[1],   pw1[2]=PKW(P0,12),pw1[3]=PKW(P0,14), pw1); \
    const bf16x8 q3_=QLD(3); VRD(2); SBAR(); GAPA(C0=__builtin_amdgcn_mfma_f32_32x32x16_bf16(kf[4],q2_,C0,0,0,0),   P1[2],P1[3],P1[4],P1[5],     pw2[0]=PKW(P1,0), pw2[1]=PKW(P1,2), pw2); \
    VRD(6); SBAR(); GAPA(C1=__builtin_amdgcn_mfma_f32_32x32x16_bf16(kf[5],q2_,C1,0,0,0),   P1[6],P1[7],P1[8],P1[9],     pw2[2]=PKW(P1,4), pw2[3]=PKW(P1,6), pw2); \
    VRD(3); SBAR(); GAPA(C0=__builtin_amdgcn_mfma_f32_32x32x16_bf16(kf[6],q3_,C0,0,0,0),   P1[10],P1[11],P1[12],P1[13], pw3[0]=PKW(P1,8), pw3[1]=PKW(P1,10), pw3); \
    VRD(7); SBAR(); GAPA(C1=__builtin_amdgcn_mfma_f32_32x32x16_bf16(kf[7],q3_,C1,0,0,0),   P1[14],P1[15],0.f,0.f,       pw3[2]=PKW(P1,12),pw3[3]=PKW(P1,14), pw3); \
    { const bf16x8 ba0_=BIASF(t,0); C0=__builtin_amdgcn_mfma_f32_32x32x16_bf16(ba0_,qaug,C0,0,0,0); } { const bf16x8 ba1_=BIASF(t,1); C1=__builtin_amdgcn_mfma_f32_32x32x16_bf16(ba1_,qaug,C1,0,0,0); } SBAR(); \
    l_reg+=sacc; \
    if(GK){DMA_K((t)+3,sl_cur);} if(GV){DMA_V((t)+1,sl_next);} \
    CMASK(C0,C1,t); \
    { float a=MX3(C0[0],C0[1],C1[0]),b=MX3(C0[2],C0[3],C1[1]); a=MX3(a,C1[2],C1[3]); \
      _Pragma("unroll") for(int r=4;r<16;r+=4){a=MX3(a,C0[r],C0[r+1]);b=MX3(b,C0[r+2],C0[r+3]);a=MX3(a,C1[r],C1[r+1]);b=MX3(b,C1[r+2],C1[r+3]);} \
      float rm=__builtin_fmaxf(a,b); { auto rr=__builtin_amdgcn_permlane32_swap(__float_as_uint(rm),__float_as_uint(rm),false,false); rm=__builtin_fmaxf(__uint_as_float(rr[0]),__uint_as_float(rr[1])); } \
      resc=false; \
      if(__builtin_expect(__any(rm>(float)THRL),0)){ const float dl=__builtin_fmaxf(rm,0.f); mhat+=dl; \
        _Pragma("unroll") for(int r=0;r<16;++r){C0[r]-=dl;C1[r]-=dl;} \
        SETREF(); \
        const float f=__builtin_amdgcn_exp2f(-dl); l_reg*=f; if(hi==0)wsf[r32]=f; resc=true; } } \
    SBAR(); \
    GAPB(o[0]=__builtin_amdgcn_mfma_f32_32x32x16_bf16(PAF(0),VFR(0),o[0],0,0,0), C0,0); \
    GAPB(o[1]=__builtin_amdgcn_mfma_f32_32x32x16_bf16(PAF(0),VFR(4),o[1],0,0,0), C0,4); \
    KRD(GL,0); GAPB(o[0]=__builtin_amdgcn_mfma_f32_32x32x16_bf16(PAF(1),VFR(1),o[0],0,0,0), C0,8); \
    KRD(GL,1); GAPB(o[1]=__builtin_amdgcn_mfma_f32_32x32x16_bf16(PAF(1),VFR(5),o[1],0,0,0), C0,12); \
    KRD(GL,2); GAPB(o[0]=__builtin_amdgcn_mfma_f32_32x32x16_bf16(PAF(2),VFR(2),o[0],0,0,0), C1,0); \
    KRD(GL,3); GAPB(o[1]=__builtin_amdgcn_mfma_f32_32x32x16_bf16(PAF(2),VFR(6),o[1],0,0,0), C1,4); \
    GAPB(o[0]=__builtin_amdgcn_mfma_f32_32x32x16_bf16(PAF(3),VFR(3),o[0],0,0,0), C1,8); \
    GAPB(o[1]=__builtin_amdgcn_mfma_f32_32x32x16_bf16(PAF(3),VFR(7),o[1],0,0,0), C1,12); \
    }while(0)
  int t=1;
  #undef CMASK
  #define CMASK(P0,P1,t) do{}while(0)
  for(;t+5<NT;t+=2){
    STEP(pB0,pB1,pA0,pA1,t,true,true,true);     WAIT_BAR(2); RESC(); ROT();
    STEP(pA0,pA1,pB0,pB1,t+1,true,true,true);   WAIT_BAR(2); RESC(); ROT();
  }
  #undef CMASK
  #define CMASK(P0,P1,t) do{int jb_=(t)-(NT-4); if(jb_>=0)cmask(P0,P1,jb_,qrel,hi);}while(0)
  #define ENDW(tt) do{ if((tt)+3<NT){WAIT_BAR(2);} else if((tt)+2<NT){WAIT_BAR(1);} else {WAIT_BAR(0);} }while(0)
  for(;t+1<NT;t+=2){
    STEP(pB0,pB1,pA0,pA1,t,(t+3<NT),(t+1<NT),(t+1<NT));       ENDW(t);   RESC(); ROT();
    STEP(pA0,pA1,pB0,pB1,t+1,(t+4<NT),(t+2<NT),(t+2<NT));     ENDW(t+1); RESC(); ROT();
  }
  STEP(pB0,pB1,pA0,pA1,NT-1,false,false,false); RESC();
  { float sacc=pB0[0]+pB0[1]; _Pragma("unroll") for(int r=2;r<16;++r)sacc+=pB0[r]; _Pragma("unroll") for(int r=0;r<16;++r)sacc+=pB1[r]; l_reg+=sacc;
    pw0=(u32x4){PKW(pB0,0),PKW(pB0,2),PKW(pB0,4),PKW(pB0,6)};pw1=(u32x4){PKW(pB0,8),PKW(pB0,10),PKW(pB0,12),PKW(pB0,14)};pw2=(u32x4){PKW(pB1,0),PKW(pB1,2),PKW(pB1,4),PKW(pB1,6)};pw3=(u32x4){PKW(pB1,8),PKW(pB1,10),PKW(pB1,12),PKW(pB1,14)};
    SBAR(); pv(o,vb0+sl_cur,PAF(0),PAF(1),PAF(2),PAF(3)); }
  #undef PKW
  #undef PAF
  #undef VFR
  #undef PIN
  #undef MX3
  #undef GAPA
  #undef GAPB
  #undef EX
  #undef VRD
  #undef KRD
  #undef STEP
  #undef ENDW
  {auto rr=__builtin_amdgcn_permlane32_swap(__float_as_uint(l_reg),__float_as_uint(l_reg),false,false);l_reg=__uint_as_float(rr[0])+__uint_as_float(rr[1]);}
  if(hi==0)wsf[32+r32]=l_reg;asm volatile("s_waitcnt lgkmcnt(0)":::"memory");
  float rli[16];
  #pragma unroll
  for(int r=0;r<16;++r)rli[r]=__builtin_amdgcn_rcpf(wsf[32+crow(r,hi)]);
  bf16*Ow=O+(rowbase+q0+wid*QBLK)*DM+h*D; const bf16*SGw=SG+(rowbase+q0+wid*QBLK)*DM+h*D;
  { bf16*stg=(bf16*)(shm+LDS_OST)+wid*2048;
    #pragma unroll
    for(int r=0;r<16;++r){const int orow=crow(r,hi);
      #pragma unroll
      for(int d0=0;d0<2;++d0)stg[orow*64+d0*32+r32]=__float2bfloat16(o[d0][r]*rli[r]);}
    asm volatile("s_waitcnt lgkmcnt(0)":::"memory");
    #pragma unroll
    for(int i=0;i<4;++i){const int row=i*8+(lane>>3),ch=lane&7; u32x4 v=*(const u32x4*)(stg+row*64+ch*8); const u32x4 g=*(const u32x4*)(SGw+(long)row*DM+ch*8);
      _Pragma("unroll") for(int e_=0;e_<4;++e_){ const float a0=__uint_as_float(v[e_]<<16)*__uint_as_float(g[e_]<<16), a1=__uint_as_float(v[e_]&0xffff0000u)*__uint_as_float(g[e_]&0xffff0000u); v[e_]=cvtpk_s(a0,a1); }
      ATTN_STORE16(Ow+(long)row*DM+ch*8,v);} }
  asm volatile("s_waitcnt lgkmcnt(0)\n\ts_barrier":::"memory");
  #undef DMA_K
  #undef DMA_V
  #undef CMASK
  #undef START
  #undef RESC
  #undef ROT
  #undef BIASF
  #undef QLD
  #undef SETREF
  #undef qaug
}
constexpr int ATTN_LDS_BYTES=LDS_BYTES;
struct AttnTensors { const bf16* Q; const bf16* K; const bf16* V; bf16* O; const bf16* SG; const float* BIAS; };
struct AttnUnit { int bh; int qb; };
struct StaticOrder {
  int vcu,G;
  __device__ __forceinline__ explicit StaticOrder(int grid,int block):vcu(block),G(grid){}
  __device__ __forceinline__ bool next(int i,AttnUnit&u)const{ const int bh=vcu+(i>>3)*G; if(bh>=BATCH*NHEAD)return false; u.bh=bh; u.qb=i&7; return true; }
  __device__ __forceinline__ void a_ready(const AttnUnit&)const{}
  __device__ __forceinline__ void done(const AttnUnit&)const{}
};
__device__ __forceinline__ void fill_bias(const float*brow,char*shm,const int mk_wave){
  for(int kv=mk_wave*64+mk_lane();kv<SEQ;kv+=NW*64){ const float x=brow[kv];
    const unsigned h0=cvtpk_s(x,0.f)&0xffffu; const float r1=x-__uint_as_float(h0<<16);
    const unsigned h1=cvtpk_s(r1,0.f)&0xffffu; const float r2=r1-__uint_as_float(h1<<16);
    const unsigned h2=cvtpk_s(r2,0.f)&0xffffu;
    *(u32x4*)(shm+LDS_BT+kv*16)=(u32x4){h0|(h1<<16),h2|0x3F800000u,0x3F803F80u,0u}; }
}
template<class Sched,int THRL=8> __device__ __forceinline__ void attn_phase(char*lds,const AttnTensors&T,const Sched&S,const int mk_wave){
  AttnUnit u;
  for(int i=0;S.next(i,u);++i){ S.a_ready(u); if((i&7)==0) fill_bias(T.BIAS+(long)u.bh*SEQ,lds,mk_wave); attn_unit<THRL>(u.bh/NHEAD,u.bh%NHEAD,u.qb,T.Q,T.K,T.V,T.O,T.SG,lds,mk_wave); S.done(u); }
}
#undef SBAR
#undef WAIT_BAR
}

#define GAS __attribute__((address_space(1)))
#define LAS __attribute__((address_space(3)))
typedef unsigned short bf16;
typedef unsigned v4u __attribute__((ext_vector_type(4)));
typedef float f32x4 __attribute__((ext_vector_type(4)));
typedef short bf16x8 __attribute__((ext_vector_type(8)));
typedef GAS unsigned gu32;
typedef GAS unsigned long long gu64;
#define RLX_AGENT __ATOMIC_RELAXED, __HIP_MEMORY_SCOPE_AGENT
#define LDS_WAIT() asm volatile("s_waitcnt lgkmcnt(0)" ::: "memory")
#define VM_WAIT() asm volatile("s_waitcnt vmcnt(0)" ::: "memory")
__device__ __forceinline__ unsigned long long rt() { return __builtin_amdgcn_s_memrealtime(); }
__device__ __forceinline__ unsigned f2bf(float f) { unsigned u = __builtin_bit_cast(unsigned, f); return (u + 0x7fffu + ((u >> 16) & 1u)) >> 16; }
typedef float f32x2_t_ __attribute__((ext_vector_type(2))); typedef __bf16 bf16x2_t_ __attribute__((ext_vector_type(2)));
__device__ __forceinline__ unsigned pk2(float lo, float hi) { f32x2_t_ v = {lo, hi}; bf16x2_t_ b = __builtin_convertvector(v, bf16x2_t_); return __builtin_bit_cast(unsigned, b); }

#define XB_TMO      128
#define XB_XCNT(j)  (256  + 64 * (j))
#define XB_XSUB(j)  (1280 + 64 * (j))
#define XB_XGEN(j)  (2304 + 64 * (j))
#define XB_TOP      3328
#define XB_TOPGEN   3392
#define XCD_BAR_WORDS 3456
#define XB_SPIN_CAP (1u << 18)

__device__ __forceinline__ unsigned xb_ld(unsigned* p)              { return __hip_atomic_load(p, __ATOMIC_RELAXED, __HIP_MEMORY_SCOPE_AGENT); }
__device__ __forceinline__ unsigned xb_add(unsigned* p, unsigned v) { return __hip_atomic_fetch_add(p, v, __ATOMIC_RELAXED, __HIP_MEMORY_SCOPE_AGENT); }
__device__ __forceinline__ unsigned xb_xcc_id() { return (unsigned)__builtin_amdgcn_s_getreg((3 << 11) | 20) & 0xFu; }
#define XB_SPIN(cond, bar) do { unsigned _sp = 0; while (cond) { __builtin_amdgcn_s_sleep(1); \
    if ((++_sp & 255u) == 0u) { if (xb_ld(&(bar)[XB_TMO])) break; if (_sp > XB_SPIN_CAP) { atomicAdd(&(bar)[XB_TMO], 1u); break; } } } } while (0)

struct XcdBarrier {
    unsigned* bar; unsigned x; int w;
    volatile LAS unsigned* st;
};

__device__ __forceinline__ XcdBarrier xcd_barrier_post(unsigned* bar, volatile LAS unsigned* st, int wave) {
    XcdBarrier b; b.bar = bar; b.x = xb_xcc_id(); b.st = st; b.w = wave;
    if (b.w == 0 && mk_lane() == 0) (void)xb_add(&bar[XB_XCNT(b.x)], 1u);
    return b;
}
__device__ __forceinline__ void xcd_barrier_complete(unsigned* bar, unsigned x, unsigned& nloc, unsigned& nx) {
    const unsigned G = gridDim.x * gridDim.y * gridDim.z;
    unsigned sum, cnt, mine, sp = 0u;
    for (;;) {
        sum = 0u; cnt = 0u; mine = 0u;
#pragma unroll
        for (unsigned j = 0; j < 16; ++j) { const unsigned c = xb_ld(&bar[XB_XCNT(j)]); sum += c; cnt += (c > 0u) ? 1u : 0u; mine = (j == x) ? c : mine; }
        if (sum == G) break;
        __builtin_amdgcn_s_sleep(1);
        if ((++sp & 255u) == 0u) { if (xb_ld(&bar[XB_TMO])) break; if (sp > XB_SPIN_CAP) { atomicAdd(&bar[XB_TMO], 1u); break; } }
    }
    nloc = mine > 0u ? mine : 1u; nx = cnt > 0u ? cnt : 1u;
}

__device__ __forceinline__ void xcd_barrier(const XcdBarrier& b) {
    asm volatile("s_waitcnt vmcnt(0)" ::: "memory");
    __syncthreads();
    if (b.w == 0 && mk_lane() == 0) {
        unsigned* bar = b.bar;
        __builtin_amdgcn_s_waitcnt(0);
        unsigned nloc = b.st[0], nx = b.st[1];
        if (nloc == 0u) { xcd_barrier_complete(bar, b.x, nloc, nx); b.st[0] = nloc; b.st[1] = nx; }
        const unsigned old = xb_add(&bar[XB_XSUB(b.x)], 1u);
        const unsigned gen = old / nloc;
        if (old + 1u == (gen + 1u) * nloc) {
            __builtin_amdgcn_fence(__ATOMIC_RELEASE, "agent");
            asm volatile("s_waitcnt vmcnt(0)" ::: "memory");
            const unsigned og = xb_add(&bar[XB_TOP], 1u);
            const unsigned tg = og / nx;
            if (og + 1u == (tg + 1u) * nx) xb_add(&bar[XB_TOPGEN], 1u);
            else XB_SPIN(xb_ld(&bar[XB_TOPGEN]) == tg, bar);
            __builtin_amdgcn_fence(__ATOMIC_ACQUIRE, "agent");
            xb_add(&bar[XB_XGEN(b.x)], 1u);
            asm volatile("s_waitcnt vmcnt(0)" ::: "memory");
        } else {
            XB_SPIN(xb_ld(&bar[XB_XGEN(b.x)]) == gen, bar);
            __builtin_amdgcn_fence(__ATOMIC_ACQUIRE, "agent");
            asm volatile("s_waitcnt vmcnt(0)" ::: "memory");
        }
    }
    __syncthreads();
}

constexpr int NWAVES = 8;
constexpr int NB = 32, SEQ = 2048, D = 1024, T = NB * SEQ, DEPTH = 4, NE = 32, TOPK = 4, NMOD = 6;
constexpr int NFOXP = 4352;
constexpr int TPAD = T * TOPK + NE * 256;
constexpr int NCHUNK = T / 256;
constexpr float EPS = 1e-6f;

constexpr size_t MiB = 1u << 20;
constexpr size_t WS_CTL = 0, CTL_ZERO_BYTES = 1 * MiB;
constexpr size_t WS_ROUTE = 1 * MiB;
constexpr size_t WS_MOD = 2 * MiB;
constexpr size_t WS_FL = 5 * MiB;
constexpr size_t WS_BIAS = 9 * MiB;
constexpr size_t WS_TOPI = 13 * MiB, WS_TOPW = 14 * MiB, WS_POS = 15 * MiB;
constexpr size_t WS_WFI = 16 * MiB, WS_WFO = 33 * MiB, WS_WHI = 37 * MiB, WS_WHO = 53 * MiB;
constexpr size_t WS_WGU = 64 * MiB, WS_WDN = 192 * MiB;
constexpr size_t WS_HN = 256 * MiB;
constexpr size_t WS_R1 = 384 * MiB;
constexpr size_t WS_ACT = 1024 * MiB;
constexpr size_t WS_END = 1552 * MiB;
constexpr int RT_NTILES = 0, RT_TEXP = 64, RT_HIST = 2048;
constexpr int CW_BAR = 4096;

constexpr int RING_OFF = 0, RING_BYTES = 131072;
constexpr int LDSCTL_OFF = RING_BYTES, MISC_OFF = LDSCTL_OFF + 320;
constexpr int LSCR_OFF = LDSCTL_OFF + 1024;
constexpr int LDS_BYTES = 147456;

__device__ __forceinline__ float wave_sum(float v) {
#pragma unroll
    for (int o = 1; o < 64; o <<= 1) v += __shfl_xor(v, o);
    return v;
}
__device__ __forceinline__ float sigm_f(float x) { return __builtin_amdgcn_rcpf(1.0f + __expf(-x)); }
#define LBAR() do { asm volatile("s_waitcnt lgkmcnt(0)" ::: "memory"); __builtin_amdgcn_s_barrier(); asm volatile("" ::: "memory"); } while (0)

struct MapIdent { __device__ __forceinline__ int operator()(int n) const { return n; } };
struct MapFoxIn { __device__ __forceinline__ int operator()(int n) const { const int pn = n >> 8, s = n & 255, bj = s >> 7, wc = (s >> 5) & 3, j = s & 31, lc = 64 * wc + 32 * bj + j;
    return pn < 16 ? 256 * pn + lc : (lc < 16 ? 4096 + lc : -1); } };
struct MapGu { __device__ __forceinline__ int operator()(int n) const { const int pn = n >> 8, s = n & 255, bj = s >> 7, wc = (s >> 5) & 3, j = s & 31; return 2 * (128 * pn + 32 * wc + j) + bj; } };
template <class CM>
__device__ __forceinline__ void transpose_item(const float* W, int ldw, int K, bf16* WT, const CM& cm, LAS float* scr, int item, int nblk, int lane) {
    const int kb = item / nblk, nb = item - kb * nblk, k0 = 64 * kb, n0 = 32 * nb;
    const int col = cm(n0 + (lane & 31));
#pragma unroll 8
    for (int i = 0; i < 32; ++i) { const int kk = 2 * i + (lane >> 5); scr[kk * 33 + (lane & 31)] = (col >= 0) ? W[(size_t)(k0 + kk) * ldw + col] : 0.f; }
    LDS_WAIT(); asm volatile("" ::: "memory");
    const int c = lane & 7;
#pragma unroll
    for (int j = 0; j < 4; ++j) { const int n = (lane >> 3) + 8 * j; const LAS float* s = scr + (8 * c) * 33 + n;
        v4u o; o.x = pk2(s[0 * 33], s[1 * 33]); o.y = pk2(s[2 * 33], s[3 * 33]); o.z = pk2(s[4 * 33], s[5 * 33]); o.w = pk2(s[6 * 33], s[7 * 33]);
        *(GAS v4u*)(WT + (size_t)(n0 + n) * K + k0 + 8 * c) = o; }
    LDS_WAIT(); asm volatile("" ::: "memory");
}
template <class CM>
__device__ __forceinline__ void convert_matrix(const float* W, int ldw, int K, int Nd, bf16* WT, const CM& cm, LAS float* scr, int gw, int NGW, int lane) {
    const int nblk = Nd / 32, nitems = (K / 64) * nblk;
    for (int it = gw; it < nitems; it += NGW) transpose_item(W, ldw, K, WT, cm, scr, it, nblk, lane);
}

__device__ __forceinline__ void phase_mod(const float* c, const float* ada_w, const float* ada_b, float* MOD, float* ldsf, int tid, int bid, int G) {
    for (int idx = tid; idx < NB * D; idx += NWAVES * 64) { const int b = idx >> 10, k = idx & 1023; const float x = c[idx]; ldsf[k * 32 + b] = x * sigm_f(x); }
    __syncthreads();
    const int bq = tid >> 7, n = tid & 127;
    for (int grp = bid; grp < DEPTH * 48; grp += G) {
        const int L = grp / 48, n0 = (grp - L * 48) * 128;
        const float* wp = ada_w + (size_t)L * D * (NMOD * D) + n0 + n;
        float acc[8];
#pragma unroll
        for (int i = 0; i < 8; ++i) acc[i] = 0.f;
#pragma unroll 8
        for (int k = 0; k < D; ++k) { const float w = wp[(size_t)k * (NMOD * D)]; const f32x4 c0 = *(const f32x4*)(ldsf + k * 32 + 8 * bq), c1 = *(const f32x4*)(ldsf + k * 32 + 8 * bq + 4);
            acc[0] += w * c0[0]; acc[1] += w * c0[1]; acc[2] += w * c0[2]; acc[3] += w * c0[3]; acc[4] += w * c1[0]; acc[5] += w * c1[1]; acc[6] += w * c1[2]; acc[7] += w * c1[3]; }
        const float bb = ada_b[(size_t)L * (NMOD * D) + n0 + n];
#pragma unroll
        for (int i = 0; i < 8; ++i) MOD[((size_t)L * NB + 8 * bq + i) * (NMOD * D) + n0 + n] = acc[i] + bb;
    }
    __syncthreads();
}

__device__ __forceinline__ void phase_norm1(const float* xin, float* xout, bf16* HN, const float* nw, const float* modL  , bool do_norm,
                                            bool combine, const bf16* Y, const int* POS, const float* TOPW, const float* modP  , int gw, int NGW, int lane) {
    for (int r0 = gw * 32; r0 < T; r0 += NGW * 32) {
        const int b = r0 >> 11;
        f32x4 A[4], Bv[4], G2[4];
#pragma unroll
        for (int j = 0; j < 4; ++j) { const int col = 4 * lane + 256 * j;
            if (do_norm) { const f32x4 w = *(const f32x4*)(nw + col), sc = *(const f32x4*)(modL + (size_t)b * 6144 + 1024 + col); A[j] = w * (sc + 1.0f); Bv[j] = *(const f32x4*)(modL + (size_t)b * 6144 + col); }
            else { A[j] = (f32x4){0.f, 0.f, 0.f, 0.f}; Bv[j] = A[j]; }
            G2[j] = combine ? *(const f32x4*)(modP + (size_t)b * 6144 + 5120 + col) : (f32x4){0.f, 0.f, 0.f, 0.f}; }
        for (int r = r0; r < r0 + 32; ++r) {
            f32x4 v[4];
#pragma unroll
            for (int j = 0; j < 4; ++j) v[j] = *(const f32x4*)(xin + (size_t)r * D + 4 * lane + 256 * j);
            if (combine) {
                f32x4 acc[4];
#pragma unroll
                for (int j = 0; j < 4; ++j) acc[j] = (f32x4){0.f, 0.f, 0.f, 0.f};
#pragma unroll
                for (int k = 0; k < TOPK; ++k) { const int pos = __builtin_amdgcn_readfirstlane(POS[r * 4 + k]); const float w = TOPW[r * 4 + k];
#pragma unroll
                    for (int j = 0; j < 4; ++j) { const uint2 y = *(const uint2*)(Y + (size_t)pos * D + 4 * lane + 256 * j);
                        acc[j][0] += w * __uint_as_float(y.x << 16); acc[j][1] += w * __uint_as_float(y.x & 0xffff0000u); acc[j][2] += w * __uint_as_float(y.y << 16); acc[j][3] += w * __uint_as_float(y.y & 0xffff0000u); } }
#pragma unroll
                for (int j = 0; j < 4; ++j) v[j] = v[j] + G2[j] * acc[j];
            }
            if (combine || xin != xout) {
#pragma unroll
                for (int j = 0; j < 4; ++j) *(f32x4*)(xout + (size_t)r * D + 4 * lane + 256 * j) = v[j];
            }
            if (do_norm) {
                float ss = 0.f;
#pragma unroll
                for (int j = 0; j < 4; ++j) ss += (v[j][0] * v[j][0] + v[j][1] * v[j][1]) + (v[j][2] * v[j][2] + v[j][3] * v[j][3]);
                const float rs = __builtin_amdgcn_rsqf(wave_sum(ss) * (1.0f / D) + EPS);
#pragma unroll
                for (int j = 0; j < 4; ++j) { const f32x4 h = v[j] * rs * A[j] + Bv[j]; uint2 o; o.x = pk2(h[0], h[1]); o.y = pk2(h[2], h[3]); *(uint2*)(HN + (size_t)r * D + 4 * lane + 256 * j) = o; }
            }
        }
    }
}

__device__ __forceinline__ void phase_cumsum(const float* FL, float* BIAS, int gw, int NGW, int lane) {
    for (int seq = gw; seq < NB * 16; seq += NGW) {
        const int b = seq >> 4, h = seq & 15;
        const float* src = FL + ((size_t)b * SEQ + 32 * lane) * 16 + h;
        float v[32]; float run = 0.f;
#pragma unroll
        for (int i = 0; i < 32; ++i) { run += src[(size_t)i * 16]; v[i] = run; }
        float inc = run;
#pragma unroll
        for (int d = 1; d < 64; d <<= 1) { const float t = __shfl_up(inc, d); if (lane >= d) inc += t; }
        const float excl = inc - run;
        float* dst = BIAS + (size_t)seq * SEQ + 32 * lane;
#pragma unroll
        for (int i = 0; i < 32; i += 4) *(f32x4*)(dst + i) = (f32x4){-(v[i] + excl), -(v[i + 1] + excl), -(v[i + 2] + excl), -(v[i + 3] + excl)};
    }
}

__device__ __forceinline__ void phase_norm2_route(const float* X, bf16* HN, const float* nw, const float* modL, const float* rw, const float* rb,
                                                  int* TOPI, float* TOPW, int* HIST, unsigned char* lds, int tid, int lane, int wave, int bid, int G) {
    float* wrt = (float*)(lds + RING_OFF);
    float* wl = (float*)(lds + LSCR_OFF) + wave * 64;
    int* hist = (int*)(lds + LSCR_OFF + 2048);
    for (int idx = tid; idx < NE * D; idx += NWAVES * 64) { const int e = idx >> 10, c = idx & 1023; wrt[idx] = rw[c * NE + e]; }
    for (int chunk = bid; chunk < NCHUNK; chunk += G) {
        if (tid < NE) hist[tid] = 0;
        __syncthreads();
        const int b = chunk >> 3;
        f32x4 A[4], Bv[4];
#pragma unroll
        for (int j = 0; j < 4; ++j) { const int col = 4 * lane + 256 * j; const f32x4 w = *(const f32x4*)(nw + col), sc = *(const f32x4*)(modL + (size_t)b * 6144 + 4096 + col); A[j] = w * (sc + 1.0f); Bv[j] = *(const f32x4*)(modL + (size_t)b * 6144 + 3072 + col); }
        for (int it = 0; it < 16; ++it) {
            const int r0 = chunk * 256 + wave * 32 + it * 2;
            f32x4 h[2][4];
#pragma unroll
            for (int rr = 0; rr < 2; ++rr) {
                f32x4 v[4]; float ss = 0.f;
#pragma unroll
                for (int j = 0; j < 4; ++j) { v[j] = *(const f32x4*)(X + (size_t)(r0 + rr) * D + 4 * lane + 256 * j); ss += (v[j][0] * v[j][0] + v[j][1] * v[j][1]) + (v[j][2] * v[j][2] + v[j][3] * v[j][3]); }
                const float rs = __builtin_amdgcn_rsqf(wave_sum(ss) * (1.0f / D) + EPS);
#pragma unroll
                for (int j = 0; j < 4; ++j) { h[rr][j] = v[j] * rs * A[j] + Bv[j]; uint2 o; o.x = pk2(h[rr][j][0], h[rr][j][1]); o.y = pk2(h[rr][j][2], h[rr][j][3]); *(uint2*)(HN + (size_t)(r0 + rr) * D + 4 * lane + 256 * j) = o; }
            }
#pragma unroll 1
            for (int grp = 0; grp < 4; ++grp) {
                float acc[2][8];
#pragma unroll
                for (int e = 0; e < 8; ++e) { float a0 = 0.f, a1 = 0.f;
#pragma unroll
                    for (int j = 0; j < 4; ++j) { const f32x4 w = *(const f32x4*)(wrt + (8 * grp + e) * D + 4 * lane + 256 * j);
                        a0 += (h[0][j][0] * w[0] + h[0][j][1] * w[1]) + (h[0][j][2] * w[2] + h[0][j][3] * w[3]); a1 += (h[1][j][0] * w[0] + h[1][j][1] * w[1]) + (h[1][j][2] * w[2] + h[1][j][3] * w[3]); }
                    acc[0][e] = a0; acc[1][e] = a1; }
#pragma unroll
                for (int rr = 0; rr < 2; ++rr) {
#pragma unroll
                    for (int half = 4, bit = 32; half >= 1; half >>= 1, bit >>= 1) {
                        const bool up = (lane & bit) != 0;
#pragma unroll
                        for (int i = 0; i < half; ++i) { const float lo = acc[rr][i], hi = acc[rr][i + half]; const float send = up ? lo : hi, keep = up ? hi : lo; acc[rr][i] = keep + __shfl_xor(send, bit); }
                    }
                    float v = acc[rr][0]; v += __shfl_xor(v, 4); v += __shfl_xor(v, 2); v += __shfl_xor(v, 1);
                    const int eg = 8 * grp + (lane >> 3);
                    if ((lane & 7) == 0) wl[rr * 32 + eg] = v + rb[eg];
                }
            }
            asm volatile("s_waitcnt lgkmcnt(0)" ::: "memory");
#pragma unroll
            for (int rr = 0; rr < 2; ++rr) {
                float l[32];
#pragma unroll
                for (int q = 0; q < 8; ++q) { const f32x4 t = *(const f32x4*)(wl + rr * 32 + 4 * q); l[4 * q] = t[0]; l[4 * q + 1] = t[1]; l[4 * q + 2] = t[2]; l[4 * q + 3] = t[3]; }
                int sel[4]; float val[4];
#pragma unroll
                for (int k = 0; k < 4; ++k) { float best = l[0]; int bi = 0;
#pragma unroll
                    for (int e = 1; e < 32; ++e) { if (l[e] > best) { best = l[e]; bi = e; } }
                    sel[k] = bi; val[k] = best;
#pragma unroll
                    for (int e = 0; e < 32; ++e) l[e] = (e == bi) ? -INFINITY : l[e]; }
                const float e1 = __expf(val[1] - val[0]), e2 = __expf(val[2] - val[0]), e3 = __expf(val[3] - val[0]); const float inv = 1.0f / (1.0f + e1 + e2 + e3);
                if (lane == 0) { const int r = r0 + rr;
                    *(int4*)(TOPI + (size_t)r * 4) = make_int4(sel[0], sel[1], sel[2], sel[3]); *(float4*)(TOPW + (size_t)r * 4) = make_float4(inv, e1 * inv, e2 * inv, e3 * inv);
                    atomicAdd(&hist[sel[0]], 1); atomicAdd(&hist[sel[1]], 1); atomicAdd(&hist[sel[2]], 1); atomicAdd(&hist[sel[3]], 1); }
            }
            asm volatile("s_waitcnt lgkmcnt(0)" ::: "memory");
        }
        __syncthreads();
        if (tid < NE) HIST[chunk * NE + tid] = hist[tid];
        __syncthreads();
    }
}

__device__ __forceinline__ void phase_scatter(const bf16* HN, bf16* HS, const int* TOPI, int* POS, const int* HIST, int* ROUTE, unsigned char* lds, int tid, int lane, int wave, int bid, int G) {
    int* idx = (int*)(lds + RING_OFF);
    int* posl = idx + 1024;
    int* part = posl + 1024;
    int* tot_s = part + 1024; int* bef_s = tot_s + 32; int* pst_s = bef_s + 32; int* base_s = pst_s + 32;
    for (int chunk = bid; chunk < NCHUNK; chunk += G) {
        { const int e = tid & 31, p = tid >> 5; int t = 0, bf = 0;
          for (int c2 = p * 16; c2 < p * 16 + 16; ++c2) { const int hv = HIST[c2 * NE + e]; t += hv; bf += (c2 < chunk) ? hv : 0; }
          part[p * 32 + e] = t; part[512 + p * 32 + e] = bf; }
        idx[tid] = TOPI[(size_t)chunk * 1024 + tid]; idx[tid + 512] = TOPI[(size_t)chunk * 1024 + 512 + tid];
        __syncthreads();
        if (tid < NE) { int t = 0, bf = 0; for (int p = 0; p < 16; ++p) { t += part[p * 32 + tid]; bf += part[512 + p * 32 + tid]; } tot_s[tid] = t; bef_s[tid] = bf; }
        __syncthreads();
        if (tid == 0) { int run = 0; for (int e = 0; e < NE; ++e) { const int padded = (tot_s[e] + 255) & ~255; pst_s[e] = run; base_s[e] = run + bef_s[e]; run += padded; }
            if (chunk == 0) ROUTE[RT_NTILES] = run >> 8; }
        __syncthreads();
        if (chunk == 0 && tid < NE) { const int t0 = pst_s[tid] >> 8, t1 = (pst_s[tid] + ((tot_s[tid] + 255) & ~255)) >> 8; for (int t = t0; t < t1; ++t) ROUTE[RT_TEXP + t] = tid; }
#pragma unroll
        for (int q = 0; q < 2; ++q) { const int a = tid + 512 * q; const int e = idx[a]; const int lim = (a >> 2) * 4; int rank = 0;
            for (int a2 = 0; a2 < lim; ++a2) rank += (idx[a2] == e) ? 1 : 0;
            const int p = base_s[e] + rank; posl[a] = p; POS[(size_t)chunk * 1024 + a] = p; }
        __syncthreads();
        for (int tl = wave * 32; tl < wave * 32 + 32; ++tl) { const size_t r = (size_t)chunk * 256 + tl;
            const v4u v0 = *(const v4u*)(HN + r * D + 8 * lane), v1 = *(const v4u*)(HN + r * D + 512 + 8 * lane);
#pragma unroll
            for (int k = 0; k < TOPK; ++k) { const size_t p = (size_t)posl[tl * 4 + k]; *(v4u*)(HS + p * D + 8 * lane) = v0; *(v4u*)(HS + p * D + 512 + 8 * lane) = v1; } }
        __syncthreads();
    }
}

namespace hg {
typedef short s16x4 __attribute__((ext_vector_type(4)));
typedef float f32x16 __attribute__((ext_vector_type(16)));
constexpr int QS = 136, TS = 40, OSS = 129;
constexpr int L_QT = 0, L_KT = L_QT + 32 * QS * 2, L_KH = L_KT + 32 * QS * 2, L_VT = L_KH + 128 * TS * 2, L_SB = L_VT + 128 * TS * 2, SB_BYTES = 128 * QS * 2,
              L_OS = L_SB + 2 * SB_BYTES, L_SEG = L_OS + 32 * OSS * 4, L_DEC = L_SEG + 4 * 128 * 4, L_END = L_DEC + 128 * 4;
static_assert(L_END <= RING_BYTES, "hgrn LDS map");
__device__ __forceinline__ int crow(int r, int hi) { return (r & 3) + 8 * (r >> 2) + 4 * hi; }
__device__ __forceinline__ unsigned short bfr(float x) { return (unsigned short)f2bf(x); }
}
__device__ __forceinline__ void phase_hgrn(const bf16* Pq, const float* LF, const bf16* Pk, const bf16* Pv, const bf16* Pg, bf16* AO, const float* gnorm,
                                           LAS unsigned char* lds, int tid, int lane, int wave, int bid, int G) {
    using namespace hg;
    const int d = tid & 127, seg = tid >> 7;
    const int et = tid >> 4, ec = tid & 15;
    const int r = lane & 31, hh = lane >> 5;
    f32x4 gn0 = *(const f32x4*)(gnorm + 8 * ec), gn1 = *(const f32x4*)(gnorm + 8 * ec + 4);
    for (int bh = bid; bh < NB * 8; bh += G) {
        const int b = bh >> 3, h = bh & 7;
        const size_t rowbase = (size_t)b * SEQ; const int colbase = h * 128;
        for (int i = tid; i < SB_BYTES / 4; i += NWAVES * 64) ((LAS unsigned*)(lds + L_SB))[i] = 0u;
        f32x16 st[2];
#pragma unroll
        for (int q = 0; q < 2; ++q)
#pragma unroll
            for (int i = 0; i < 16; ++i) st[q][i] = 0.f;
        float lf[8]; unsigned short qv[8], kv[8], vv[8]; v4u sgv;
#pragma unroll
        for (int i = 0; i < 8; ++i) { const size_t off = (rowbase + 8 * seg + i) * D + colbase + d; lf[i] = LF[off]; qv[i] = Pq[off]; kv[i] = Pk[off]; vv[i] = Pv[off]; }
        sgv = *(const v4u*)(Pg + (rowbase + et) * D + colbase + 8 * ec);
        LBAR();
        for (int c = 0; c < SEQ / 32; ++c) {
            const int t0 = c * 32;
            float bl[8]; { float run = 0.f;
#pragma unroll
                for (int i = 0; i < 8; ++i) { run += lf[i]; bl[i] = run; } }
            ((LAS float*)(lds + L_SEG))[seg * 128 + d] = bl[7];
            LBAR();
            float pre = 0.f, bend = 0.f;
#pragma unroll
            for (int s2 = 0; s2 < 4; ++s2) { const float sv = ((LAS float*)(lds + L_SEG))[s2 * 128 + d]; bend += sv; pre += (s2 < seg) ? sv : 0.f; }
            unsigned short kh[8];
#pragma unroll
            for (int i = 0; i < 8; ++i) { const float bb = pre + bl[i]; const float qf = __uint_as_float((unsigned)qv[i] << 16), kf = __uint_as_float((unsigned)kv[i] << 16);
                ((LAS unsigned short*)(lds + L_QT))[(8 * seg + i) * QS + d] = bfr(qf * __expf(bb));
                ((LAS unsigned short*)(lds + L_KT))[(8 * seg + i) * QS + d] = bfr(kf * __expf(fminf(-bb, 80.0f)));
                kh[i] = bfr(kf * __expf(bend - bb)); }
            *(LAS v4u*)(lds + L_KH + (d * TS + 8 * seg) * 2) = (v4u){(unsigned)kh[0] | ((unsigned)kh[1] << 16), (unsigned)kh[2] | ((unsigned)kh[3] << 16), (unsigned)kh[4] | ((unsigned)kh[5] << 16), (unsigned)kh[6] | ((unsigned)kh[7] << 16)};
            *(LAS v4u*)(lds + L_VT + (d * TS + 8 * seg) * 2) = (v4u){(unsigned)vv[0] | ((unsigned)vv[1] << 16), (unsigned)vv[2] | ((unsigned)vv[3] << 16), (unsigned)vv[4] | ((unsigned)vv[5] << 16), (unsigned)vv[6] | ((unsigned)vv[7] << 16)};
            if (seg == 0) ((LAS float*)(lds + L_DEC))[d] = __expf(bend);
            const v4u sg_cur = sgv;
            if (c + 1 < SEQ / 32) {
#pragma unroll
                for (int i = 0; i < 8; ++i) { const size_t off = (rowbase + t0 + 32 + 8 * seg + i) * D + colbase + d; lf[i] = LF[off]; qv[i] = Pq[off]; kv[i] = Pk[off]; vv[i] = Pv[off]; }
                sgv = *(const v4u*)(Pg + (rowbase + t0 + 32 + et) * D + colbase + 8 * ec);
            }
            LBAR();
            const LAS unsigned char* sbc = lds + L_SB + (c & 1) * SB_BYTES; LAS unsigned char* sbn = lds + L_SB + ((c + 1) & 1) * SB_BYTES;
            if (wave < 4) {
                const int dvt = wave;
                bf16x8 qf[8];
#pragma unroll
                for (int ks = 0; ks < 8; ++ks) qf[ks] = *(const LAS bf16x8*)(lds + L_QT + (r * QS + 16 * ks + 8 * hh) * 2);
                f32x16 pt;
#pragma unroll
                for (int i = 0; i < 16; ++i) pt[i] = 0.f;
#pragma unroll
                for (int ks = 0; ks < 8; ++ks) { const bf16x8 a = *(const LAS bf16x8*)(lds + L_KT + (r * QS + 16 * ks + 8 * hh) * 2); pt = __builtin_amdgcn_mfma_f32_32x32x16_bf16(a, qf[ks], pt, 0, 0, 0); }
                bf16x8 pb[2];
#pragma unroll
                for (int ks2 = 0; ks2 < 2; ++ks2) { unsigned w[4];
#pragma unroll
                    for (int jp = 0; jp < 4; ++jp) { const int r0 = 8 * ks2 + 2 * jp, r1 = r0 + 1; const float x0 = (crow(r0, hh) <= r) ? pt[r0] : 0.f, x1 = (crow(r1, hh) <= r) ? pt[r1] : 0.f; w[jp] = pk2(x0, x1); }
                    pb[ks2] = __builtin_bit_cast(bf16x8, (v4u){w[0], w[1], w[2], w[3]}); }
                f32x16 ot;
#pragma unroll
                for (int i = 0; i < 16; ++i) ot[i] = 0.f;
#pragma unroll
                for (int ks = 0; ks < 8; ++ks) { const bf16x8 a = *(const LAS bf16x8*)(sbc + ((32 * dvt + r) * QS + 16 * ks + 8 * hh) * 2); ot = __builtin_amdgcn_mfma_f32_32x32x16_bf16(a, qf[ks], ot, 0, 0, 0); }
#pragma unroll
                for (int ks2 = 0; ks2 < 2; ++ks2) { const s16x4 lo = *(const LAS s16x4*)(lds + L_VT + ((32 * dvt + r) * TS + 16 * ks2 + 4 * hh) * 2), hi4 = *(const LAS s16x4*)(lds + L_VT + ((32 * dvt + r) * TS + 16 * ks2 + 8 + 4 * hh) * 2);
                    const bf16x8 a = (bf16x8){lo[0], lo[1], lo[2], lo[3], hi4[0], hi4[1], hi4[2], hi4[3]}; ot = __builtin_amdgcn_mfma_f32_32x32x16_bf16(a, pb[ks2], ot, 0, 0, 0); }
#pragma unroll
                for (int i = 0; i < 16; ++i) ((LAS float*)(lds + L_OS))[r * OSS + 32 * dvt + crow(i, hh)] = ot[i];
            }
            { const int dvt = wave & 3;
#pragma unroll
              for (int q = 0; q < 2; ++q) { const int dkt = 2 * (wave >> 2) + q; const float dec = ((LAS float*)(lds + L_DEC))[32 * dkt + r];
#pragma unroll
                  for (int i = 0; i < 16; ++i) st[q][i] *= dec;
#pragma unroll
                  for (int ks2 = 0; ks2 < 2; ++ks2) { const bf16x8 a = *(const LAS bf16x8*)(lds + L_VT + ((32 * dvt + r) * TS + 16 * ks2 + 8 * hh) * 2), bq = *(const LAS bf16x8*)(lds + L_KH + ((32 * dkt + r) * TS + 16 * ks2 + 8 * hh) * 2);
                      st[q] = __builtin_amdgcn_mfma_f32_32x32x16_bf16(a, bq, st[q], 0, 0, 0); }
#pragma unroll
                  for (int i = 0; i < 16; ++i) ((LAS unsigned short*)sbn)[(32 * dvt + crow(i, hh)) * QS + 32 * dkt + r] = bfr(st[q][i]); } }
            LBAR();
            { float o[8]; float ss = 0.f;
#pragma unroll
              for (int i = 0; i < 8; ++i) { o[i] = ((LAS float*)(lds + L_OS))[et * OSS + 8 * ec + i]; ss += o[i] * o[i]; }
              ss += __shfl_xor(ss, 1); ss += __shfl_xor(ss, 2); ss += __shfl_xor(ss, 4); ss += __shfl_xor(ss, 8);
              const float rs = __builtin_amdgcn_rsqf(ss * (1.0f / 128.0f) + EPS);
              const unsigned gw4[4] = {sg_cur.x, sg_cur.y, sg_cur.z, sg_cur.w}; v4u w;
              const float gnv[8] = {gn0[0], gn0[1], gn0[2], gn0[3], gn1[0], gn1[1], gn1[2], gn1[3]}; unsigned wo[4];
#pragma unroll
              for (int p = 0; p < 4; ++p) { const float g0 = __uint_as_float(gw4[p] << 16), g1 = __uint_as_float(gw4[p] & 0xffff0000u);
                  wo[p] = pk2(o[2 * p] * rs * gnv[2 * p] * g0, o[2 * p + 1] * rs * gnv[2 * p + 1] * g1); }
              w = (v4u){wo[0], wo[1], wo[2], wo[3]};
              *(v4u*)(AO + (rowbase + t0 + et) * D + colbase + 8 * ec) = w; }
        }
        LBAR();
    }
}

struct Args { const float* in[21]; float* out; unsigned char* ws; int ph_lo, ph_hi; };
#ifndef MK_PER_PHASE
#define MK_PER_PHASE 0
#endif
constexpr int PH_PER_LAYER = 9;
constexpr int N_PHASES = 1 + DEPTH * PH_PER_LAYER + 1;

#ifndef PH_MASK
#define PH_MASK 0xFFF
#endif
#ifndef SUB_MASK
#define SUB_MASK 3
#endif
#define EN(b) ((PH_MASK >> (b)) & 1)
#define SUBEN(b) ((SUB_MASK >> (b)) & 1)
#define IN(k) in_range(k)
#define SEAM(k) do { if (IN((k) + 1)) { if (MK_PER_PHASE) { } else { CArgs& a_ = kargs(); XcdBarrier bar_; bar_.bar = (unsigned*)(a_.ws + WS_CTL) + CW_BAR; bar_.x = xb_xcc_id(); bar_.st = (volatile LAS unsigned*)(ldsl + MISC_OFF) + 8; bar_.w = wave; xcd_barrier(bar_); } } } while (0)
typedef const __attribute__((address_space(4))) Args CArgs;
__device__ __forceinline__ CArgs& kargs() { CArgs* p = (CArgs*)__builtin_amdgcn_kernarg_segment_ptr(); asm volatile("" : "+s"(p)); return *p; }
__device__ __forceinline__ bool in_range(int k) { CArgs& a = kargs(); return a.ph_lo <= k && k < a.ph_hi; }
#define WSP(T_, off) ((T_*)(ws + (off)))
constexpr size_t PSTR = (size_t)T * D;

template <int L>
__device__ __forceinline__ void run_layer(unsigned char* lds, LAS unsigned char* ldsl, const int wave) {
    constexpr int pb = 1 + L * PH_PER_LAYER; constexpr int j = L >> 1; constexpr bool fox = (L & 1) == 0;
    const int G = gridDim.x, bid = blockIdx.x; const int gw = bid * NWAVES + wave, NGW = G * NWAVES;
    if (EN(1) && IN(pb + 0)) {
        CArgs& a = kargs(); unsigned char* ws = a.ws; const int lane = mk_lane();
        const float* modL = WSP(float, WS_MOD) + (size_t)L * NB * 6144;
        phase_norm1(L == 0 ? a.in[0] : a.out, a.out, WSP(bf16, WS_HN), a.in[13] + (size_t)L * D, modL, true, L > 0, WSP(bf16, WS_R1), WSP(int, WS_POS), WSP(float, WS_TOPW), modL - (size_t)NB * 6144, gw, NGW, lane);
        LAS float* scr = (LAS float*)(ldsl + RING_OFF + wave * 16384);
        for (int e = 0; e < NE; ++e) {
            convert_matrix(a.in[17] + ((size_t)L * NE + e) * D * 2048, 2048, D, 2048, WSP(bf16, WS_WGU) + (size_t)e * 2048 * D, MapGu(), scr, gw, NGW, lane);
            convert_matrix(a.in[19] + ((size_t)L * NE + e) * D * D, D, D, D, WSP(bf16, WS_WDN) + (size_t)e * D * D, MapIdent(), scr, gw, NGW, lane);
        }
        __syncthreads();
        SEAM(pb + 0);
    }
    if (EN(2) && IN(pb + 1)) {
        CArgs& a = kargs(); unsigned char* ws = a.ws;
        if constexpr (fox) { if (SUBEN(0)) {
            pg8::Gemm g{WSP(bf16, WS_HN), WSP(bf16, WS_WFI) + (size_t)j * NFOXP * D, T, NFOXP, D}; pg8::StaticOrder S; S.init(T, NFOXP, G, bid);
            pg8::EpiFox E{WSP(bf16, WS_R1), PSTR, WSP(float, WS_FL), a.in[4] + j * 64, a.in[5] + j * 64, a.in[3] + j * 16, attn_body::C2};
            pg8::gemm_phase<pg8::EpiFox, pg8::StaticOrder, true, true>(ldsl + RING_OFF, g, S, E, wave);
        } } else { if (SUBEN(1)) {
            pg8::Gemm g{WSP(bf16, WS_HN), WSP(bf16, WS_WHI) + (size_t)j * 4096 * D, T, 4096, D}; pg8::StaticOrder S; S.init(T, 4096, G, bid);
            pg8::EpiHgrn E{WSP(bf16, WS_R1), PSTR, WSP(float, WS_ACT), a.in[8], a.in[8] + D, j};
            pg8::gemm_phase<pg8::EpiHgrn, pg8::StaticOrder, true, true>(ldsl + RING_OFF, g, S, E, wave);
        } }
        SEAM(pb + 1);
    }
    if (EN(3) && IN(pb + 2)) {
        if constexpr (fox) { CArgs& a = kargs(); unsigned char* ws = a.ws; phase_cumsum(WSP(float, WS_FL), WSP(float, WS_BIAS), gw, NGW, mk_lane()); }
        SEAM(pb + 2);
    }
    if (EN(4) && IN(pb + 3)) {
        CArgs& a = kargs(); unsigned char* ws = a.ws; bf16* P0 = WSP(bf16, WS_R1); bf16* AO = WSP(bf16, WS_R1 + 512 * MiB);
        if constexpr (fox) { if (SUBEN(0)) {
            const attn_body::AttnTensors AT{(const attn_body::bf16*)P0, (const attn_body::bf16*)(P0 + PSTR), (const attn_body::bf16*)(P0 + 2 * PSTR), (attn_body::bf16*)AO, (const attn_body::bf16*)(P0 + 3 * PSTR), WSP(float, WS_BIAS)};
            const attn_body::StaticOrder S(G, bid);
            attn_body::attn_phase<attn_body::StaticOrder>((char*)lds + RING_OFF, AT, S, wave);
        } } else { if (SUBEN(1)) {
            const int lane = mk_lane();
            phase_hgrn(P0, WSP(float, WS_ACT), P0 + PSTR, P0 + 2 * PSTR, P0 + 3 * PSTR, AO, a.in[9] + j * 128, ldsl + RING_OFF, wave * 64 + lane, lane, wave, bid, G);
        } }
        SEAM(pb + 3);
    }
    if (EN(5) && IN(pb + 4)) {
        CArgs& a = kargs(); unsigned char* ws = a.ws;
        pg8::Gemm g{WSP(bf16, WS_R1 + 512 * MiB), WSP(bf16, fox ? WS_WFO : WS_WHO) + (size_t)j * D * D, T, D, D}; pg8::StaticOrder S; S.init(T, D, G, bid);
        pg8::EpiResid E{a.out, a.out, WSP(float, WS_MOD) + (size_t)L * NB * 6144 + 2048};
        pg8::gemm_phase<pg8::EpiResid, pg8::StaticOrder, true, true>(ldsl + RING_OFF, g, S, E, wave);
        SEAM(pb + 4);
    }
    if (EN(6) && IN(pb + 5)) {
        CArgs& a = kargs(); unsigned char* ws = a.ws; const int lane = mk_lane();
        phase_norm2_route(a.out, WSP(bf16, WS_HN), a.in[14] + (size_t)L * D, WSP(float, WS_MOD) + (size_t)L * NB * 6144, a.in[15] + (size_t)L * D * NE, a.in[16] + (size_t)L * NE,
                          WSP(int, WS_TOPI), WSP(float, WS_TOPW), WSP(int, WS_ROUTE) + RT_HIST, lds, wave * 64 + lane, lane, wave, bid, G);
        SEAM(pb + 5);
    }
    if (EN(7) && IN(pb + 6)) {
        CArgs& a = kargs(); unsigned char* ws = a.ws; const int lane = mk_lane();
        phase_scatter(WSP(bf16, WS_HN), WSP(bf16, WS_R1), WSP(int, WS_TOPI), WSP(int, WS_POS), WSP(int, WS_ROUTE) + RT_HIST, WSP(int, WS_ROUTE), lds, wave * 64 + lane, lane, wave, bid, G);
        SEAM(pb + 6);
    }
    if (EN(8) && IN(pb + 7)) {
        CArgs& a = kargs(); unsigned char* ws = a.ws;
        pg8::Gemm g{WSP(bf16, WS_R1), WSP(bf16, WS_WGU), TPAD, NE * 2048, D}; pg8::GroupedOrder S; S.init(WSP(int, WS_ROUTE) + RT_NTILES, WSP(int, WS_ROUTE) + RT_TEXP, 8, G, bid);
        pg8::EpiSwiglu E{WSP(bf16, WS_ACT), a.in[18] + (size_t)L * NE * 2048};
        pg8::gemm_phase<pg8::EpiSwiglu, pg8::GroupedOrder, true, true>(ldsl + RING_OFF, g, S, E, wave);
        SEAM(pb + 7);
    }
    if (EN(9) && IN(pb + 8)) {
        CArgs& a = kargs(); unsigned char* ws = a.ws;
        pg8::Gemm g{WSP(bf16, WS_ACT), WSP(bf16, WS_WDN), TPAD, NE * D, D}; pg8::GroupedOrder S; S.init(WSP(int, WS_ROUTE) + RT_NTILES, WSP(int, WS_ROUTE) + RT_TEXP, 4, G, bid);
        pg8::EpiDown E{WSP(bf16, WS_R1), a.in[20] + (size_t)L * NE * D};
        pg8::gemm_phase<pg8::EpiDown, pg8::GroupedOrder, true, true>(ldsl + RING_OFF, g, S, E, wave);
        SEAM(pb + 8);
    }
}

__global__ void __launch_bounds__(NWAVES * 64, 2) mega_fwd(Args args_unused) {
    extern __shared__ __attribute__((aligned(16))) unsigned char lds[];
    LAS unsigned char* ldsl = (LAS unsigned char*)lds;
    volatile LAS unsigned* MISC = (volatile LAS unsigned*)(ldsl + MISC_OFF);
    const int wave = __builtin_amdgcn_readfirstlane((int)threadIdx.x >> 6);
    const int G = gridDim.x, bid = blockIdx.x;
    for (int u = wave * 64 + mk_lane(); u < (LDS_BYTES - LDSCTL_OFF) / 4; u += NWAVES * 64) ((LAS unsigned*)(ldsl + LDSCTL_OFF))[u] = 0u;
    __syncthreads();
    if (!MK_PER_PHASE) { CArgs& a = kargs(); (void)xcd_barrier_post((unsigned*)(a.ws + WS_CTL) + CW_BAR, MISC + 8, wave); }

    if (EN(0) && IN(0)) {
        CArgs& a = kargs(); unsigned char* ws = a.ws; const int lane = mk_lane(); const int gw = bid * NWAVES + wave, NGW = G * NWAVES;
        phase_mod(a.in[1], a.in[11], a.in[12], WSP(float, WS_MOD), (float*)(lds + RING_OFF), wave * 64 + lane, bid, G);
        LAS float* scr = (LAS float*)(ldsl + RING_OFF + wave * 16384);
        for (int j = 0; j < 2; ++j) {
            convert_matrix(a.in[2] + (size_t)j * D * 4112, 4112, D, NFOXP, WSP(bf16, WS_WFI) + (size_t)j * NFOXP * D, MapFoxIn(), scr, gw, NGW, lane);
            convert_matrix(a.in[6] + (size_t)j * D * D, D, D, D, WSP(bf16, WS_WFO) + (size_t)j * D * D, MapIdent(), scr, gw, NGW, lane);
            convert_matrix(a.in[7] + (size_t)j * D * 4096, 4096, D, 4096, WSP(bf16, WS_WHI) + (size_t)j * 4096 * D, MapIdent(), scr, gw, NGW, lane);
            convert_matrix(a.in[10] + (size_t)j * D * D, D, D, D, WSP(bf16, WS_WHO) + (size_t)j * D * D, MapIdent(), scr, gw, NGW, lane);
        }
        __syncthreads();
        SEAM(0);
    }
    run_layer<0>(lds, ldsl, wave);
    run_layer<1>(lds, ldsl, wave);
    run_layer<2>(lds, ldsl, wave);
    run_layer<3>(lds, ldsl, wave);
    if (EN(10) && IN(N_PHASES - 1)) {
        CArgs& a = kargs(); unsigned char* ws = a.ws; const int gw = bid * NWAVES + wave, NGW = G * NWAVES;
        phase_norm1(a.out, a.out, WSP(bf16, WS_HN), a.in[13], WSP(float, WS_MOD), false, true, WSP(bf16, WS_R1), WSP(int, WS_POS), WSP(float, WS_TOPW), WSP(float, WS_MOD) + (size_t)(DEPTH - 1) * NB * 6144, gw, NGW, mk_lane());
    }
}

extern "C" void kernel_launch(void* const* d_in, const int* in_sizes, int n_in, void* d_out, int out_size, void* d_ws, size_t ws_size, hipStream_t stream) {
    static int grid = 0;
    if (grid == 0) {
        if (n_in != 21 || in_sizes[0] != T * D || out_size != T * D || ws_size < WS_END) { fprintf(stderr, "kernel_launch: unexpected shapes (n_in %d, in0 %d, out %d, ws %zu < %zu); nothing launched\n", n_in, n_in > 0 ? in_sizes[0] : -1, out_size, ws_size, (size_t)WS_END); grid = -1; return; }
        int dev = 0, cus = 0, per_cu = 0;
        if (hipGetDevice(&dev) != hipSuccess || hipDeviceGetAttribute(&cus, hipDeviceAttributeMultiprocessorCount, dev) != hipSuccess) { grid = -1; return; }
        if (hipFuncSetAttribute((const void*)mega_fwd, hipFuncAttributeMaxDynamicSharedMemorySize, LDS_BYTES) != hipSuccess) { fprintf(stderr, "kernel_launch: hipFuncSetAttribute failed\n"); grid = -1; return; }
        if (hipOccupancyMaxActiveBlocksPerMultiprocessor(&per_cu, (const void*)mega_fwd, NWAVES * 64, LDS_BYTES) != hipSuccess || per_cu < 1) { fprintf(stderr, "kernel_launch: occupancy query says %d blocks per CU\n", per_cu); }
        (void)hipGetLastError();
        grid = cus;
    }
    if (grid < 0) return;
    if (hipMemsetAsync((char*)d_ws + WS_CTL, 0, CTL_ZERO_BYTES, stream) != hipSuccess) return;
    Args a{};
    for (int i = 0; i < 21; ++i) a.in[i] = (const float*)d_in[i];
    a.out = (float*)d_out; a.ws = (unsigned char*)d_ws;
#if MK_PER_PHASE
    for (int p = 0; p < N_PHASES; ++p) { a.ph_lo = p; a.ph_hi = p + 1; hipLaunchKernelGGL(mega_fwd, dim3(grid), dim3(NWAVES * 64), LDS_BYTES, stream, a); }
#else
    a.ph_lo = 0; a.ph_hi = N_PHASES;
    hipLaunchKernelGGL(mega_fwd, dim3(grid), dim3(NWAVES * 64), LDS_BYTES, stream, a);
#endif
}
```

```cpp
#include <hip/hip_runtime.h>
#include <cstdio>
#include <cstdint>
__device__ __forceinline__ int mk_lane() { int l = (int)__builtin_amdgcn_mbcnt_hi(~0u, __builtin_amdgcn_mbcnt_lo(~0u, 0u)); asm volatile("" : "+v"(l)); return l; }
namespace pg8 {
#define PG8_LAS __attribute__((address_space(3)))
typedef unsigned short bf16_t;
typedef short bf16x8 __attribute__((ext_vector_type(8)));
typedef float f32x4 __attribute__((ext_vector_type(4)));
typedef unsigned u32x4 __attribute__((ext_vector_type(4)));
constexpr int BM = 256, BK = 64, HALF = 128, HTB = HALF * BK * 2  , STAGE_BYTES = 8 * HTB, NXCD = 8, WGM = 8;

__host__ __device__ __forceinline__ int lds_byte(int r, int c) { const int st = (r >> 4) * 2 + (c >> 5), rr = r & 15, cc = c & 31, ob = rr * 64 + cc * 2; return st * 1024 + (ob ^ (((ob >> 9) & 1) << 5)); }
__host__ __device__ __forceinline__ void stage_rc(int b, int& R, int& C) { const int st = b / 1024, sb = b % 1024, swz = sb ^ (((sb >> 9) & 1) << 5); R = (st >> 1) * 16 + swz / 64; C = (st & 1) * 32 + (swz % 64) / 2; }
__host__ __device__ __forceinline__ int perm32(int rho) { const int n = rho >> 4, i = rho & 15; return 8 * (i >> 2) + 4 * n + (i & 3); }

struct Unit { int pm, pn, pb, e; };
struct Gemm { const bf16_t* A; const bf16_t* Bt; int M, N, K; };

struct StaticOrder {
    static constexpr bool GATHER = false; const int* rowtok = nullptr;
    int nM, nN, nwg, G, c;
    __host__ __device__ void init(int M, int N, int G_, int c_) { nM = M / BM; nN = N / BM; nwg = nM * nN; G = G_; c = c_; }
    __host__ __device__ bool next(int i, Unit& u) const {
        const long L = (long)i * G + c; if (L >= nwg) return false;
        int wgid = (int)L; { const int q = nwg / NXCD, r = nwg % NXCD, xcd = wgid % NXCD, off = wgid / NXCD; wgid = (xcd < r ? xcd * (q + 1) : r * (q + 1) + (xcd - r) * q) + off; }
        const int nig = WGM * nN, gid = wgid / nig, fm = gid * WGM, gsz = (nM - fm) < WGM ? (nM - fm) : WGM;
        u.pm = fm + ((wgid % nig) % gsz); u.pn = (wgid % nig) / gsz; u.pb = u.pn; u.e = 0; return true;
    }
    struct Raw {};
    __device__ __forceinline__ void prefetch(int, Raw&) const {}
    __device__ __forceinline__ bool finish(int i, const Raw&, Unit& u) const { return next(i, u); }
    __device__ __forceinline__ int tile_of(int) const { return -1; }
    __device__ __forceinline__ void a_ready(const Unit&) const {}
    __device__ __forceinline__ void done(const Unit&) const {}
};

__device__ __forceinline__ unsigned cvt_pk_bf16(float lo, float hi) { unsigned r; asm volatile("v_cvt_pk_bf16_f32 %0, %1, %2" : "=v"(r) : "v"(lo), "v"(hi)); return r; }
typedef int i32x4 __attribute__((ext_vector_type(4)));
typedef int i32x8 __attribute__((ext_vector_type(8)));
typedef unsigned u32x2 __attribute__((ext_vector_type(2)));
__device__ __forceinline__ unsigned pk_fp8x4(float a, float b, float c, float d) { int w = 0; w = __builtin_amdgcn_cvt_pk_fp8_f32(a, b, w, false); w = __builtin_amdgcn_cvt_pk_fp8_f32(c, d, w, true); return (unsigned)w; }
template <bool I8> struct AccSel { typedef f32x4 type; }; template <> struct AccSel<true> { typedef i32x4 type; };
template <bool I8, class AccV> __device__ __forceinline__ f32x4 acc_val(const AccV& a, const f32x4& cs, float rs) { if constexpr (I8) return (f32x4){(float)a[0], (float)a[1], (float)a[2], (float)a[3]} * (cs * rs); else return a; }
__device__ __forceinline__ float sigm(float x) { return __builtin_amdgcn_rcpf(1.0f + __expf(-x)); }
__device__ __forceinline__ f32x4 exp2_4(const f32x4 v) { return (f32x4){__builtin_amdgcn_exp2f(v[0]), __builtin_amdgcn_exp2f(v[1]), __builtin_amdgcn_exp2f(v[2]), __builtin_amdgcn_exp2f(v[3])}; }
__device__ __forceinline__ f32x4 rcp_4(const f32x4 v) { return (f32x4){__builtin_amdgcn_rcpf(v[0]), __builtin_amdgcn_rcpf(v[1]), __builtin_amdgcn_rcpf(v[2]), __builtin_amdgcn_rcpf(v[3])}; }
__device__ __forceinline__ f32x4 log2_4(const f32x4 v) { return (f32x4){__builtin_amdgcn_logf(v[0]), __builtin_amdgcn_logf(v[1]), __builtin_amdgcn_logf(v[2]), __builtin_amdgcn_logf(v[3])}; }
__device__ __forceinline__ f32x4 sigm4(const f32x4 v) { return rcp_4(exp2_4(v * -1.4426950408889634f) + 1.0f); }
__device__ __forceinline__ u32x4 pack8(const f32x4 v0, const f32x4 v1) { u32x4 w; w.x = cvt_pk_bf16(v0[0], v0[1]); w.y = cvt_pk_bf16(v0[2], v0[3]); w.z = cvt_pk_bf16(v1[0], v1[1]); w.w = cvt_pk_bf16(v1[2], v1[3]); return w; }

template <bool I8> struct EpiFoxT {
    static constexpr bool PERM = true, AFTER_DRAIN = false, DRAIN_AFTER = true;        typedef typename AccSel<I8>::type AccV;
    bf16_t* P; size_t pstride; float* FL; const float* qw; const float* kw; const float* bfv; float qscale; const float* sa; const float* sw;
    __device__ __forceinline__ void operator()(const AccV (&acc)[2][2][4][2], const Unit& u, int wr, int wc, int fr_in, int fq_in) const {
        int fr = fr_in, fq = fq_in; asm volatile("" : "+v"(fr), "+v"(fq));
        typedef const __attribute__((address_space(1))) float GF; typedef const __attribute__((address_space(1))) f32x4 GF4;
        GF* sa = (GF*)this->sa; GF* sw = (GF*)this->sw; GF* qw = (GF*)this->qw; GF* kw = (GF*)this->kw; GF* bfv = (GF*)this->bfv; asm volatile("" : "+s"(sa), "+s"(sw), "+s"(qw), "+s"(kw), "+s"(bfv));
        const int type = u.pn >> 2; const int row0 = u.pm * BM + wr * 64 + fr;
        float srow[2][4]; f32x4 swv[2][2];
        if (type == 4) {
            if (wc == 0) {
                const int fqc = fq & 1;
#pragma unroll
                for (int ai = 0; ai < 2; ++ai)
#pragma unroll
                    for (int m = 0; m < 4; ++m) srow[ai][m] = I8 ? sa[row0 + ai * HALF + m * 16] : 1.0f;
                const f32x4 one4 = (f32x4){1.f, 1.f, 1.f, 1.f};
                const f32x4 s0 = I8 ? *(GF4*)(sw + 4096 + 8 * fqc) : one4, s1 = I8 ? *(GF4*)(sw + 4096 + 8 * fqc + 4) : one4;
                const f32x4 b0 = *(GF4*)(bfv + 8 * fqc), b1 = *(GF4*)(bfv + 8 * fqc + 4);
#pragma unroll
                for (int ai = 0; ai < 2; ++ai)
#pragma unroll
                    for (int m = 0; m < 4; ++m) { const size_t row = (size_t)(row0 + ai * HALF + m * 16);
                        f32x4 v0 = acc_val<I8>(acc[ai][0][m][0], s0, srow[ai][m]) + b0, v1 = acc_val<I8>(acc[ai][0][m][1], s1, srow[ai][m]) + b1;
#pragma unroll
                        for (int i = 0; i < 4; ++i) { { const float z = v0[i]; v0[i] = (fminf(z, 0.f) - __logf(1.0f + __expf(-fabsf(z)))) * 1.4426950408889634f; }
                                                      { const float z = v1[i]; v1[i] = (fminf(z, 0.f) - __logf(1.0f + __expf(-fabsf(z)))) * 1.4426950408889634f; } }
                        if (fq < 2) { *(f32x4*)(FL + row * 16 + 8 * fq) = v0; *(f32x4*)(FL + row * 16 + 8 * fq + 4) = v1; } }
            }
            return;
        }
#pragma unroll
        for (int ai = 0; ai < 2; ++ai)
#pragma unroll
            for (int m = 0; m < 4; ++m) srow[ai][m] = I8 ? sa[row0 + ai * HALF + m * 16] : 1.0f;
        { const int sc0 = 256 * u.pn + 64 * wc + 8 * fq;
#pragma unroll
          for (int bj = 0; bj < 2; ++bj)
#pragma unroll
              for (int n = 0; n < 2; ++n) swv[bj][n] = I8 ? *(GF4*)(sw + sc0 + 32 * bj + 4 * n) : (f32x4){1.f, 1.f, 1.f, 1.f}; }
#define PG8_V(ai, bj, m, n) acc_val<I8>(acc[ai][bj][m][n], swv[bj][n], srow[ai][m])
        bf16_t* base = P + (size_t)type * pstride;
        const int colh = (u.pn & 3) * 256 + 64 * wc + 8 * fq;
        if (type < 2) {
            GF* w = (type == 0) ? qw : kw; const float sc = (type == 0) ? qscale : 1.0f;
            f32x4 wv[2][2];
#pragma unroll
            for (int bj = 0; bj < 2; ++bj)
#pragma unroll
                for (int n = 0; n < 2; ++n) wv[bj][n] = *(GF4*)(w + 32 * bj + 8 * fq + 4 * n) * sc;
#pragma unroll
            for (int ai = 0; ai < 2; ++ai)
#pragma unroll
                for (int m = 0; m < 4; ++m) {
                    float ss = 0.f;
#pragma unroll
                    for (int bj = 0; bj < 2; ++bj)
#pragma unroll
                        for (int n = 0; n < 2; ++n) { const f32x4 x = PG8_V(ai, bj, m, n); ss += (x[0] * x[0] + x[1] * x[1]) + (x[2] * x[2] + x[3] * x[3]); }
                    ss += __shfl_xor(ss, 16); ss += __shfl_xor(ss, 32);
                    const float rs = __builtin_amdgcn_rsqf(ss * (1.0f / 64.0f) + 1e-6f);
                    bf16_t* rowp = base + (size_t)(row0 + ai * HALF + m * 16) * 1024 + colh;
#pragma unroll
                    for (int bj = 0; bj < 2; ++bj) { const f32x4 v0 = PG8_V(ai, bj, m, 0) * rs * wv[bj][0], v1 = PG8_V(ai, bj, m, 1) * rs * wv[bj][1]; *(u32x4*)(rowp + 32 * bj) = pack8(v0, v1); }
                    __builtin_amdgcn_sched_barrier(0);
                }
        } else {
#pragma unroll
            for (int ai = 0; ai < 2; ++ai)
#pragma unroll
                for (int m = 0; m < 4; ++m) { bf16_t* rowp = base + (size_t)(row0 + ai * HALF + m * 16) * 1024 + colh;
#pragma unroll
                    for (int bj = 0; bj < 2; ++bj) { f32x4 v0 = PG8_V(ai, bj, m, 0), v1 = PG8_V(ai, bj, m, 1);
                        if (type == 3) { v0 = sigm4(v0); v1 = sigm4(v1); }
                        *(u32x4*)(rowp + 32 * bj) = pack8(v0, v1); } __builtin_amdgcn_sched_barrier(0); }
        }
    }
};
#undef PG8_V

template <bool I8> struct EpiHgrnT {
    static constexpr bool PERM = true, AFTER_DRAIN = false, DRAIN_AFTER = true; typedef typename AccSel<I8>::type AccV;
    bf16_t* P; size_t pstride; float* LF; const float* lb0; const float* lb1; int jh; const float* sa; const float* sw;
    __device__ __forceinline__ void operator()(const AccV (&acc)[2][2][4][2], const Unit& u, int wr, int wc, int fr_in, int fq_in) const {
        int fr = fr_in, fq = fq_in; asm volatile("" : "+v"(fr), "+v"(fq));
        typedef const __attribute__((address_space(1))) float GF; typedef const __attribute__((address_space(1))) f32x4 GF4;
        GF* sa = (GF*)this->sa; GF* sw = (GF*)this->sw; GF* lb0 = (GF*)this->lb0; GF* lb1 = (GF*)this->lb1; asm volatile("" : "+s"(sa), "+s"(sw), "+s"(lb0), "+s"(lb1));
        const int type = u.pn >> 2; const int row0 = u.pm * BM + wr * 64 + fr;
        const int col0 = (u.pn & 3) * 256 + wc * 32 + 8 * fq;
        float srow[2][4]; f32x4 swv[2][2];
#pragma unroll
        for (int ai = 0; ai < 2; ++ai)
#pragma unroll
            for (int m = 0; m < 4; ++m) srow[ai][m] = I8 ? sa[row0 + ai * HALF + m * 16] : 1.0f;
#pragma unroll
        for (int bj = 0; bj < 2; ++bj)
#pragma unroll
            for (int n = 0; n < 2; ++n) swv[bj][n] = I8 ? *(GF4*)(sw + u.pn * 256 + wc * 32 + 8 * fq + bj * HALF + 4 * n) : (f32x4){1.f, 1.f, 1.f, 1.f};
#define PG8_V(ai, bj, m, n) acc_val<I8>(acc[ai][bj][m][n], swv[bj][n], srow[ai][m])
        bf16_t* base = P + (size_t)type * pstride;
        if (type == 1) {
            f32x4 lbv[2][2];
#pragma unroll
            for (int bj = 0; bj < 2; ++bj)
#pragma unroll
                for (int n = 0; n < 2; ++n) { f32x4 l = (f32x4){0.f, 0.f, 0.f, 0.f};
                    if (jh != 0) { const f32x4 a = *(GF4*)(lb0 + col0 + bj * HALF + 4 * n), b = *(GF4*)(lb1 + col0 + bj * HALF + 4 * n);
#pragma unroll
                        for (int i = 0; i < 4; ++i) l[i] = __builtin_amdgcn_rcpf(1.0f + __expf(a[i] - b[i])); }
                    lbv[bj][n] = l; }
#pragma unroll
            for (int ai = 0; ai < 2; ++ai)
#pragma unroll
                for (int m = 0; m < 4; ++m) { const size_t off = (size_t)(row0 + ai * HALF + m * 16) * 1024 + col0;
#pragma unroll
                    for (int bj = 0; bj < 2; ++bj) { f32x4 lf[2], kk[2];
#pragma unroll
                        for (int n = 0; n < 2; ++n) { f32x4 x = PG8_V(ai, bj, m, n);
#pragma unroll
                            for (int i = 0; i < 4; ++i) x[i] = __builtin_amdgcn_fmed3f(x[i], -80.0f, 80.0f);
                            const f32x4 lb = lbv[bj][n], om = 1.0f - lb, ex = exp2_4(x * -1.4426950408889634f), sg = rcp_4(ex + 1.0f);
                            lf[n] = log2_4(om * sg + lb); kk[n] = om * (ex * sg); }
                        *(f32x4*)(LF + off + bj * HALF) = lf[0]; *(f32x4*)(LF + off + bj * HALF + 4) = lf[1];
                        *(u32x4*)(base + off + bj * HALF) = pack8(kk[0], kk[1]); } }
        } else {
#pragma unroll
            for (int ai = 0; ai < 2; ++ai)
#pragma unroll
                for (int m = 0; m < 4; ++m) { bf16_t* rowp = base + (size_t)(row0 + ai * HALF + m * 16) * 1024 + col0;
#pragma unroll
                    for (int bj = 0; bj < 2; ++bj) { f32x4 v0 = PG8_V(ai, bj, m, 0), v1 = PG8_V(ai, bj, m, 1);
                        if (type != 2) { v0 = v0 * sigm4(v0); v1 = v1 * sigm4(v1); }
                        *(u32x4*)(rowp + bj * HALF) = pack8(v0, v1); } }
        }
    }
};
#undef PG8_V

__device__ __forceinline__ f32x4 bf4_lo(const u32x4 w) { return (f32x4){__builtin_bit_cast(float, w.x << 16), __builtin_bit_cast(float, w.x & 0xffff0000u), __builtin_bit_cast(float, w.y << 16), __builtin_bit_cast(float, w.y & 0xffff0000u)}; }
__device__ __forceinline__ f32x4 bf4_hi(const u32x4 w) { return (f32x4){__builtin_bit_cast(float, w.z << 16), __builtin_bit_cast(float, w.z & 0xffff0000u), __builtin_bit_cast(float, w.w << 16), __builtin_bit_cast(float, w.w & 0xffff0000u)}; }
template <bool BASEF32> struct EpiResidT {
    static constexpr bool PERM = true, AFTER_DRAIN = false, DRAIN_AFTER = true;
    const float* basef; const bf16_t* baseh; bf16_t* out; const float* gate; float osc;
    __device__ __forceinline__ void operator()(const f32x4 (&acc)[2][2][4][2], const Unit& u, int wr, int wc, int fr, int fq) const {
        const int row0 = u.pm * BM + wr * 64 + fr; const int col0 = u.pn * BM + wc * 32 + 8 * fq;
        const float* gp = gate + (size_t)(u.pm >> 3) * 6144 + col0;
        f32x4 gv[2][2];
#pragma unroll
        for (int bj = 0; bj < 2; ++bj)
#pragma unroll
            for (int n = 0; n < 2; ++n) gv[bj][n] = *(const f32x4*)(gp + bj * HALF + 4 * n) * osc;
#pragma unroll
        for (int ai = 0; ai < 2; ++ai)
#pragma unroll
            for (int m = 0; m < 4; ++m) { const size_t off = (size_t)(row0 + ai * HALF + m * 16) * 1024 + col0;
#pragma unroll
                for (int bj = 0; bj < 2; ++bj) { f32x4 b0, b1;
                    if constexpr (BASEF32) { b0 = *(const f32x4*)(basef + off + bj * HALF); b1 = *(const f32x4*)(basef + off + bj * HALF + 4); }
                    else { const u32x4 w = *(const u32x4*)(baseh + off + bj * HALF); b0 = bf4_lo(w); b1 = bf4_hi(w); }
                    *(u32x4*)(out + off + bj * HALF) = pack8(b0 + gv[bj][0] * acc[ai][bj][m][0], b1 + gv[bj][1] * acc[ai][bj][m][1]); } }
    }
};

struct EpiSwiglu {
    static constexpr bool PERM = true, AFTER_DRAIN = false, DRAIN_AFTER = true;
    bf16_t* ACT; const float* bgu;
    __device__ __forceinline__ void operator()(const f32x4 (&acc)[2][2][4][2], const Unit& u, int wr, int wc, int fr, int fq) const {
        const int row0 = u.pm * BM + wr * 64 + fr; const int a0 = u.pn * 128 + wc * 32 + 8 * fq;
        const float* bp = bgu + (size_t)u.e * 2048 + 2 * a0;
        f32x4 bv[4];
#pragma unroll
        for (int q = 0; q < 4; ++q) bv[q] = *(const f32x4*)(bp + 4 * q);
#pragma unroll
        for (int ai = 0; ai < 2; ++ai)
#pragma unroll
            for (int m = 0; m < 4; ++m) { f32x4 o[2];
#pragma unroll
                for (int n = 0; n < 2; ++n)
#pragma unroll
                    for (int i = 0; i < 4; ++i) { const int ip = 4 * n + i; float g = acc[ai][0][m][n][i] + bv[ip >> 1][(ip & 1) * 2], up = acc[ai][1][m][n][i] + bv[ip >> 1][(ip & 1) * 2 + 1];
                        g = fminf(g, 7.0f); up = fminf(fmaxf(up, -7.0f), 7.0f); o[n][i] = (up + 1.0f) * g * sigm(1.702f * g); }
                *(u32x4*)(ACT + (size_t)(row0 + ai * HALF + m * 16) * 1024 + a0) = pack8(o[0], o[1]); }
    }
};

struct EpiSwigluI8 {
    static constexpr bool PERM = true, AFTER_DRAIN = false, DRAIN_AFTER = false;
    unsigned char* ACT; const float* bgu; const float* swgu; const float* sarow;
    typedef float f32x2 __attribute__((ext_vector_type(2)));
    __device__ __forceinline__ void operator()(const i32x4 (&acc)[2][2][4][2], const Unit& u, int wr, int wc, int fr, int fq) const {
        const int row0 = u.pm * BM + wr * 64 + fr; const int a0 = u.pn * 128 + wc * 32 + 8 * fq;
        const float* bp = bgu + (size_t)u.e * 2048 + 2 * a0; const float* sp = swgu + (size_t)u.e * 2048 + 2 * a0;
        f32x4 bv[4], sv[4];
#pragma unroll
        for (int q = 0; q < 4; ++q) { bv[q] = *(const f32x4*)(bp + 4 * q); sv[q] = *(const f32x4*)(sp + 4 * q); }
        const f32x2 one2 = (f32x2){1.0f, 1.0f}, kz2 = (f32x2){-1.702f * 1.4426950408889634f, -1.702f * 1.4426950408889634f};
#pragma unroll
        for (int ai = 0; ai < 2; ++ai)
#pragma unroll
            for (int m = 0; m < 4; ++m) { const int row = row0 + ai * HALF + m * 16; const float sr = sarow[row]; const f32x2 sr2 = (f32x2){sr, sr}; float o[8];
#pragma unroll
                for (int pp = 0; pp < 4; ++pp) {
                    const int n = pp >> 1, i0 = (2 * pp) & 3;
                    const f32x2 gu0 = (f32x2){(float)acc[ai][0][m][n][i0], (float)acc[ai][1][m][n][i0]} * ((f32x2){sv[pp][0], sv[pp][1]} * sr2) + (f32x2){bv[pp][0], bv[pp][1]};
                    const f32x2 gu1 = (f32x2){(float)acc[ai][0][m][n][i0 + 1], (float)acc[ai][1][m][n][i0 + 1]} * ((f32x2){sv[pp][2], sv[pp][3]} * sr2) + (f32x2){bv[pp][2], bv[pp][3]};
                    const f32x2 g2 = (f32x2){fminf(gu0[0], 7.0f), fminf(gu1[0], 7.0f)};
                    const f32x2 u2 = (f32x2){__builtin_amdgcn_fmed3f(gu0[1], -7.0f, 7.0f), __builtin_amdgcn_fmed3f(gu1[1], -7.0f, 7.0f)} + one2;
                    const f32x2 z2 = g2 * kz2;
                    const f32x2 d2 = (f32x2){__builtin_amdgcn_exp2f(z2[0]), __builtin_amdgcn_exp2f(z2[1])} + one2;
                    const f32x2 r2 = (u2 * g2) * (f32x2){__builtin_amdgcn_rcpf(d2[0]), __builtin_amdgcn_rcpf(d2[1])};
                    o[2 * pp] = r2[0]; o[2 * pp + 1] = r2[1]; }
                *(u32x2*)(ACT + (size_t)row * 1024 + a0) = (u32x2){pk_fp8x4(o[0], o[1], o[2], o[3]), pk_fp8x4(o[4], o[5], o[6], o[7])}; __builtin_amdgcn_sched_barrier(0); }
    }
};

struct EpiDown {
    static constexpr bool PERM = true, AFTER_DRAIN = false, DRAIN_AFTER = false;
    unsigned char* Y; const float* bd; float wsc;
    __device__ __forceinline__ void operator()(const f32x4 (&acc)[2][2][4][2], const Unit& u, int wr, int wc, int fr, int fq) const {
        const int row0 = u.pm * BM + wr * 64 + fr; const int col0 = u.pn * BM + wc * 32 + 8 * fq;
        const float* bp = bd + (size_t)u.e * 1024 + col0;
        f32x4 bv[2][2];
#pragma unroll
        for (int bj = 0; bj < 2; ++bj)
#pragma unroll
            for (int n = 0; n < 2; ++n) bv[bj][n] = *(const f32x4*)(bp + bj * HALF + 4 * n);
#pragma unroll
        for (int ai = 0; ai < 2; ++ai)
#pragma unroll
            for (int m = 0; m < 4; ++m) { unsigned char* rowp = Y + (size_t)(row0 + ai * HALF + m * 16) * 1024 + col0;
#pragma unroll
                for (int bj = 0; bj < 2; ++bj) { f32x4 y0 = acc[ai][bj][m][0] * wsc + bv[bj][0], y1 = acc[ai][bj][m][1] * wsc + bv[bj][1];
#pragma unroll
                    for (int i = 0; i < 4; ++i) { y0[i] = __builtin_amdgcn_fmed3f(y0[i], -448.0f, 448.0f); y1[i] = __builtin_amdgcn_fmed3f(y1[i], -448.0f, 448.0f); }
                    *(u32x2*)(rowp + bj * HALF) = (u32x2){pk_fp8x4(y0[0], y0[1], y0[2], y0[3]), pk_fp8x4(y1[0], y1[1], y1[2], y1[3])}; } }
    }
};

template <bool GATHER_> struct GroupedOrderT {
    static constexpr bool GATHER = GATHER_; const int* rowtok;
    const int* texp; int nunits, nn, G, v;
    __device__ void init(const int* ntiles_p, const int* texp_, int nn_, int G_, int c_, const int* rowtok_ = nullptr) { texp = texp_; rowtok = rowtok_; nn = nn_; G = G_; v = (G_ % 8 == 0) ? (c_ % 8) * (G_ / 8) + c_ / 8 : c_;
        nunits = __builtin_amdgcn_readfirstlane(*ntiles_p) * nn_; }
    __device__ bool next(int i, Unit& u) const {
        const int U = i * G + v; if (U >= nunits) return false;
        const int tile = U / nn, pn = U - tile * nn; const int e = __builtin_amdgcn_readfirstlane(texp[tile]);
        u.pm = tile; u.pn = pn; u.e = e; u.pb = e * nn + pn; return true;
    }
    struct Raw { int te; };
    __device__ __forceinline__ int tile_of(int i) const { const int U = i * G + v; return U < nunits ? U / nn : -1; }
    __device__ __forceinline__ void prefetch(int i, Raw& r) const { const int t = tile_of(i); r.te = texp[t < 0 ? 0 : t]; }
    __device__ __forceinline__ bool finish(int i, const Raw& r, Unit& u) const {
        const int U = i * G + v; if (U >= nunits) return false;
        const int tile = U / nn, pn = U - tile * nn; const int e = __builtin_amdgcn_readfirstlane(r.te);
        u.pm = tile; u.pn = pn; u.e = e; u.pb = e * nn + pn; return true;
    }
    __device__ __forceinline__ void a_ready(const Unit&) const {}
    __device__ __forceinline__ void done(const Unit&) const {}
};
template <class Epi, class Sched, bool ALIGN_EPI = false, bool SP2 = false, bool I8 = false, bool F8 = false>
__device__ __forceinline__ void gemm_phase(PG8_LAS unsigned char* lds, const Gemm g, const Sched& S, const Epi& E, const int mk_wave) {
    const int lane = mk_lane(), wid = mk_wave, tid = wid * 64 + lane, wr = wid >> 2, wc = wid & 3, fr = lane & 15, fq = lane >> 4;
    const int K = g.K, nt = K / BK;
    unsigned voffA[2], voffB[2]; int gR[2], gC[2];
#pragma unroll
    for (int i = 0; i < 2; ++i) { int R, C; stage_rc(tid * 16 + i * 8192, R, C); const int Rb = Epi::PERM ? ((R & ~31) + perm32(R & 31)) : R;
        voffA[i] = (unsigned)(R * K + C) * 2u; voffB[i] = (unsigned)(Rb * K + C) * 2u; gR[i] = R; gC[i] = C; }
    constexpr bool GATHER = Sched::GATHER;
    unsigned vgC[2][2], vgN[2][2];
#define PG8_GOFF(dst, u) do { if constexpr (GATHER) { _Pragma("unroll") for (int _h = 0; _h < 2; ++_h) _Pragma("unroll") for (int _i = 0; _i < 2; ++_i) \
        dst[_h][_i] = (unsigned)S.rowtok[(u).pm * BM + _h * HALF + gR[_i]] * (unsigned)(K * 2) + (unsigned)(gC[_i] * 2); } } while (0)
    const size_t kstep = (size_t)(BK * 2);
    const size_t hstep = (size_t)HALF * K * 2;
    const size_t tstep = 2 * hstep;
    const unsigned ldsw = (unsigned)wid * 1024u;
    const int aoff = lds_byte(wr * 64 + fr, fq * 8), boff = lds_byte(wc * 32 + fr, fq * 8);
#define PG8_SA(b, h) (((b) * 2 + (h)) * HTB)
#define PG8_SB(b, h) ((4 + (b) * 2 + (h)) * HTB)
#define PG8_STAGE(bufoff, gbase, voff) do { _Pragma("unroll") for (int _i = 0; _i < 2; ++_i) \
        __builtin_amdgcn_global_load_lds((const unsigned*)((const char*)(gbase) + (voff)[_i]), (PG8_LAS unsigned*)(lds + (bufoff) + ldsw + _i * 8192), 16, 0, 0); } while (0)
#define PG8_STAGEA(bufoff, ptr, h, sel) do { if constexpr (GATHER) { _Pragma("unroll") for (int _i = 0; _i < 2; ++_i) \
        __builtin_amdgcn_global_load_lds((const unsigned*)((const char*)(ptr) + ((sel) ? vgN[h][_i] : vgC[h][_i])), (PG8_LAS unsigned*)(lds + (bufoff) + ldsw + _i * 8192), 16, 0, 0); } \
    else { PG8_STAGE(bufoff, (ptr) + (h) * hstep, voffA); } } while (0)
#define PG8_LDF8(dst8, idx_, off) do { const bf16x8 l0_ = *(const PG8_LAS bf16x8*)(lds + (off)), l1_ = *(const PG8_LAS bf16x8*)(lds + (off) + 1024); \
        (dst8)[idx_] = __builtin_shufflevector(__builtin_bit_cast(i32x4, l0_), __builtin_bit_cast(i32x4, l1_), 0, 1, 2, 3, 4, 5, 6, 7); } while (0)
#define PG8_LDA(dst, b, h) do { if constexpr (F8) { _Pragma("unroll") for (int m = 0; m < 4; ++m) PG8_LDF8(dst##8, m, PG8_SA(b, h) + aoff + m * 2048); } \
        else { _Pragma("unroll") for (int m = 0; m < 4; ++m) _Pragma("unroll") for (int k = 0; k < 2; ++k) dst[m][k] = *(const PG8_LAS bf16x8*)(lds + PG8_SA(b, h) + aoff + m * 2048 + k * 1024); } } while (0)
#define PG8_LDB(dst, b, h) do { if constexpr (F8) { _Pragma("unroll") for (int n = 0; n < 2; ++n) PG8_LDF8(dst##8, n, PG8_SB(b, h) + boff + n * 2048); } \
        else { _Pragma("unroll") for (int n = 0; n < 2; ++n) _Pragma("unroll") for (int k = 0; k < 2; ++k) dst[n][k] = *(const PG8_LAS bf16x8*)(lds + PG8_SB(b, h) + boff + n * 2048 + k * 1024); } } while (0)
#define PG8_MMA(ai, bj, At, Bt) do { __builtin_amdgcn_s_setprio(1); \
        if constexpr (F8) { _Pragma("unroll") for (int m = 0; m < 4; ++m) _Pragma("unroll") for (int n = 0; n < 2; ++n) \
            asm("v_mfma_scale_f32_16x16x128_f8f6f4 %0, %1, %2, %0, %3, %3 op_sel_hi:[0,0,0]" : "+v"(acc[ai][bj][m][n]) : "v"(Bt##8[n]), "v"(At##8[m]), "v"(f8sc_)); } \
        else { _Pragma("unroll") for (int m = 0; m < 4; ++m) _Pragma("unroll") for (int n = 0; n < 2; ++n) _Pragma("unroll") for (int k = 0; k < 2; ++k) \
        { if constexpr (I8) acc[ai][bj][m][n] = __builtin_amdgcn_mfma_i32_16x16x64_i8(__builtin_bit_cast(i32x4, Bt[n][k]), __builtin_bit_cast(i32x4, At[m][k]), acc[ai][bj][m][n], 0, 0, 0); \
          else acc[ai][bj][m][n] = __builtin_amdgcn_mfma_f32_16x16x32_bf16(Bt[n][k], At[m][k], acc[ai][bj][m][n], 0, 0, 0); } } __builtin_amdgcn_s_setprio(0); } while (0)
#define PG8_WAIT_V(n) asm volatile("s_waitcnt vmcnt(" #n ")" ::: "memory")
#define PG8_WAIT_L(n) asm volatile("s_waitcnt lgkmcnt(" #n ")" ::: "memory")
#define PG8_BAR __builtin_amdgcn_s_barrier()
#define PG8_SCHED __builtin_amdgcn_sched_barrier(0)
    Unit cur, nxt; int ui = 0;
    if (!S.next(0, cur)) return;
    typedef typename AccSel<I8>::type AccV; AccV acc[2][2][4][2];
#pragma unroll
    for (int a = 0; a < 2; ++a)
#pragma unroll
        for (int b = 0; b < 2; ++b)
#pragma unroll
            for (int m = 0; m < 4; ++m)
#pragma unroll
                for (int n = 0; n < 2; ++n) acc[a][b][m][n] = (AccV){0, 0, 0, 0};
    bf16x8 At[4][2], B0[2][2], B1[2][2]; i32x8 At8[4], B08[2], B18[2];
    int f8sc_ = 127; asm volatile("" : "+v"(f8sc_));
    const char* cA = (const char*)g.A + (GATHER ? (size_t)0 : (size_t)cur.pm * tstep); PG8_GOFF(vgC, cur); const char* cB = (const char*)g.Bt + (size_t)cur.pb * tstep;
    typename Sched::Raw raw; unsigned rawrt[2][2];
#define PG8_GRAW(i_) do { S.prefetch((i_), raw); if constexpr (GATHER) { int tl_ = S.tile_of(i_); tl_ = tl_ < 0 ? 0 : tl_; _Pragma("unroll") for (int _h = 0; _h < 2; ++_h) _Pragma("unroll") for (int _i = 0; _i < 2; ++_i) \
        rawrt[_h][_i] = (unsigned)S.rowtok[tl_ * BM + _h * HALF + gR[_i]]; } } while (0)
    PG8_GRAW(1);
    S.a_ready(cur);
    if constexpr (SP2) {
        PG8_STAGE(PG8_SB(0, 0), cB, voffB); PG8_STAGE(PG8_SB(0, 1), cB + hstep, voffB); PG8_STAGEA(PG8_SA(0, 0), cA, 0, false); PG8_STAGEA(PG8_SA(0, 1), cA, 1, false);
        if (wr == 1) PG8_BAR;
        PG8_WAIT_V(2); PG8_BAR;
        PG8_STAGE(PG8_SB(1, 0), cB + kstep, voffB); PG8_STAGEA(PG8_SA(1, 0), cA + kstep, 0, false); PG8_STAGE(PG8_SB(1, 1), cB + hstep + kstep, voffB);
        PG8_WAIT_V(6); PG8_BAR;
    } else {
        PG8_STAGE(PG8_SB(0, 0), cB, voffB); PG8_STAGEA(PG8_SA(0, 0), cA, 0, false); PG8_STAGE(PG8_SB(0, 1), cB + hstep, voffB); PG8_STAGEA(PG8_SA(0, 1), cA, 1, false);
        if (wr == 1) PG8_BAR;
        PG8_WAIT_V(4); PG8_BAR;
        PG8_STAGE(PG8_SB(1, 0), cB + kstep, voffB); PG8_STAGEA(PG8_SA(1, 0), cA + kstep, 0, false); PG8_STAGE(PG8_SB(1, 1), cB + hstep + kstep, voffB);
        PG8_WAIT_V(6); PG8_BAR;
    }
    for (;;) {
        const bool has_next = S.finish(ui + 1, raw, nxt);
        const char* nA = has_next ? (const char*)g.A + (GATHER ? (size_t)0 : (size_t)nxt.pm * tstep) : cA;
        if constexpr (GATHER) { if (has_next) { _Pragma("unroll") for (int _h = 0; _h < 2; ++_h) _Pragma("unroll") for (int _i = 0; _i < 2; ++_i) vgN[_h][_i] = rawrt[_h][_i] * (unsigned)(K * 2) + (unsigned)(gC[_i] * 2); } else { _Pragma("unroll") for (int _h = 0; _h < 2; ++_h) _Pragma("unroll") for (int _i = 0; _i < 2; ++_i) vgN[_h][_i] = vgC[_h][_i]; } }
        const char* nB = has_next ? (const char*)g.Bt + (size_t)nxt.pb * tstep : cB;
        for (int t = 0; t < nt; t += 2) {
            const bool last = (t == nt - 2);
            const char* a1 = cA + (size_t)(t + 1) * kstep;
            const char* a2 = last ? nA : cA + (size_t)(t + 2) * kstep; const char* b2 = last ? nB : cB + (size_t)(t + 2) * kstep;
            const char* a3 = a2 + kstep; const char* b3 = b2 + kstep;
            if (last && has_next) S.a_ready(nxt);
            if constexpr (SP2) {
            PG8_LDB(B0, 0, 0); PG8_LDB(B1, 0, 1); PG8_SCHED; PG8_LDA(At, 0, 0); PG8_STAGEA(PG8_SA(1, 1), a1, 1, false);
            PG8_WAIT_V(8); PG8_WAIT_L(0); PG8_BAR; PG8_MMA(0, 0, At, B0); PG8_MMA(0, 1, At, B1); PG8_BAR; PG8_SCHED;
            PG8_LDA(At, 0, 1); PG8_STAGE(PG8_SB(0, 0), b2, voffB); PG8_STAGE(PG8_SB(0, 1), b2 + hstep, voffB); PG8_STAGEA(PG8_SA(0, 0), a2, 0, last);
            PG8_WAIT_V(8); PG8_WAIT_L(0); PG8_BAR; PG8_MMA(1, 0, At, B0); PG8_MMA(1, 1, At, B1); PG8_BAR; PG8_SCHED;
            PG8_LDB(B0, 1, 0); PG8_LDB(B1, 1, 1); PG8_SCHED; PG8_LDA(At, 1, 0); PG8_STAGEA(PG8_SA(0, 1), a2, 1, last);
            PG8_WAIT_V(8); PG8_WAIT_L(0); PG8_BAR; PG8_MMA(0, 0, At, B0); PG8_MMA(0, 1, At, B1); PG8_BAR; PG8_SCHED;
            PG8_LDA(At, 1, 1); PG8_STAGE(PG8_SB(1, 0), b3, voffB); PG8_STAGE(PG8_SB(1, 1), b3 + hstep, voffB); PG8_STAGEA(PG8_SA(1, 0), a3, 0, last);
            PG8_WAIT_V(8); PG8_WAIT_L(0); PG8_BAR; PG8_MMA(1, 0, At, B0); PG8_MMA(1, 1, At, B1); PG8_BAR; PG8_SCHED;
            } else {
            PG8_LDB(B0, 0, 0); PG8_SCHED; PG8_LDA(At, 0, 0); PG8_STAGEA(PG8_SA(1, 1), a1, 1, false);
            PG8_WAIT_L(8); PG8_BAR; PG8_WAIT_L(0); PG8_MMA(0, 0, At, B0); PG8_BAR; PG8_SCHED;
            PG8_LDB(B1, 0, 1); PG8_STAGE(PG8_SB(0, 0), b2, voffB);
            PG8_BAR; PG8_WAIT_L(0); PG8_MMA(0, 1, At, B1); PG8_BAR;
            PG8_LDA(At, 0, 1); PG8_STAGEA(PG8_SA(0, 0), a2, 0, last);
            PG8_BAR; PG8_WAIT_L(0); PG8_MMA(1, 0, At, B0); PG8_BAR; PG8_SCHED;
            PG8_STAGE(PG8_SB(0, 1), b2 + hstep, voffB);
            PG8_WAIT_V(6); PG8_BAR; PG8_MMA(1, 1, At, B1); PG8_BAR;
            PG8_LDB(B0, 1, 0); PG8_SCHED; PG8_LDA(At, 1, 0); PG8_STAGEA(PG8_SA(0, 1), a2, 1, last);
            PG8_WAIT_L(8); PG8_BAR; PG8_WAIT_L(0); PG8_MMA(0, 0, At, B0); PG8_BAR; PG8_SCHED;
            PG8_LDB(B1, 1, 1); PG8_STAGE(PG8_SB(1, 0), b3, voffB);
            PG8_BAR; PG8_WAIT_L(0); PG8_MMA(0, 1, At, B1); PG8_BAR;
            PG8_LDA(At, 1, 1); PG8_STAGEA(PG8_SA(1, 0), a3, 0, last);
            PG8_BAR; PG8_WAIT_L(0); PG8_MMA(1, 0, At, B0); PG8_BAR; PG8_SCHED;
            PG8_STAGE(PG8_SB(1, 1), b3 + hstep, voffB);
            PG8_WAIT_V(6); PG8_BAR; PG8_MMA(1, 1, At, B1); PG8_BAR;
            }
        }
        if constexpr (ALIGN_EPI) { if (wr == 0) PG8_BAR; }
        PG8_GRAW(ui + 2);
        if constexpr (F8) {
#pragma unroll
            for (int a_ = 0; a_ < 2; ++a_)
#pragma unroll
                for (int b_ = 0; b_ < 2; ++b_) asm volatile("s_nop 15\n\ts_nop 7" : "+v"(acc[a_][b_][0][0]), "+v"(acc[a_][b_][0][1]), "+v"(acc[a_][b_][1][0]), "+v"(acc[a_][b_][1][1]), "+v"(acc[a_][b_][2][0]), "+v"(acc[a_][b_][2][1]), "+v"(acc[a_][b_][3][0]), "+v"(acc[a_][b_][3][1]));
        }
        if constexpr (!Epi::AFTER_DRAIN) { E(acc, cur, wr, wc, fr, fq); S.done(cur); }
        if constexpr (Epi::DRAIN_AFTER) __builtin_amdgcn_s_waitcnt(0x0F70);
        if (!has_next) break;
#pragma unroll
        for (int a = 0; a < 2; ++a)
#pragma unroll
            for (int b = 0; b < 2; ++b)
#pragma unroll
                for (int m = 0; m < 4; ++m)
#pragma unroll
                    for (int n = 0; n < 2; ++n) acc[a][b][m][n] = (AccV){0, 0, 0, 0};
        cur = nxt; cA = nA; cB = nB; ++ui;
        if constexpr (GATHER) { _Pragma("unroll") for (int _h = 0; _h < 2; ++_h) _Pragma("unroll") for (int _i = 0; _i < 2; ++_i) vgC[_h][_i] = vgN[_h][_i]; }
        if constexpr (ALIGN_EPI) { if (wr == 1) PG8_BAR; }
    }
    PG8_WAIT_V(0);
    if constexpr (!ALIGN_EPI) { if (wr == 0) PG8_BAR; }
    PG8_BAR;
    if constexpr (Epi::AFTER_DRAIN) { E.fused(acc, cur, wr, wc, fr, fq, lds, wid, lane); S.done(cur); }
#undef PG8_SA
#undef PG8_SB
#undef PG8_STAGE
#undef PG8_STAGEA
#undef PG8_GOFF
#undef PG8_GRAW
#undef PG8_LDA
#undef PG8_LDF8
#undef PG8_LDB
#undef PG8_MMA
#undef PG8_WAIT_V
#undef PG8_WAIT_L
#undef PG8_BAR
#undef PG8_SCHED
}
}

#include <hip/hip_bf16.h>
#include <cmath>
namespace attn_body {
using bf16=__hip_bfloat16;
using bf16x8=__attribute__((ext_vector_type(8)))short;
using s16x4=__attribute__((ext_vector_type(4)))short;
using f32x16=__attribute__((ext_vector_type(16)))float;
using u32x4=__attribute__((ext_vector_type(4)))unsigned;
constexpr int BATCH=32,NHEAD=16,SEQ=2048,D=64,DM=NHEAD*D;
constexpr int NW=8,QBLK=32,QB=QBLK*NW,KVBLK=64,NQB=SEQ/QB;
constexpr int ATTN_PITCH=DM, ATTN_UNIT_ROWS=QB;
__device__ __forceinline__ int crow(int r,int hi){return (r&3)+8*(r>>2)+4*hi;}
#define SBAR() __builtin_amdgcn_sched_barrier(0)
__device__ __forceinline__ void cmask(f32x16&p0,f32x16&p1,int jb,int qrel,int hi){
  asm volatile("":"+v"(qrel));
  const float NEG=-INFINITY; int kb=64*jb+4*hi;
  #pragma unroll
  for(int r=0;r<16;++r){int kv=kb+(r&3)+8*(r>>2); if(kv>qrel)p0[r]=NEG; if(kv+32>qrel)p1[r]=NEG;}
}

constexpr int NSLOT=3, SLOTB=8192;
constexpr int LDS_K=0, LDS_V=NSLOT*SLOTB, LDS_WS=2*NSLOT*SLOTB, LDS_OST=LDS_WS+NW*64*4, LDS_BT=LDS_OST+NW*4096, LDS_BYTES=LDS_BT+SEQ*16;
constexpr float C2=0.125f*1.4426950408889634f;
__device__ __forceinline__ void glds16(const void*gsrc,unsigned lds_dst){unsigned keep;
  asm volatile("s_mov_b32 %0, m0\n\ts_mov_b32 m0, %2\n\ts_nop 0\n\tglobal_load_lds_dwordx4 %1, off\n\ts_mov_b32 m0, %0":"=&s"(keep):"v"(gsrc),"s"(lds_dst):"memory");}
__device__ __forceinline__ float max3f(float a,float b,float c){float r;asm("v_max3_f32 %0, %1, %2, %3":"=v"(r):"v"(a),"v"(b),"v"(c));return r;}
__device__ __forceinline__ float max2f(float a,float b){float r;asm("v_max_f32_e32 %0, %1, %2":"=v"(r):"v"(a),"v"(b));return r;}
__device__ __forceinline__ float fadd_s(float a,float b){float r;asm("v_add_f32_e32 %0, %1, %2":"=v"(r):"v"(a),"v"(b));return r;}
__device__ __forceinline__ float fsub_s(float a,float b){float r;asm("v_sub_f32_e32 %0, %1, %2":"=v"(r):"v"(a),"v"(b));return r;}
typedef float f32x2_t __attribute__((ext_vector_type(2))); typedef __bf16 bf16x2_t __attribute__((ext_vector_type(2)));
typedef unsigned u32x2 __attribute__((ext_vector_type(2))); constexpr float AO_SC=8.0f;
__device__ __forceinline__ unsigned pkf8x4(float a,float b,float c,float d){int w=0;w=__builtin_amdgcn_cvt_pk_fp8_f32(a,b,w,false);w=__builtin_amdgcn_cvt_pk_fp8_f32(c,d,w,true);return (unsigned)w;}
__device__ __forceinline__ unsigned cvtpk_s(float lo,float hi){f32x2_t v={lo,hi};bf16x2_t b=__builtin_convertvector(v,bf16x2_t);return __builtin_bit_cast(unsigned,b);}
#define WAIT_BAR(N) asm volatile("s_waitcnt vmcnt(" #N ") lgkmcnt(0)\n\ts_barrier":::"memory")

__device__ __forceinline__ void qkt(f32x16&p0,f32x16&p1,const char*Kslot,const bf16x8*qr,int r32,int hi,bf16x8 ba0,bf16x8 ba1,bf16x8 qaug){
  const char*kb=Kslot+hi*1024+r32*16;
  #pragma unroll
  for(int d0=0;d0<4;++d0){
    const bf16x8 b0=*reinterpret_cast<const bf16x8*>(kb+d0*2048);
    const bf16x8 b1=*reinterpret_cast<const bf16x8*>(kb+d0*2048+512);
    if(d0==0){p0=__builtin_amdgcn_mfma_f32_32x32x16_bf16(b0,qr[0],f32x16{},0,0,0);p1=__builtin_amdgcn_mfma_f32_32x32x16_bf16(b1,qr[0],f32x16{},0,0,0);}
    else{p0=__builtin_amdgcn_mfma_f32_32x32x16_bf16(b0,qr[d0],p0,0,0,0);p1=__builtin_amdgcn_mfma_f32_32x32x16_bf16(b1,qr[d0],p1,0,0,0);}}
  p0=__builtin_amdgcn_mfma_f32_32x32x16_bf16(ba0,qaug,p0,0,0,0);p1=__builtin_amdgcn_mfma_f32_32x32x16_bf16(ba1,qaug,p1,0,0,0);
}
typedef __attribute__((address_space(3))) const char* lds_cptr;
typedef short v4i16_t __attribute__((ext_vector_type(4)));
__device__ __forceinline__ void kload8(bf16x8*kf,lds_cptr kp){
  kf[0]=*(const __attribute__((address_space(3))) bf16x8*)(kp);      kf[1]=*(const __attribute__((address_space(3))) bf16x8*)(kp+512);
  kf[2]=*(const __attribute__((address_space(3))) bf16x8*)(kp+2048); kf[3]=*(const __attribute__((address_space(3))) bf16x8*)(kp+2560);
  kf[4]=*(const __attribute__((address_space(3))) bf16x8*)(kp+4096); kf[5]=*(const __attribute__((address_space(3))) bf16x8*)(kp+4608);
  kf[6]=*(const __attribute__((address_space(3))) bf16x8*)(kp+6144); kf[7]=*(const __attribute__((address_space(3))) bf16x8*)(kp+6656);
}
__device__ __forceinline__ void kload2(bf16x8*kf,lds_cptr kp,int j){ kf[2*j]=*(const __attribute__((address_space(3))) bf16x8*)(kp+j*2048); kf[2*j+1]=*(const __attribute__((address_space(3))) bf16x8*)(kp+j*2048+512); }
__device__ __forceinline__ s16x4 vtr(lds_cptr p){ return __builtin_bit_cast(s16x4,__builtin_amdgcn_ds_read_tr16_b64_v4i16((__attribute__((address_space(3))) v4i16_t*)p)); }
__device__ __forceinline__ float rowmax(const f32x16&p0,const f32x16&p1){
  float a=max3f(p0[0],p0[1],p1[0]),b=max3f(p0[2],p0[3],p1[1]);a=max3f(a,p1[2],p1[3]);
  #pragma unroll
  for(int r=4;r<16;r+=4){a=max3f(a,p0[r],p0[r+1]);b=max3f(b,p0[r+2],p0[r+3]);a=max3f(a,p1[r],p1[r+1]);b=max3f(b,p1[r+2],p1[r+3]);}
  const float m=max2f(a,b);
  auto rr=__builtin_amdgcn_permlane32_swap(__float_as_uint(m),__float_as_uint(m),false,false);
  return max2f(__uint_as_float(rr[0]),__uint_as_float(rr[1]));
}
__device__ __forceinline__ void pv(f32x16*o,int vb,bf16x8 pa0,bf16x8 pa1,bf16x8 pa2,bf16x8 pa3){
  #pragma unroll
  for(int d0=0;d0<2;++d0){s16x4 lo[4],hi[4];
    #pragma unroll
    for(int ks=0;ks<4;++ks){
      asm volatile("ds_read_b64_tr_b16 %0,%1 offset:%c2":"=&v"(lo[ks]):"v"(vb),"i"(d0*4096+ks*1024):"memory");
      asm volatile("ds_read_b64_tr_b16 %0,%1 offset:%c2":"=&v"(hi[ks]):"v"(vb),"i"(d0*4096+ks*1024+512):"memory");}
    asm volatile("s_waitcnt lgkmcnt(0)":::"memory");SBAR();
    #define PK(k) (bf16x8){lo[k][0],lo[k][1],lo[k][2],lo[k][3],hi[k][0],hi[k][1],hi[k][2],hi[k][3]}
    o[d0]=__builtin_amdgcn_mfma_f32_32x32x16_bf16(pa0,PK(0),o[d0],0,0,0);
    o[d0]=__builtin_amdgcn_mfma_f32_32x32x16_bf16(pa1,PK(1),o[d0],0,0,0);
    o[d0]=__builtin_amdgcn_mfma_f32_32x32x16_bf16(pa2,PK(2),o[d0],0,0,0);
    o[d0]=__builtin_amdgcn_mfma_f32_32x32x16_bf16(pa3,PK(3),o[d0],0,0,0);
    #undef PK
  }
}

#ifndef ATTN_STORE16
#define ATTN_STORE16(p,v) (*(u32x4*)(p)=(v))
#endif
template<int THRL> __device__ __forceinline__ void attn_unit(int b,int h,int qb,const bf16*Q,const bf16*__restrict__ K,const bf16*__restrict__ V,bf16*O,const bf16*__restrict__ SG,const float*__restrict__ brow,float skipthr,char*shm,const int mk_wave){
  const int lane=mk_lane(),r32=lane&31,hi=lane>>5; const int wid=mk_wave; const int tid=wid*64+lane; (void)tid;
  const long rowbase=(long)b*SEQ; const int q0=qb*QB;
  const bf16*Qw=Q+(rowbase+q0+wid*QBLK)*DM+h*D;
  int ts; { const int NT0=(q0+QB)/KVBLK; const float thr_=brow[q0]-skipthr; const float bl_=(lane<NT0-4)?brow[KVBLK*lane+KVBLK-1]:INFINITY; const unsigned long long m_=__ballot(bl_<thr_);
    ts=(int)__builtin_ctzll(~m_); ts=(ts>NT0-4?NT0-4:ts)&~1; ts=__builtin_amdgcn_readfirstlane(ts); }
  const bf16*Kh=K+(rowbase+(long)ts*KVBLK)*DM+h*D,*Vh=V+(rowbase+(long)ts*KVBLK)*DM+h*D;
  const unsigned lds0=(unsigned)(uintptr_t)shm;
  float*wsf=(float*)(shm+LDS_WS)+wid*64;
  const bf16*ksrc=Kh+(long)lane*DM+wid*8;
  const bf16*vsrc=Vh+(long)(16*(wid&3)+(lane>>2))*DM+(wid>>2)*32+(lane&3)*8;
  const unsigned kdst=lds0+LDS_K+wid*1024, vdst=lds0+LDS_V+wid*1024;
  #define DMA_K(t,slot) glds16(ksrc+(long)(t)*KVBLK*DM,(unsigned)__builtin_amdgcn_readfirstlane(kdst+(slot)))
  #define DMA_V(t,slot) glds16(vsrc+(long)(t)*KVBLK*DM,(unsigned)__builtin_amdgcn_readfirstlane(vdst+(slot)))
  const int vb0=(int)(lds0+LDS_V)+((lane>>4)&1)*32+(lane&3)*8+(4*hi+((lane&15)>>2))*64;
  const char*Kbase=shm+LDS_K; bf16x8 kf[8];
  const lds_cptr shm3=(lds_cptr)shm; const lds_cptr kp0=shm3+LDS_K+hi*1024+r32*16; const lds_cptr vp0=shm3+LDS_V+((lane>>4)&1)*32+(lane&3)*8+(4*hi+((lane&15)>>2))*64;
  const int NT=(q0+QB)/KVBLK-ts;
  const lds_cptr btp=shm3+LDS_BT+(ts*KVBLK+r32)*16;
  unsigned qref1=(hi==0)?0x00003F80u:0u, qref2=0u;
  #define SETREF() do{ const float x_=-mhat; const unsigned h0_=cvtpk_s(x_,0.f)&0xffffu; const float r1_=x_-__uint_as_float(h0_<<16); const unsigned h1_=cvtpk_s(r1_,0.f)&0xffffu; const float r2_=r1_-__uint_as_float(h1_<<16); const unsigned h2_=cvtpk_s(r2_,0.f)&0xffffu; \
      qref1=(hi==0)?(0x3F80u|(h0_<<16)):0u; qref2=(hi==0)?(h1_|(h2_<<16)):0u; }while(0)
  #define qaug __builtin_bit_cast(bf16x8,((u32x4){(hi==0)?0x3F803F80u:0u,qref1,qref2,0u}))
  #define BIASF(t,half) (*(const __attribute__((address_space(3))) bf16x8*)(btp+((t)*KVBLK+(half)*32)*16))
  DMA_K(0,0);DMA_V(0,0);DMA_K(1,SLOTB);
  bf16x8 qr[4];
  #pragma unroll
  for(int d0=0;d0<4;++d0)qr[d0]=*reinterpret_cast<const bf16x8*>(&Qw[(long)r32*DM+d0*16+hi*8]);
  float mhat=0.f,l_reg=0.f;f32x16 o[2];o[0]=f32x16{};o[1]=f32x16{};
  const int qrel=wid*QBLK+r32;
  #define CMASK(P0,P1,t) do{int jb_=(t)-(NT-4); if(jb_>=0)cmask(P0,P1,jb_,qrel,hi);}while(0)
  bool resc=false;
  const float refb_=brow[q0+wid*QBLK+r32]+0.5f*(skipthr-64.0f);
  #define START_NOTE
  #define START(P0,P1) do{ const float rm=refb_; resc=false; \
    { const float dl=rm; mhat=fadd_s(mhat,dl); \
      _Pragma("unroll") for(int r=0;r<16;++r){P0[r]=fsub_s(P0[r],dl);P1[r]=fsub_s(P1[r],dl);} \
      SETREF(); } \
    _Pragma("unroll") for(int r=0;r<16;++r)P0[r]=__builtin_amdgcn_exp2f(P0[r]); }while(0)
  #define RESC() do{ if(resc){ asm volatile("s_waitcnt lgkmcnt(0)":::"memory"); \
      _Pragma("unroll") for(int d_=0;d_<2;++d_) _Pragma("unroll") for(int r=0;r<16;++r)o[d_][r]*=wsf[crow(r,hi)]; } }while(0)
  f32x16 pA0,pA1,pB0,pB1;
  int sl_prev=0,sl_cur=0,sl_next=SLOTB;
  #define ROT() do{sl_prev=sl_cur;sl_cur=sl_next;sl_next=(sl_next==(NSLOT-1)*SLOTB)?0:sl_next+SLOTB;}while(0)
  DMA_K(2,2*SLOTB);
  WAIT_BAR(3);
  { const bf16x8 ba0_=BIASF(0,0),ba1_=BIASF(0,1); qkt(pA0,pA1,Kbase,qr,r32,hi,ba0_,ba1_,qaug); }asm volatile("s_nop 15\n\ts_nop 7":"+v"(pA0),"+v"(pA1));CMASK(pA0,pA1,0);
  START(pA0,pA1);
  _Pragma("unroll") for(int r=0;r<16;++r)pA1[r]=__builtin_amdgcn_exp2f(pA1[r]);
  WAIT_BAR(0);
  DMA_K(3,0);DMA_V(1,SLOTB);
  ROT();
  kload8(kf,kp0+sl_cur);
  WAIT_BAR(2);
  s16x4 vlo[8],vhi[8]; u32x4 pw0,pw1,pw2,pw3;
  #define PKW(P,B) cvtpk_s(P[B],P[B+1])
  #define PAF(k) __builtin_bit_cast(bf16x8,pw##k)
  #define VFR(i) (bf16x8){vlo[i][0],vlo[i][1],vlo[i][2],vlo[i][3],vhi[i][0],vhi[i][1],vhi[i][2],vhi[i][3]}
  #define PIN(x) asm volatile("":"+v"(x))
  #define MX3(a,b,c) __builtin_fmaxf(__builtin_fmaxf((a),(b)),(c))
  #define GAPA(MF,A0,A1,A2,A3,W0,W1,PW) do{ MF; sacc+=A0; sacc+=A1; sacc+=A2; sacc+=A3; PIN(sacc); W0; W1; PIN(PW); SBAR(); }while(0)
  #define EX(v) __builtin_amdgcn_exp2f(v)
  #define GAPB(MF,X,B) do{ MF; X[B]=EX(X[B]); X[B+1]=EX(X[B+1]); X[B+2]=EX(X[B+2]); X[B+3]=EX(X[B+3]); PIN(X); SBAR(); }while(0)
  #define VRD(i) do{ vlo[i]=vtr(vp_+(((i)>>2)*4096+((i)&3)*1024)); vhi[i]=vtr(vp_+(((i)>>2)*4096+((i)&3)*1024+512)); }while(0)
  #define KRD(G,j) do{ if(G){ kload2(kf,kp0+sl_next,j); SBAR(); } }while(0)
  #define STEP(C0,C1,P0,P1,t,GK,GV,GL) do{ SBAR(); \
    const lds_cptr vp_=vp0+sl_prev; \
    VRD(0); SBAR(); float sacc=(P0[0]+P0[1]); \
    GAPA(C0=__builtin_amdgcn_mfma_f32_32x32x16_bf16(kf[0],qr[0],f32x16{},0,0,0), P0[2],P0[3],P0[4],P0[5],     pw0[0]=PKW(P0,0), pw0[1]=PKW(P0,2), pw0); \
    VRD(4); SBAR(); GAPA(C1=__builtin_amdgcn_mfma_f32_32x32x16_bf16(kf[1],qr[0],f32x16{},0,0,0), P0[6],P0[7],P0[8],P0[9],     pw0[2]=PKW(P0,4), pw0[3]=PKW(P0,6), pw0); \
    VRD(1); SBAR(); GAPA(C0=__builtin_amdgcn_mfma_f32_32x32x16_bf16(kf[2],qr[1],C0,0,0,0),   P0[10],P0[11],P0[12],P0[13], pw1[0]=PKW(P0,8), pw1[1]=PKW(P0,10), pw1); \
    VRD(5); SBAR(); GAPA(C1=__builtin_amdgcn_mfma_f32_32x32x16_bf16(kf[3],qr[1],C1,0,0,0),   P0[14],P0[15],P1[0],P1[1],   pw1[2]=PKW(P0,12),pw1[3]=PKW(P0,14), pw1); \
    VRD(2); SBAR(); GAPA(C0=__builtin_amdgcn_mfma_f32_32x32x16_bf16(kf[4],qr[2],C0,0,0,0),   P1[2],P1[3],P1[4],P1[5],     pw2[0]=PKW(P1,0), pw2[1]=PKW(P1,2), pw2); \
    VRD(6); SBAR(); GAPA(C1=__builtin_amdgcn_mfma_f32_32x32x16_bf16(kf[5],qr[2],C1,0,0,0),   P1[6],P1[7],P1[8],P1[9],     pw2[2]=PKW(P1,4), pw2[3]=PKW(P1,6), pw2); \
    VRD(3); SBAR(); GAPA(C0=__builtin_amdgcn_mfma_f32_32x32x16_bf16(kf[6],qr[3],C0,0,0,0),   P1[10],P1[11],P1[12],P1[13], pw3[0]=PKW(P1,8), pw3[1]=PKW(P1,10), pw3); \
    VRD(7); SBAR(); GAPA(C1=__builtin_amdgcn_mfma_f32_32x32x16_bf16(kf[7],qr[3],C1,0,0,0),   P1[14],P1[15],0.f,0.f,       pw3[2]=PKW(P1,12),pw3[3]=PKW(P1,14), pw3); \
    { const bf16x8 ba0_=BIASF(t,0); C0=__builtin_amdgcn_mfma_f32_32x32x16_bf16(ba0_,qaug,C0,0,0,0); } { const bf16x8 ba1_=BIASF(t,1); C1=__builtin_amdgcn_mfma_f32_32x32x16_bf16(ba1_,qaug,C1,0,0,0); } SBAR(); \
    l_reg+=sacc; \
    if(GK){DMA_K((t)+3,sl_cur);} if(GV){DMA_V((t)+1,sl_next);} \
    CMASK(C0,C1,t); \
      \
    SBAR(); \
    GAPB(o[0]=__builtin_amdgcn_mfma_f32_32x32x16_bf16(PAF(0),VFR(0),o[0],0,0,0), C0,0); \
    GAPB(o[1]=__builtin_amdgcn_mfma_f32_32x32x16_bf16(PAF(0),VFR(4),o[1],0,0,0), C0,4); \
    KRD(GL,0); GAPB(o[0]=__builtin_amdgcn_mfma_f32_32x32x16_bf16(PAF(1),VFR(1),o[0],0,0,0), C0,8); \
    KRD(GL,1); GAPB(o[1]=__builtin_amdgcn_mfma_f32_32x32x16_bf16(PAF(1),VFR(5),o[1],0,0,0), C0,12); \
    KRD(GL,2); GAPB(o[0]=__builtin_amdgcn_mfma_f32_32x32x16_bf16(PAF(2),VFR(2),o[0],0,0,0), C1,0); \
    KRD(GL,3); GAPB(o[1]=__builtin_amdgcn_mfma_f32_32x32x16_bf16(PAF(2),VFR(6),o[1],0,0,0), C1,4); \
    GAPB(o[0]=__builtin_amdgcn_mfma_f32_32x32x16_bf16(PAF(3),VFR(3),o[0],0,0,0), C1,8); \
    GAPB(o[1]=__builtin_amdgcn_mfma_f32_32x32x16_bf16(PAF(3),VFR(7),o[1],0,0,0), C1,12); \
    }while(0)
  int t=1;
  #undef CMASK
  #define CMASK(P0,P1,t) do{}while(0)
  for(;t+5<NT;t+=2){
    STEP(pB0,pB1,pA0,pA1,t,true,true,true);     WAIT_BAR(2); RESC(); ROT();
    STEP(pA0,pA1,pB0,pB1,t+1,true,true,true);   WAIT_BAR(2); RESC(); ROT();
  }
  #undef CMASK
  #define CMASK(P0,P1,t) do{int jb_=(t)-(NT-4); if(jb_>=0)cmask(P0,P1,jb_,qrel,hi);}while(0)
  #define ENDW(tt) do{ if((tt)+3<NT){WAIT_BAR(2);} else if((tt)+2<NT){WAIT_BAR(1);} else {WAIT_BAR(0);} }while(0)
  for(;t+1<NT;t+=2){
    STEP(pB0,pB1,pA0,pA1,t,(t+3<NT),(t+1<NT),(t+1<NT));       ENDW(t);   RESC(); ROT();
    STEP(pA0,pA1,pB0,pB1,t+1,(t+4<NT),(t+2<NT),(t+2<NT));     ENDW(t+1); RESC(); ROT();
  }
  STEP(pB0,pB1,pA0,pA1,NT-1,false,false,false); RESC();
  { float sacc=pB0[0]+pB0[1]; _Pragma("unroll") for(int r=2;r<16;++r)sacc+=pB0[r]; _Pragma("unroll") for(int r=0;r<16;++r)sacc+=pB1[r]; l_reg+=sacc;
    pw0=(u32x4){PKW(pB0,0),PKW(pB0,2),PKW(pB0,4),PKW(pB0,6)};pw1=(u32x4){PKW(pB0,8),PKW(pB0,10),PKW(pB0,12),PKW(pB0,14)};pw2=(u32x4){PKW(pB1,0),PKW(pB1,2),PKW(pB1,4),PKW(pB1,6)};pw3=(u32x4){PKW(pB1,8),PKW(pB1,10),PKW(pB1,12),PKW(pB1,14)};
    SBAR(); pv(o,vb0+sl_cur,PAF(0),PAF(1),PAF(2),PAF(3)); }
  #undef PKW
  #undef PAF
  #undef VFR
  #undef PIN
  #undef MX3
  #undef GAPA
  #undef GAPB
  #undef EX
  #undef VRD
  #undef KRD
  #undef STEP
  #undef ENDW
  {auto rr=__builtin_amdgcn_permlane32_swap(__float_as_uint(l_reg),__float_as_uint(l_reg),false,false);l_reg=__uint_as_float(rr[0])+__uint_as_float(rr[1]);}
  if(hi==0)wsf[32+r32]=l_reg;asm volatile("s_waitcnt lgkmcnt(0)":::"memory");
  float rli[16];
  #pragma unroll
  for(int r=0;r<16;++r)rli[r]=__builtin_amdgcn_rcpf(wsf[32+crow(r,hi)]);
  unsigned char*Ow=(unsigned char*)O+(rowbase+q0+wid*QBLK)*DM+h*D; const bf16*SGw=SG+(rowbase+q0+wid*QBLK)*DM+h*D;
  { bf16*stg=(bf16*)(shm+LDS_OST)+wid*2048;
    #pragma unroll
    for(int r=0;r<16;++r){const int orow=crow(r,hi);
      #pragma unroll
      for(int d0=0;d0<2;++d0)stg[orow*64+d0*32+r32]=__float2bfloat16(o[d0][r]*rli[r]);}
    asm volatile("s_waitcnt lgkmcnt(0)":::"memory");
    #pragma unroll
    for(int i=0;i<4;++i){const int row=i*8+(lane>>3),ch=lane&7; u32x4 v=*(const u32x4*)(stg+row*64+ch*8); const u32x4 g=*(const u32x4*)(SGw+(long)row*DM+ch*8);
      float af[8]; _Pragma("unroll") for(int e_=0;e_<4;++e_){ af[2*e_]=__builtin_amdgcn_fmed3f(__uint_as_float(v[e_]<<16)*__uint_as_float(g[e_]<<16)*AO_SC,-448.0f,448.0f); af[2*e_+1]=__builtin_amdgcn_fmed3f(__uint_as_float(v[e_]&0xffff0000u)*__uint_as_float(g[e_]&0xffff0000u)*AO_SC,-448.0f,448.0f); }
      *(u32x2*)(Ow+(long)row*DM+ch*8)=(u32x2){pkf8x4(af[0],af[1],af[2],af[3]),pkf8x4(af[4],af[5],af[6],af[7])};} }
  asm volatile("s_waitcnt lgkmcnt(0)\n\ts_barrier":::"memory");
  #undef DMA_K
  #undef DMA_V
  #undef CMASK
  #undef START
  #undef RESC
  #undef ROT
  #undef BIASF
  #undef SETREF
  #undef qaug
}
constexpr int ATTN_LDS_BYTES=LDS_BYTES;
struct AttnTensors { const bf16* Q; const bf16* K; const bf16* V; bf16* O; const bf16* SG; const float* BIAS; float skipthr; };
struct AttnUnit { int bh; int qb; };
struct StaticOrder {
  int vcu,G;
  __device__ __forceinline__ explicit StaticOrder(int grid,int block):vcu(block),G(grid){}
  __device__ __forceinline__ bool next(int i,AttnUnit&u)const{ int bh=vcu+(i>>3)*G; if(bh>=BATCH*NHEAD)return false; if((i>>3)&1)bh^=8; u.bh=bh; u.qb=i&7; return true; }
  __device__ __forceinline__ void a_ready(const AttnUnit&)const{}
  __device__ __forceinline__ void done(const AttnUnit&)const{}
};
__device__ __forceinline__ void fill_bias(const float*brow,char*shm,const int mk_wave){
  int kv0=mk_wave*64+mk_lane(); asm volatile("":"+v"(kv0));
  for(int kv=kv0;kv<SEQ;kv+=NW*64){ const float x=brow[kv];
    const unsigned h0=cvtpk_s(x,0.f)&0xffffu; const float r1=x-__uint_as_float(h0<<16);
    const unsigned h1=cvtpk_s(r1,0.f)&0xffffu; const float r2=r1-__uint_as_float(h1<<16);
    const unsigned h2=cvtpk_s(r2,0.f)&0xffffu;
    *(u32x4*)(shm+LDS_BT+kv*16)=(u32x4){h0|(h1<<16),h2|0x3F800000u,0x3F803F80u,0u}; }
}
template<class Sched,class Hook,int THRL=8> __device__ __forceinline__ void attn_phase(char*lds,const AttnTensors&T,const Sched&S,const int mk_wave,const Hook&hook){
  AttnUnit u;
  for(int i=0;S.next(i,u);++i){ S.a_ready(u); const bool clob_=hook(i); if(clob_||(i&7)==0) fill_bias(T.BIAS+(long)u.bh*SEQ,lds,mk_wave); attn_unit<THRL>(u.bh/NHEAD,u.bh%NHEAD,u.qb,T.Q,T.K,T.V,T.O,T.SG,T.BIAS+(long)u.bh*SEQ,T.skipthr,lds,mk_wave); S.done(u); }
}
#undef SBAR
#undef WAIT_BAR
}

#define GAS __attribute__((address_space(1)))
#define LAS __attribute__((address_space(3)))
typedef unsigned short bf16;
typedef unsigned v4u __attribute__((ext_vector_type(4)));
typedef float f32x4 __attribute__((ext_vector_type(4)));
typedef short bf16x8 __attribute__((ext_vector_type(8)));
typedef GAS unsigned gu32;
typedef GAS unsigned long long gu64;
#define RLX_AGENT __ATOMIC_RELAXED, __HIP_MEMORY_SCOPE_AGENT
#define LDS_WAIT() asm volatile("s_waitcnt lgkmcnt(0)" ::: "memory")
#define VM_WAIT() asm volatile("s_waitcnt vmcnt(0)" ::: "memory")
__device__ __forceinline__ unsigned long long rt() { return __builtin_amdgcn_s_memrealtime(); }
__device__ __forceinline__ unsigned f2bf(float f) { unsigned u = __builtin_bit_cast(unsigned, f); return (u + 0x7fffu + ((u >> 16) & 1u)) >> 16; }
typedef float f32x2_t_ __attribute__((ext_vector_type(2))); typedef __bf16 bf16x2_t_ __attribute__((ext_vector_type(2)));
__device__ __forceinline__ unsigned pk2(float lo, float hi) { f32x2_t_ v = {lo, hi}; bf16x2_t_ b = __builtin_convertvector(v, bf16x2_t_); return __builtin_bit_cast(unsigned, b); }

#define XB_TMO      128
#define XB_XCNT(j)  (256  + 64 * (j))
#define XB_XSUB(j)  (1280 + 64 * (j))
#define XB_XGEN(j)  (2304 + 64 * (j))
#define XB_TOP      3328
#define XB_TOPGEN   3392
#define XCD_BAR_WORDS 3456
#define XB_SPIN_CAP (1u << 18)

__device__ __forceinline__ unsigned xb_ld(unsigned* p)              { return __hip_atomic_load(p, __ATOMIC_RELAXED, __HIP_MEMORY_SCOPE_AGENT); }
__device__ __forceinline__ unsigned xb_add(unsigned* p, unsigned v) { return __hip_atomic_fetch_add(p, v, __ATOMIC_RELAXED, __HIP_MEMORY_SCOPE_AGENT); }
__device__ __forceinline__ unsigned xb_xcc_id() { return (unsigned)__builtin_amdgcn_s_getreg((3 << 11) | 20) & 0xFu; }
#define XB_SPIN(cond, bar) do { unsigned _sp = 0; while (cond) { __builtin_amdgcn_s_sleep(1); \
    if ((++_sp & 255u) == 0u) { if (xb_ld(&(bar)[XB_TMO])) break; if (_sp > XB_SPIN_CAP) { atomicAdd(&(bar)[XB_TMO], 1u); break; } } } } while (0)

struct XcdBarrier {
    unsigned* bar; unsigned x; int w;
    volatile LAS unsigned* st;
};

__device__ __forceinline__ XcdBarrier xcd_barrier_post(unsigned* bar, volatile LAS unsigned* st, int wave) {
    XcdBarrier b; b.bar = bar; b.x = xb_xcc_id(); b.st = st; b.w = wave;
    if (b.w == 0 && mk_lane() == 0) (void)xb_add(&bar[XB_XCNT(b.x)], 1u);
    return b;
}
__device__ __forceinline__ void xcd_barrier_complete(unsigned* bar, unsigned x, unsigned& nloc, unsigned& nx) {
    const unsigned G = gridDim.x * gridDim.y * gridDim.z;
    unsigned sum, cnt, mine, sp = 0u;
    for (;;) {
        sum = 0u; cnt = 0u; mine = 0u;
#pragma unroll
        for (unsigned j = 0; j < 16; ++j) { const unsigned c = xb_ld(&bar[XB_XCNT(j)]); sum += c; cnt += (c > 0u) ? 1u : 0u; mine = (j == x) ? c : mine; }
        if (sum == G) break;
        __builtin_amdgcn_s_sleep(1);
        if ((++sp & 255u) == 0u) { if (xb_ld(&bar[XB_TMO])) break; if (sp > XB_SPIN_CAP) { atomicAdd(&bar[XB_TMO], 1u); break; } }
    }
    nloc = mine > 0u ? mine : 1u; nx = cnt > 0u ? cnt : 1u;
}

__device__ __forceinline__ void xcd_barrier(const XcdBarrier& b) {
    asm volatile("s_waitcnt vmcnt(0)" ::: "memory");
    __syncthreads();
    if (b.w == 0 && mk_lane() == 0) {
        unsigned* bar = b.bar;
        __builtin_amdgcn_s_waitcnt(0);
        unsigned nloc = b.st[0], nx = b.st[1];
        if (nloc == 0u) { xcd_barrier_complete(bar, b.x, nloc, nx); b.st[0] = nloc; b.st[1] = nx; }
        const unsigned old = xb_add(&bar[XB_XSUB(b.x)], 1u);
        const unsigned gen = old / nloc;
        if (old + 1u == (gen + 1u) * nloc) {
            __builtin_amdgcn_fence(__ATOMIC_RELEASE, "agent");
            asm volatile("s_waitcnt vmcnt(0)" ::: "memory");
            const unsigned og = xb_add(&bar[XB_TOP], 1u);
            const unsigned tg = og / nx;
            if (og + 1u == (tg + 1u) * nx) xb_add(&bar[XB_TOPGEN], 1u);
            else XB_SPIN(xb_ld(&bar[XB_TOPGEN]) == tg, bar);
            __builtin_amdgcn_fence(__ATOMIC_ACQUIRE, "agent");
            xb_add(&bar[XB_XGEN(b.x)], 1u);
            asm volatile("s_waitcnt vmcnt(0)" ::: "memory");
        } else {
            XB_SPIN(xb_ld(&bar[XB_XGEN(b.x)]) == gen, bar);
            __builtin_amdgcn_fence(__ATOMIC_ACQUIRE, "agent");
            asm volatile("s_waitcnt vmcnt(0)" ::: "memory");
        }
    }
    __syncthreads();
}

constexpr int NWAVES = 8;
constexpr int NB = 32, SEQ = 2048, D = 1024, T = NB * SEQ, DEPTH = 4, NE = 32, TOPK = 4, NMOD = 6;
constexpr int NFOXP = 4352;
constexpr int TPAD = T * TOPK + NE * 256;
constexpr int NCHUNK = T / 256;
constexpr float EPS = 1e-6f;

constexpr size_t MiB = 1u << 20;
constexpr size_t WS_CTL = 0, CTL_ZERO_BYTES = 1 * MiB;
constexpr size_t WS_ROUTE = 1 * MiB;
constexpr size_t WS_MOD = 2 * MiB;
constexpr size_t WS_FL = 5 * MiB;
constexpr size_t WS_BIAS = 9 * MiB;
constexpr size_t WS_TOPI = 13 * MiB, WS_TOPW = 14 * MiB, WS_POS = 15 * MiB;
constexpr size_t WS_WFI = 16 * MiB, WS_WFO = 33 * MiB, WS_WHI = 37 * MiB, WS_WHO = 53 * MiB;
constexpr size_t WS_WGU = 64 * MiB, WS_WDN = 192 * MiB;
constexpr size_t WS_HN = 256 * MiB;
constexpr size_t WS_R1 = 384 * MiB;
constexpr size_t WS_ACT = 1024 * MiB;
constexpr size_t WS_XB = 1296 * MiB;
constexpr size_t WS_ROWTOK = 1552 * MiB;
constexpr size_t WS_SAROW = 1554 * MiB;
constexpr size_t WS_PART = 1554 * MiB + 0;
constexpr size_t WS_PARTM = 1556 * MiB;
constexpr size_t WS_END = 1558 * MiB;
constexpr size_t WS_SWM = WS_ROUTE + 768 * 1024;
constexpr size_t WS_SA = WS_ROUTE + 256 * 1024;
constexpr size_t WS_SW = WS_ROUTE + 512 * 1024;
constexpr int RT_NTILES = 0, RT_TEXP = 64, RT_HIST = 2048;
constexpr int CW_BAR = 4096;

constexpr int RING_OFF = 0, RING_BYTES = 131072;
constexpr int LSCR_OFF = RING_BYTES;
constexpr int LDSCTL_OFF = 163840 - 1024, MISC_OFF = LDSCTL_OFF + 320;
constexpr int LDS_BYTES = 163840;

__device__ __forceinline__ float wave_sum(float v) {
#pragma unroll
    for (int o = 1; o < 64; o <<= 1) v += __shfl_xor(v, o);
    return v;
}
__device__ __forceinline__ float wave_max(float v) {
#pragma unroll
    for (int o = 1; o < 64; o <<= 1) v = fmaxf(v, __shfl_xor(v, o));
    return v;
}
__device__ __forceinline__ float sigm_f(float x) { return __builtin_amdgcn_rcpf(1.0f + __expf(-x)); }
#define LBAR() do { asm volatile("s_waitcnt lgkmcnt(0)" ::: "memory"); __builtin_amdgcn_s_barrier(); asm volatile("" ::: "memory"); } while (0)

struct MapIdent { __device__ __forceinline__ int operator()(int n) const { return n; } };
struct MapFoxIn { __device__ __forceinline__ int operator()(int n) const { const int pn = n >> 8, s = n & 255, bj = s >> 7, wc = (s >> 5) & 3, j = s & 31, lc = 64 * wc + 32 * bj + j;
    return pn < 16 ? 256 * pn + lc : (lc < 16 ? 4096 + lc : -1); } };
struct MapGu { __device__ __forceinline__ int operator()(int n) const { const int pn = n >> 8, s = n & 255, bj = s >> 7, wc = (s >> 5) & 3, j = s & 31; return 2 * (128 * pn + 32 * wc + j) + bj; } };
template <class CM>
__device__ __forceinline__ void transpose_item(const float* W, int ldw, int K, bf16* WT, const CM& cm, LAS float* scr, int item, int nblk, int lane) {
    const int kb = item / nblk, nb = item - kb * nblk, k0 = 64 * kb, n0 = 32 * nb;
    const int col = cm(n0 + (lane & 31));
#pragma unroll 8
    for (int i = 0; i < 32; ++i) { const int kk = 2 * i + (lane >> 5); scr[kk * 33 + (lane & 31)] = (col >= 0) ? W[(size_t)(k0 + kk) * ldw + col] : 0.f; }
    LDS_WAIT(); asm volatile("" ::: "memory");
    const int c = lane & 7;
#pragma unroll
    for (int j = 0; j < 4; ++j) { const int n = (lane >> 3) + 8 * j; const LAS float* s = scr + (8 * c) * 33 + n;
        v4u o; o.x = pk2(s[0 * 33], s[1 * 33]); o.y = pk2(s[2 * 33], s[3 * 33]); o.z = pk2(s[4 * 33], s[5 * 33]); o.w = pk2(s[6 * 33], s[7 * 33]);
        *(GAS v4u*)(WT + (size_t)(n0 + n) * K + k0 + 8 * c) = o; }
    LDS_WAIT(); asm volatile("" ::: "memory");
}
template <class CM>
__device__ __forceinline__ void convert_matrix(const float* W, int ldw, int K, int Nd, bf16* WT, const CM& cm, LAS float* scr, int gw, int NGW, int lane) {
    const int nblk = Nd / 32, nitems = (K / 64) * nblk;
    for (int it = gw; it < nitems; it += NGW) transpose_item(W, ldw, K, WT, cm, scr, it, nblk, lane);
}

struct OrIdent { __device__ __forceinline__ int operator()(int c) const { return c; } };
struct OrGu { __device__ __forceinline__ int operator()(int c) const { const int a = c >> 1, bj = c & 1; return ((a >> 7) << 8) + (bj << 7) + (a & 127); } };
template <class OR>
__device__ __forceinline__ void convert_tile128(const float* W, int ldw, int K, bf16* WT, const OR& orow, LAS unsigned char* wl, int k0, int c0, int lane) {
    const int kk = lane >> 5, n4 = lane & 31;
#pragma unroll
    for (int bq = 0; bq < 2; ++bq) {
        f32x4 v[16];
#pragma unroll
        for (int it = 0; it < 16; ++it) v[it] = __builtin_nontemporal_load((const f32x4*)(W + (size_t)(k0 + 32 * bq + 16 * kk + it) * ldw + c0 + 4 * n4));
#pragma unroll
        for (int i = 0; i < 4; ++i) { const int c = 4 * n4 + i, sw = n4 & 7, ch = 4 * bq + 2 * kk;
            v4u w0, w1; w0.x = pk2(v[0][i], v[1][i]); w0.y = pk2(v[2][i], v[3][i]); w0.z = pk2(v[4][i], v[5][i]); w0.w = pk2(v[6][i], v[7][i]);
            w1.x = pk2(v[8][i], v[9][i]); w1.y = pk2(v[10][i], v[11][i]); w1.z = pk2(v[12][i], v[13][i]); w1.w = pk2(v[14][i], v[15][i]);
            *(LAS v4u*)(wl + c * 128 + ((ch ^ sw) << 4)) = w0; *(LAS v4u*)(wl + c * 128 + (((ch + 1) ^ sw) << 4)) = w1; }
    }
    LDS_WAIT(); asm volatile("" ::: "memory");
#pragma unroll
    for (int r = 0; r < 16; ++r) { const int c = 8 * r + (lane >> 3), ch = lane & 7; const v4u o = *(const LAS v4u*)(wl + c * 128 + ((ch ^ ((c >> 2) & 7)) << 4));
        *(GAS v4u*)(WT + (size_t)orow(c0 + c) * K + k0 + 8 * ch) = o; }
    LDS_WAIT(); asm volatile("" ::: "memory");
}
__device__ __forceinline__ void convert_experts_down(const float* wdn, bf16* WDN, LAS unsigned char* wl, int gw, int NGW, int lane) {
    for (int it = gw; it < 4096; it += NGW) { const int e = it >> 7, r = it & 127, kt = r >> 3, ct = r & 7;
        convert_tile128(wdn + (size_t)e * D * D, D, D, WDN + (size_t)e * D * D, OrIdent(), wl, 64 * kt, 128 * ct, lane); }
}
__device__ __forceinline__ void absmax_gu(const float* wgu, float* PART, int gw, int NGW, int lane) {
    const int kk = lane >> 5, n4 = lane & 31;
    for (int it = gw; it < 2048; it += NGW) {
        const int kq = it >> 9, e = (it >> 4) & 31, ct = it & 15;
        const float* src = wgu + ((size_t)e * D + 256 * kq + kk) * 2048 + 128 * ct + 4 * n4;
        f32x4 mx = (f32x4){0.f, 0.f, 0.f, 0.f};
#pragma unroll 16
        for (int i = 0; i < 128; ++i) { const f32x4 v = *(const f32x4*)(src + (size_t)(2 * i) * 2048);
            mx[0] = fmaxf(mx[0], fabsf(v[0])); mx[1] = fmaxf(mx[1], fabsf(v[1])); mx[2] = fmaxf(mx[2], fabsf(v[2])); mx[3] = fmaxf(mx[3], fabsf(v[3])); }
#pragma unroll
        for (int i = 0; i < 4; ++i) mx[i] = fmaxf(mx[i], __shfl_xor(mx[i], 32));
        if (kk == 0) *(f32x4*)(PART + ((size_t)kq * NE + e) * 2048 + 128 * ct + 4 * n4) = mx;
    }
}
__device__ __forceinline__ unsigned pack_i8x4(float a, float b, float c, float d) {
    const int qa = (int)__builtin_rintf(a), qb = (int)__builtin_rintf(b), qc = (int)__builtin_rintf(c), qd = (int)__builtin_rintf(d);
    return ((unsigned)qa & 0xffu) | (((unsigned)qb & 0xffu) << 8) | (((unsigned)qc & 0xffu) << 16) | ((unsigned)qd << 24);
}
__device__ __forceinline__ void convert_gu_i8(const float* wgu, const float* PART, unsigned char* WQ, float* SW, LAS unsigned char* wl, int gw, int NGW, int lane) {
    const int kk = lane >> 5, n4 = lane & 31;
    for (int it = gw; it < 4096; it += NGW) {
        const int e = it >> 7, r = it & 127, kt = r >> 4, ct = r & 15; const int k0 = 128 * kt, c0 = 128 * ct;
        f32x4 am = *(const f32x4*)(PART + ((size_t)0 * NE + e) * 2048 + c0 + 4 * n4);
#pragma unroll
        for (int kq = 1; kq < 4; ++kq) { const f32x4 t = *(const f32x4*)(PART + ((size_t)kq * NE + e) * 2048 + c0 + 4 * n4); am[0] = fmaxf(am[0], t[0]); am[1] = fmaxf(am[1], t[1]); am[2] = fmaxf(am[2], t[2]); am[3] = fmaxf(am[3], t[3]); }
        f32x4 inv;
#pragma unroll
        for (int i = 0; i < 4; ++i) inv[i] = am[i] > 0.f ? 127.0f / am[i] : 0.f;
        if (kt == 0 && kk == 0) *(f32x4*)(SW + (size_t)e * 2048 + c0 + 4 * n4) = am * (1.0f / 127.0f);
        const float* W = wgu + (size_t)e * D * 2048;
#pragma unroll 1
        for (int bq = 0; bq < 4; ++bq) {
            f32x4 v[16];
#pragma unroll
            for (int t = 0; t < 16; ++t) v[t] = *(const f32x4*)(W + (size_t)(k0 + 32 * bq + 16 * kk + t) * 2048 + c0 + 4 * n4);
#pragma unroll
            for (int i = 0; i < 4; ++i) { const int c = 4 * n4 + i, sw = n4 & 7, ch = 2 * bq + kk; const float s = inv[i];
                v4u w; w.x = pack_i8x4(v[0][i] * s, v[1][i] * s, v[2][i] * s, v[3][i] * s); w.y = pack_i8x4(v[4][i] * s, v[5][i] * s, v[6][i] * s, v[7][i] * s);
                w.z = pack_i8x4(v[8][i] * s, v[9][i] * s, v[10][i] * s, v[11][i] * s); w.w = pack_i8x4(v[12][i] * s, v[13][i] * s, v[14][i] * s, v[15][i] * s);
                *(LAS v4u*)(wl + c * 128 + ((ch ^ sw) << 4)) = w; }
        }
        LDS_WAIT(); asm volatile("" ::: "memory");
#pragma unroll
        for (int r2 = 0; r2 < 16; ++r2) { const int c = 8 * r2 + (lane >> 3), ch = lane & 7; const v4u o = *(const LAS v4u*)(wl + c * 128 + ((ch ^ ((c >> 2) & 7)) << 4));
            *(GAS v4u*)(WQ + ((size_t)e * 2048 + OrGu()(c0 + c)) * 1024 + k0 + 16 * ch) = o; }
        LDS_WAIT(); asm volatile("" ::: "memory");
    }
}

template <class OR>
__device__ __forceinline__ void convert_strip_i8(const float* W, int ldw, unsigned char* WQ, float* SW, const OR& orow, int c0, LAS float* cmax, LAS unsigned char* wl, int wave, int lane) {
    const int kk = lane >> 5, n4 = lane & 31; const int k0 = 128 * wave;
    f32x4 mx = (f32x4){0.f, 0.f, 0.f, 0.f};
#pragma unroll 1
    for (int bq = 0; bq < 4; ++bq) {
        f32x4 v[16];
#pragma unroll
        for (int t = 0; t < 16; ++t) v[t] = *(const f32x4*)(W + (size_t)(k0 + 32 * bq + 16 * kk + t) * ldw + c0 + 4 * n4);
#pragma unroll
        for (int t = 0; t < 16; ++t) { mx[0] = fmaxf(mx[0], fabsf(v[t][0])); mx[1] = fmaxf(mx[1], fabsf(v[t][1])); mx[2] = fmaxf(mx[2], fabsf(v[t][2])); mx[3] = fmaxf(mx[3], fabsf(v[t][3])); }
    }
#pragma unroll
    for (int i = 0; i < 4; ++i) mx[i] = fmaxf(mx[i], __shfl_xor(mx[i], 32));
    if (kk == 0) *(LAS f32x4*)(cmax + wave * 128 + 4 * n4) = mx;
    LBAR();
    f32x4 am = *(const LAS f32x4*)(cmax + 4 * n4);
#pragma unroll
    for (int w2 = 1; w2 < 8; ++w2) { const f32x4 t = *(const LAS f32x4*)(cmax + w2 * 128 + 4 * n4); am[0] = fmaxf(am[0], t[0]); am[1] = fmaxf(am[1], t[1]); am[2] = fmaxf(am[2], t[2]); am[3] = fmaxf(am[3], t[3]); }
    f32x4 inv;
#pragma unroll
    for (int i = 0; i < 4; ++i) inv[i] = am[i] > 0.f ? 127.0f / am[i] : 0.f;
    if (wave == 0 && kk == 0) *(f32x4*)(SW + c0 + 4 * n4) = am * (1.0f / 127.0f);
#pragma unroll 1
    for (int bq = 0; bq < 4; ++bq) {
        f32x4 v[16];
#pragma unroll
        for (int t = 0; t < 16; ++t) v[t] = __builtin_nontemporal_load((const f32x4*)(W + (size_t)(k0 + 32 * bq + 16 * kk + t) * ldw + c0 + 4 * n4));
#pragma unroll
        for (int i = 0; i < 4; ++i) { const int c = 4 * n4 + i, sw = n4 & 7, ch = 2 * bq + kk; const float sc = inv[i];
            v4u w; w.x = pack_i8x4(v[0][i] * sc, v[1][i] * sc, v[2][i] * sc, v[3][i] * sc); w.y = pack_i8x4(v[4][i] * sc, v[5][i] * sc, v[6][i] * sc, v[7][i] * sc);
            w.z = pack_i8x4(v[8][i] * sc, v[9][i] * sc, v[10][i] * sc, v[11][i] * sc); w.w = pack_i8x4(v[12][i] * sc, v[13][i] * sc, v[14][i] * sc, v[15][i] * sc);
            *(LAS v4u*)(wl + c * 128 + ((ch ^ sw) << 4)) = w; }
    }
    LDS_WAIT(); asm volatile("" ::: "memory");
#pragma unroll
    for (int r2 = 0; r2 < 16; ++r2) { const int c = 8 * r2 + (lane >> 3), ch = lane & 7; const v4u o = *(const LAS v4u*)(wl + c * 128 + ((ch ^ ((c >> 2) & 7)) << 4));
        *(GAS v4u*)(WQ + (size_t)orow(c0 + c) * 1024 + k0 + 16 * ch) = o; }
    LBAR();
}

__device__ __forceinline__ unsigned pk_fp8x4m(float a, float b, float c, float d) { int w = 0; w = __builtin_amdgcn_cvt_pk_fp8_f32(a, b, w, false); w = __builtin_amdgcn_cvt_pk_fp8_f32(c, d, w, true); return (unsigned)w; }
constexpr float F8_WSCALE = 32.0f;
constexpr float AO_SCALE = 8.0f;
__device__ __forceinline__ void convert_down_f8(const float* wdn, unsigned char* WQ, LAS unsigned char* wl, int gw, int NGW, int lane, int nitems = 2048) {
    const int kk = lane >> 5, n4 = lane & 31;
    for (int it = gw; it < nitems; it += NGW) {
        const int e = it >> 6, r = it & 63, kt = r >> 3, ct = r & 7; const int k0 = 128 * kt, c0 = 128 * ct;
        const float* W = wdn + (size_t)e * D * D;
#pragma unroll 1
        for (int bq = 0; bq < 4; ++bq) {
            f32x4 v[16];
#pragma unroll
            for (int t = 0; t < 16; ++t) v[t] = __builtin_nontemporal_load((const f32x4*)(W + (size_t)(k0 + 32 * bq + 16 * kk + t) * D + c0 + 4 * n4));
#pragma unroll
            for (int t = 0; t < 16; ++t) { v[t] = v[t] * F8_WSCALE;
#pragma unroll
                for (int i = 0; i < 4; ++i) v[t][i] = fminf(fmaxf(v[t][i], -448.0f), 448.0f); }
#pragma unroll
            for (int i = 0; i < 4; ++i) { const int c = 4 * n4 + i, sw = n4 & 7, ch = 2 * bq + kk; const float sc = 1.0f;
                v4u w; w.x = pk_fp8x4m(v[0][i] * sc, v[1][i] * sc, v[2][i] * sc, v[3][i] * sc); w.y = pk_fp8x4m(v[4][i] * sc, v[5][i] * sc, v[6][i] * sc, v[7][i] * sc);
                w.z = pk_fp8x4m(v[8][i] * sc, v[9][i] * sc, v[10][i] * sc, v[11][i] * sc); w.w = pk_fp8x4m(v[12][i] * sc, v[13][i] * sc, v[14][i] * sc, v[15][i] * sc);
                *(LAS v4u*)(wl + c * 128 + ((ch ^ sw) << 4)) = w; }
        }
        LDS_WAIT(); asm volatile("" ::: "memory");
#pragma unroll
        for (int r2 = 0; r2 < 16; ++r2) { const int c = 8 * r2 + (lane >> 3), ch = lane & 7; const v4u o = *(const LAS v4u*)(wl + c * 128 + ((ch ^ ((c >> 2) & 7)) << 4));
            *(GAS v4u*)(WQ + ((size_t)e * D + c0 + c) * D + k0 + 16 * ch) = o; }
        LDS_WAIT(); asm volatile("" ::: "memory");
    }
}

struct OrFoxIn { __device__ __forceinline__ int operator()(int c) const { if (c >= 4096) return c; const int pn = c >> 8, lc = c & 255, wc = lc >> 6, bj = (lc >> 5) & 1, j = lc & 31; return 256 * pn + 128 * bj + 32 * wc + j; } };
__device__ __forceinline__ void absmax_mat(const float* W, int ldw, int ncols, int nct, float* PART, int item, int lane) {
    const int kk = lane >> 5, n4 = lane & 31; const int kq = item / nct, ct = item - kq * nct; const int col = 128 * ct + 4 * n4;
    f32x4 mx = (f32x4){0.f, 0.f, 0.f, 0.f};
    if (col < ncols) {
        const float* src = W + (size_t)(256 * kq + kk) * ldw + col;
#pragma unroll 16
        for (int i = 0; i < 128; ++i) { const f32x4 v = *(const f32x4*)(src + (size_t)(2 * i) * ldw);
            mx[0] = fmaxf(mx[0], fabsf(v[0])); mx[1] = fmaxf(mx[1], fabsf(v[1])); mx[2] = fmaxf(mx[2], fabsf(v[2])); mx[3] = fmaxf(mx[3], fabsf(v[3])); }
    }
#pragma unroll
    for (int i = 0; i < 4; ++i) mx[i] = fmaxf(mx[i], __shfl_xor(mx[i], 32));
    if (kk == 0) *(f32x4*)(PART + (size_t)kq * (nct * 128) + col) = mx;
}
template <class OR>
__device__ __forceinline__ void convert_mat_i8(const float* W, int ldw, int ncols, int nct, const float* PART, unsigned char* WQ, float* SW, const OR& orow, LAS unsigned char* wl, int item, int lane) {
    const int kk = lane >> 5, n4 = lane & 31; const int kt = item / nct, ct = item - kt * nct; const int k0 = 128 * kt, c0 = 128 * ct; const bool live = (c0 + 4 * n4) < ncols;
    f32x4 am = *(const f32x4*)(PART + c0 + 4 * n4);
#pragma unroll
    for (int kq = 1; kq < 4; ++kq) { const f32x4 t = *(const f32x4*)(PART + (size_t)kq * (nct * 128) + c0 + 4 * n4); am[0] = fmaxf(am[0], t[0]); am[1] = fmaxf(am[1], t[1]); am[2] = fmaxf(am[2], t[2]); am[3] = fmaxf(am[3], t[3]); }
    f32x4 inv;
#pragma unroll
    for (int i = 0; i < 4; ++i) inv[i] = am[i] > 0.f ? 127.0f / am[i] : 0.f;
    if (kt == 0 && kk == 0 && live) *(f32x4*)(SW + c0 + 4 * n4) = am * (1.0f / 127.0f);
#pragma unroll 1
    for (int bq = 0; bq < 4; ++bq) {
        f32x4 v[16];
#pragma unroll
        for (int t = 0; t < 16; ++t) v[t] = live ? __builtin_nontemporal_load((const f32x4*)(W + (size_t)(k0 + 32 * bq + 16 * kk + t) * ldw + c0 + 4 * n4)) : (f32x4){0.f, 0.f, 0.f, 0.f};
#pragma unroll
        for (int i = 0; i < 4; ++i) { const int c = 4 * n4 + i, sw = n4 & 7, ch = 2 * bq + kk; const float sc = inv[i];
            v4u w; w.x = pack_i8x4(v[0][i] * sc, v[1][i] * sc, v[2][i] * sc, v[3][i] * sc); w.y = pack_i8x4(v[4][i] * sc, v[5][i] * sc, v[6][i] * sc, v[7][i] * sc);
            w.z = pack_i8x4(v[8][i] * sc, v[9][i] * sc, v[10][i] * sc, v[11][i] * sc); w.w = pack_i8x4(v[12][i] * sc, v[13][i] * sc, v[14][i] * sc, v[15][i] * sc);
            *(LAS v4u*)(wl + c * 128 + ((ch ^ sw) << 4)) = w; }
    }
    LDS_WAIT(); asm volatile("" ::: "memory");
#pragma unroll
    for (int r2 = 0; r2 < 16; ++r2) { const int c = 8 * r2 + (lane >> 3), ch = lane & 7; const v4u o = *(const LAS v4u*)(wl + c * 128 + ((ch ^ ((c >> 2) & 7)) << 4));
        if (c0 + c < ncols) *(GAS v4u*)(WQ + (size_t)orow(c0 + c) * 1024 + k0 + 16 * ch) = o; }
    LDS_WAIT(); asm volatile("" ::: "memory");
}

__device__ __forceinline__ void phase_mod(const float* c, const float* ada_w, const float* ada_b, float* MOD, float* ldsf, int tid, int bid, int G) {
    for (int idx = tid; idx < NB * D; idx += NWAVES * 64) { const int b = idx >> 10, k = idx & 1023; const float x = c[idx]; ldsf[k * 32 + b] = x * sigm_f(x); }
    __syncthreads();
    const int bq = tid >> 7, n = tid & 127;
    for (int grp = bid; grp < DEPTH * 48; grp += G) {
        const int L = grp / 48, n0 = (grp - L * 48) * 128;
        const float* wp = ada_w + (size_t)L * D * (NMOD * D) + n0 + n;
        float acc[8];
#pragma unroll
        for (int i = 0; i < 8; ++i) acc[i] = 0.f;
#pragma unroll 32
        for (int k = 0; k < D; ++k) { const float w = __builtin_nontemporal_load(wp + (size_t)k * (NMOD * D));   const f32x4 c0 = *(const f32x4*)(ldsf + k * 32 + 8 * bq), c1 = *(const f32x4*)(ldsf + k * 32 + 8 * bq + 4);
            acc[0] += w * c0[0]; acc[1] += w * c0[1]; acc[2] += w * c0[2]; acc[3] += w * c0[3]; acc[4] += w * c1[0]; acc[5] += w * c1[1]; acc[6] += w * c1[2]; acc[7] += w * c1[3]; }
        const float bb = ada_b[(size_t)L * (NMOD * D) + n0 + n];
#pragma unroll
        for (int i = 0; i < 8; ++i) MOD[((size_t)L * NB + 8 * bq + i) * (NMOD * D) + n0 + n] = acc[i] + bb;
    }
    __syncthreads();
}

typedef unsigned u32x2v_ __attribute__((ext_vector_type(2)));
__device__ __forceinline__ f32x4 bfx4(const u32x2v_ w) { return (f32x4){__builtin_bit_cast(float, w.x << 16), __builtin_bit_cast(float, w.x & 0xffff0000u), __builtin_bit_cast(float, w.y << 16), __builtin_bit_cast(float, w.y & 0xffff0000u)}; }
template <int XIN, int XOUT>
__device__ __forceinline__ void phase_norm1(const void* xin_, void* xout_, unsigned char* HQ, float* SA, const float* nw, const float* modL  , bool do_norm,
                                            bool combine, const unsigned char* Y, const int* POS, const float* TOPW, const float* modP  , int gw, int NGW, int lane) {
    const float* xin = (const float*)xin_; const bf16* xinh = (const bf16*)xin_; float* xout = (float*)xout_; bf16* xouth = (bf16*)xout_;
#define N1_LOADX(dst, row) do { _Pragma("unroll") for (int j = 0; j < 4; ++j) { if constexpr (XIN == 0) dst[j] = *(const f32x4*)(xin + (size_t)(row) * D + 4 * lane + 256 * j); \
        else dst[j] = bfx4(*(const u32x2v_*)(xinh + (size_t)(row) * D + 4 * lane + 256 * j)); } } while (0)
    for (int r0 = gw * 32; r0 < T; r0 += NGW * 32) {
        const int b = r0 >> 11;
        f32x4 A[4], Bv[4], G2[4];
#pragma unroll
        for (int j = 0; j < 4; ++j) { const int col = 4 * lane + 256 * j;
            if (do_norm) { const f32x4 w = *(const f32x4*)(nw + col), sc = *(const f32x4*)(modL + (size_t)b * 6144 + 1024 + col); A[j] = w * (sc + 1.0f); Bv[j] = *(const f32x4*)(modL + (size_t)b * 6144 + col); }
            else { A[j] = (f32x4){0.f, 0.f, 0.f, 0.f}; Bv[j] = A[j]; }
            G2[j] = combine ? *(const f32x4*)(modP + (size_t)b * 6144 + 5120 + col) : (f32x4){0.f, 0.f, 0.f, 0.f}; }
        int pz0 = 0, pz1 = 0; float wz0 = 0.f, wz1 = 0.f;
        if (combine) { pz0 = POS[r0 * 4 + lane]; pz1 = POS[r0 * 4 + 64 + lane]; wz0 = TOPW[r0 * 4 + lane]; wz1 = TOPW[r0 * 4 + 64 + lane]; }
        f32x4 vn[4]; unsigned yn[TOPK][4];
#pragma unroll
        for (int j = 0; j < 4; ++j) vn[j] = (f32x4){0.f, 0.f, 0.f, 0.f};
        N1_LOADX(vn, r0);
        if (combine) {
#pragma unroll
            for (int k = 0; k < TOPK; ++k) { const int pos = __builtin_amdgcn_readlane(pz0, k);
#pragma unroll
                for (int j = 0; j < 4; ++j) yn[k][j] = *(const unsigned*)(Y + (size_t)pos * D + 4 * lane + 256 * j); }
        }
        for (int r = r0; r < r0 + 32; ++r) {
            f32x4 v[4]; unsigned yc[TOPK][4]; float wk[TOPK];
#pragma unroll
            for (int j = 0; j < 4; ++j) v[j] = vn[j];
            if (combine) {
#pragma unroll
                for (int k = 0; k < TOPK; ++k) { const int q = (r - r0) * 4 + k; wk[k] = (q < 64) ? __builtin_bit_cast(float, __builtin_amdgcn_readlane(__builtin_bit_cast(int, wz0), q)) : __builtin_bit_cast(float, __builtin_amdgcn_readlane(__builtin_bit_cast(int, wz1), q - 64));
#pragma unroll
                    for (int j = 0; j < 4; ++j) yc[k][j] = yn[k][j]; }
            }
            if (r + 1 < r0 + 32) {
                N1_LOADX(vn, r + 1);
                if (combine) {
#pragma unroll
                    for (int k = 0; k < TOPK; ++k) { const int q = (r + 1 - r0) * 4 + k; const int pos = (q < 64) ? __builtin_amdgcn_readlane(pz0, q) : __builtin_amdgcn_readlane(pz1, q - 64);
#pragma unroll
                        for (int j = 0; j < 4; ++j) yn[k][j] = *(const unsigned*)(Y + (size_t)pos * D + 4 * lane + 256 * j); }
                }
            }
            if (combine) {
                f32x4 acc[4];
#pragma unroll
                for (int j = 0; j < 4; ++j) acc[j] = (f32x4){0.f, 0.f, 0.f, 0.f};
#pragma unroll
                for (int k = 0; k < TOPK; ++k) { const float w = wk[k];
#pragma unroll
                    for (int j = 0; j < 4; ++j) { const int y = (int)yc[k][j]; const f32x2_t_ lo = __builtin_amdgcn_cvt_pk_f32_fp8(y, false), hi = __builtin_amdgcn_cvt_pk_f32_fp8(y, true);
                        acc[j][0] += w * lo[0]; acc[j][1] += w * lo[1]; acc[j][2] += w * hi[0]; acc[j][3] += w * hi[1]; } }
#pragma unroll
                for (int j = 0; j < 4; ++j) v[j] = v[j] + G2[j] * acc[j];
            }
            if constexpr (XOUT == 1) {
#pragma unroll
                for (int j = 0; j < 4; ++j) *(f32x4*)(xout + (size_t)r * D + 4 * lane + 256 * j) = v[j];
            } else if constexpr (XOUT == 2) {
#pragma unroll
                for (int j = 0; j < 4; ++j) *(u32x2v_*)(xouth + (size_t)r * D + 4 * lane + 256 * j) = (u32x2v_){pk2(v[j][0], v[j][1]), pk2(v[j][2], v[j][3])};
            }
            if (do_norm) {
                float ss = 0.f;
#pragma unroll
                for (int j = 0; j < 4; ++j) ss += (v[j][0] * v[j][0] + v[j][1] * v[j][1]) + (v[j][2] * v[j][2] + v[j][3] * v[j][3]);
                const float rs = __builtin_amdgcn_rsqf(wave_sum(ss) * (1.0f / D) + EPS);
#pragma unroll
                for (int j = 0; j < 4; ++j) v[j] = v[j] * rs * A[j] + Bv[j];
                float am = 0.f;
#pragma unroll
                for (int j = 0; j < 4; ++j) am = fmaxf(fmaxf(am, fmaxf(fabsf(v[j][0]), fabsf(v[j][1]))), fmaxf(fabsf(v[j][2]), fabsf(v[j][3])));
                am = wave_max(am); const float inv = am > 0.f ? 127.0f / am : 0.f;
#pragma unroll
                for (int j = 0; j < 4; ++j) *(unsigned*)(HQ + (size_t)r * D + 4 * lane + 256 * j) = pack_i8x4(v[j][0] * inv, v[j][1] * inv, v[j][2] * inv, v[j][3] * inv);
                if (lane == 0) SA[r] = am * (1.0f / 127.0f);
            }
        }
    }
}

#undef N1_LOADX

__device__ __forceinline__ void phase_cumsum(const float* FL, float* BIAS, LAS float* scr, int bid, int G, int wave, int lane) {
    for (int pair = bid; pair < NB * 8; pair += G) {
        const int seq = 2 * pair + (wave >> 2), q = wave & 3; const int b = seq >> 4, h = seq & 15;
        const float* src = FL + ((size_t)b * SEQ + 512 * q + 8 * lane) * 16 + h;
        float v[8]; float run = 0.f;
#pragma unroll
        for (int i = 0; i < 8; ++i) { run += src[(size_t)i * 16]; v[i] = run; }
        float inc = run;
#pragma unroll
        for (int d = 1; d < 64; d <<= 1) { const float t = __shfl_up(inc, d); if (lane >= d) inc += t; }
        const float excl = inc - run;
        if (lane == 63) scr[wave] = inc;
        __syncthreads();
        float base = excl;
#pragma unroll
        for (int qq = 0; qq < 3; ++qq) base += (qq < q) ? scr[(wave & 4) + qq] : 0.f;
        float* dst = BIAS + (size_t)seq * SEQ + 512 * q + 8 * lane;
        *(f32x4*)(dst) = (f32x4){-(v[0] + base), -(v[1] + base), -(v[2] + base), -(v[3] + base)}; *(f32x4*)(dst + 4) = (f32x4){-(v[4] + base), -(v[5] + base), -(v[6] + base), -(v[7] + base)};
        __syncthreads();
    }
}

__device__ __forceinline__ void phase_norm2_route(const bf16* X, unsigned char* HQ, float* SA, const float* nw, const float* modL, const float* rw, const float* rb,
                                                  int* TOPI, float* TOPW, int* HIST, unsigned char* lds, int tid, int lane, int wave, int bid, int G) {
    LAS unsigned char* Ll = (LAS unsigned char*)lds;
    LAS float* wl = (LAS float*)(Ll + LSCR_OFF) + wave * (16 * 33);
    LAS int* hist = (LAS int*)(Ll + LSCR_OFF + 8 * 16 * 33 * 4);
    LAS f32x4* ABl = (LAS f32x4*)(Ll + LSCR_OFF + 8 * 16 * 33 * 4 + 256);
    LAS float* cst = (LAS float*)(Ll + LSCR_OFF + 8 * 16 * 33 * 4 + 256 + 8192);
    static_assert(LSCR_OFF + 8 * 16 * 33 * 4 + 256 + 8192 + 128 <= LDSCTL_OFF, "phase F LDS map");
    for (int chunk = bid; chunk < NCHUNK; chunk += G) {
        if (tid < NE) hist[tid] = 0;
        const int b = chunk >> 3;
        if (tid < 256) { const int col = 4 * tid; const f32x4 w = *(const f32x4*)(nw + col), sc = *(const f32x4*)(modL + (size_t)b * 6144 + 4096 + col); ABl[tid] = w * (sc + 1.0f); ABl[256 + tid] = *(const f32x4*)(modL + (size_t)b * 6144 + 3072 + col); }
        __syncthreads();
        { const LAS float* Af = (const LAS float*)ABl; const LAS float* Bf = Af + 1024;
#pragma unroll 2
          for (int item = tid; item < 4096; item += NWAVES * 64) { const int s = item >> 7, mt = (item >> 6) & 1, ln = item & 63; const int e = 16 * mt + (ln & 15), c0 = 32 * s + 8 * (ln >> 4);
              v4u hi, lo;
#pragma unroll
              for (int i2 = 0; i2 < 4; ++i2) { const float w0 = Af[c0 + 2 * i2] * rw[(c0 + 2 * i2) * NE + e], w1 = Af[c0 + 2 * i2 + 1] * rw[(c0 + 2 * i2 + 1) * NE + e];
                  const unsigned h = pk2(w0, w1); hi[i2] = h; lo[i2] = pk2(w0 - __uint_as_float(h << 16), w1 - __uint_as_float(h & 0xffff0000u)); }
              *(LAS v4u*)(Ll + RING_OFF + ((s * 2 + mt) * 2 + 0) * 1024 + ln * 16) = hi; *(LAS v4u*)(Ll + RING_OFF + ((s * 2 + mt) * 2 + 1) * 1024 + ln * 16) = lo; }
          { float p = 0.f;
#pragma unroll 8
            for (int i = 0; i < 64; ++i) { const int c = 128 * wave + 2 * i + (lane >> 5); p += Bf[c] * rw[c * NE + (lane & 31)]; }
            p += __shfl_xor(p, 32);
            if (lane < 32) ((LAS float*)(Ll + LSCR_OFF))[wave * 32 + lane] = p; }
        }
        __syncthreads();
        if (tid < NE) { float p = rb[tid];
#pragma unroll
            for (int w2 = 0; w2 < 8; ++w2) p += ((LAS float*)(Ll + LSCR_OFF))[w2 * 32 + tid];
            cst[tid] = p; }
        __syncthreads();
        const int rbase = chunk * 256 + wave * 32;
        u32x2v_ vr[2][4];
#pragma unroll
        for (int rr = 0; rr < 2; ++rr)
#pragma unroll
            for (int j = 0; j < 4; ++j) vr[rr][j] = *(const u32x2v_*)(X + (size_t)(rbase + rr) * D + 4 * lane + 256 * j);
        float rsv = 0.f;
#pragma unroll 1
        for (int it = 0; it < 16; ++it) {
            const int r0 = rbase + it * 2;
            f32x4 vn[2][4];
#pragma unroll
            for (int rr = 0; rr < 2; ++rr)
#pragma unroll
                for (int j = 0; j < 4; ++j) vn[rr][j] = bfx4(vr[rr][j]);
            if (it < 15) {
#pragma unroll
                for (int rr = 0; rr < 2; ++rr)
#pragma unroll
                    for (int j = 0; j < 4; ++j) vr[rr][j] = *(const u32x2v_*)(X + (size_t)(r0 + 2 + rr) * D + 4 * lane + 256 * j);
            }
#pragma unroll
            for (int rr = 0; rr < 2; ++rr) {
                float ss = 0.f;
#pragma unroll
                for (int j = 0; j < 4; ++j) ss += (vn[rr][j][0] * vn[rr][j][0] + vn[rr][j][1] * vn[rr][j][1]) + (vn[rr][j][2] * vn[rr][j][2] + vn[rr][j][3] * vn[rr][j][3]);
                const float rs = __builtin_amdgcn_rsqf(wave_sum(ss) * (1.0f / D) + EPS);
                if (lane == (it & 7) * 2 + rr) rsv = rs;
                float am = 0.f; f32x4 h[4];
#pragma unroll
                for (int j = 0; j < 4; ++j) { h[j] = vn[rr][j] * rs * ABl[lane + 64 * j] + ABl[256 + lane + 64 * j]; am = fmaxf(fmaxf(am, fmaxf(fabsf(h[j][0]), fabsf(h[j][1]))), fmaxf(fabsf(h[j][2]), fabsf(h[j][3]))); }
                am = wave_max(am); const float inv = am > 0.f ? 127.0f / am : 0.f;
#pragma unroll
                for (int j = 0; j < 4; ++j) *(unsigned*)(HQ + (size_t)(r0 + rr) * D + 4 * lane + 256 * j) = pack_i8x4(h[j][0] * inv, h[j][1] * inv, h[j][2] * inv, h[j][3] * inv);
                if (lane == 0) SA[r0 + rr] = am * (1.0f / 127.0f);
            }
            if ((it & 7) == 7) {
                const int R0 = r0 - 14;
                const bf16* xr = X + (size_t)(R0 + (lane & 15)) * D + 8 * (lane >> 4);
                f32x4 acc[2][2];
#pragma unroll
                for (int mt = 0; mt < 2; ++mt)
#pragma unroll
                    for (int p = 0; p < 2; ++p) acc[mt][p] = (f32x4){0.f, 0.f, 0.f, 0.f};
#pragma unroll 8
                for (int s = 0; s < 32; ++s) { const bf16x8 xf = *(const bf16x8*)(xr + 32 * s);
#pragma unroll
                    for (int mt = 0; mt < 2; ++mt)
#pragma unroll
                        for (int p = 0; p < 2; ++p) { const bf16x8 wf = *(const LAS bf16x8*)(Ll + RING_OFF + ((s * 2 + mt) * 2 + p) * 1024 + lane * 16); acc[mt][p] = __builtin_amdgcn_mfma_f32_16x16x32_bf16(wf, xf, acc[mt][p], 0, 0, 0); } }
                const float rst = __shfl(rsv, lane & 15);
                const f32x4 c0v = *(const LAS f32x4*)(cst + 4 * (lane >> 4)), c1v = *(const LAS f32x4*)(cst + 16 + 4 * (lane >> 4));
                const f32x4 l0 = (acc[0][0] + acc[0][1]) * rst + c0v, l1 = (acc[1][0] + acc[1][1]) * rst + c1v;
#pragma unroll
                for (int r = 0; r < 4; ++r) { wl[(lane & 15) * 33 + 4 * (lane >> 4) + r] = l0[r]; wl[(lane & 15) * 33 + 16 + 4 * (lane >> 4) + r] = l1[r]; }
                asm volatile("s_waitcnt lgkmcnt(0)" ::: "memory");
                if (lane < 16) {
                    float l[32];
#pragma unroll
                    for (int e = 0; e < 32; ++e) l[e] = wl[lane * 33 + e];
                    int sel[4]; float val[4];
#pragma unroll
                    for (int k = 0; k < 4; ++k) { float best = l[0]; int bi = 0;
#pragma unroll
                        for (int e = 1; e < 32; ++e) { if (l[e] > best) { best = l[e]; bi = e; } }
                        sel[k] = bi; val[k] = best;
#pragma unroll
                        for (int e = 0; e < 32; ++e) l[e] = (e == bi) ? -INFINITY : l[e]; }
                    const float e1 = __expf(val[1] - val[0]), e2 = __expf(val[2] - val[0]), e3 = __expf(val[3] - val[0]); const float inv = 1.0f / (1.0f + e1 + e2 + e3);
                    const int r = R0 + lane;
                    *(int4*)(TOPI + (size_t)r * 4) = make_int4(sel[0], sel[1], sel[2], sel[3]); *(float4*)(TOPW + (size_t)r * 4) = make_float4(inv, e1 * inv, e2 * inv, e3 * inv);
                    atomicAdd((int*)&hist[sel[0]], 1); atomicAdd((int*)&hist[sel[1]], 1); atomicAdd((int*)&hist[sel[2]], 1); atomicAdd((int*)&hist[sel[3]], 1);
                }
                asm volatile("s_waitcnt lgkmcnt(0)" ::: "memory");
            }
        }
        __syncthreads();
        if (tid < NE) HIST[chunk * NE + tid] = hist[tid];
        __syncthreads();
    }
}

__device__ __forceinline__ void phase_scatter(const int* TOPI, int* POS, int* ROWTOK, float* SAROW, const float* SA, const int* HIST, int* ROUTE, unsigned char* lds, int tid, int lane, int wave, int bid, int G) {
    int* part = (int*)(lds + RING_OFF);
    int* tot_s = part + 1024; int* bef_s = tot_s + 32; int* pst_s = bef_s + 32; int* base_s = pst_s + 32; int* wcnt = base_s + 32;
    for (int chunk = bid; chunk < NCHUNK; chunk += G) {
        { const int e = tid & 31, p = tid >> 5; int t = 0, bf = 0;
          for (int c2 = p * 16; c2 < p * 16 + 16; ++c2) { const int hv = HIST[c2 * NE + e]; t += hv; bf += (c2 < chunk) ? hv : 0; }
          part[p * 32 + e] = t; part[512 + p * 32 + e] = bf; }
        const int a0 = wave * 128 + lane, a1 = a0 + 64;
        const int e0 = TOPI[(size_t)chunk * 1024 + a0], e1 = TOPI[(size_t)chunk * 1024 + a1];
        int r0 = 0, r1 = 0, cnt_me = 0;
        const unsigned long long lt = (1ull << lane) - 1ull;
#pragma unroll 4
        for (int e = 0; e < NE; ++e) { const unsigned long long m0 = __ballot(e0 == e), m1 = __ballot(e1 == e); const int c0 = __popcll(m0), c1 = __popcll(m1);
            if (e0 == e) r0 = __popcll(m0 & lt); if (e1 == e) r1 = c0 + __popcll(m1 & lt); if (lane == e) cnt_me = c0 + c1; }
        if (lane < NE) wcnt[wave * 32 + lane] = cnt_me;
        __syncthreads();
        if (tid < NE) { int t = 0, bf = 0; for (int p = 0; p < 16; ++p) { t += part[p * 32 + tid]; bf += part[512 + p * 32 + tid]; } tot_s[tid] = t; bef_s[tid] = bf; }
        __syncthreads();
        if (tid == 0) { int run = 0; for (int e = 0; e < NE; ++e) { const int padded = (tot_s[e] + 255) & ~255; pst_s[e] = run; base_s[e] = run + bef_s[e]; run += padded; }
            if (chunk == 0) ROUTE[RT_NTILES] = run >> 8; }
        __syncthreads();
        if (chunk == 0) {
            if (tid < NE) { const int t0 = pst_s[tid] >> 8, t1 = (pst_s[tid] + ((tot_s[tid] + 255) & ~255)) >> 8; for (int t = t0; t < t1; ++t) ROUTE[RT_TEXP + t] = tid; }
            if (tid < 256) for (int e = 0; e < NE; ++e) { const int p = pst_s[e] + tot_s[e] + tid; if (p < pst_s[e] + ((tot_s[e] + 255) & ~255)) { ROWTOK[p] = 0; SAROW[p] = 0.f; } }
        }
        int wp0 = 0, wp1 = 0;
        for (int w2 = 0; w2 < wave; ++w2) { wp0 += wcnt[w2 * 32 + e0]; wp1 += wcnt[w2 * 32 + e1]; }
        const int p0 = base_s[e0] + wp0 + r0, p1 = base_s[e1] + wp1 + r1;
        POS[(size_t)chunk * 1024 + a0] = p0; POS[(size_t)chunk * 1024 + a1] = p1;
        { const int tk0 = chunk * 256 + (a0 >> 2), tk1 = chunk * 256 + (a1 >> 2); ROWTOK[p0] = tk0; ROWTOK[p1] = tk1; SAROW[p0] = SA[tk0]; SAROW[p1] = SA[tk1]; }
        __syncthreads();
    }
}

namespace hg {
typedef short s16x4 __attribute__((ext_vector_type(4)));
typedef float f32x16 __attribute__((ext_vector_type(16)));
constexpr int QS = 136, OSS = 129, TP = 144;
constexpr int QT_B = 32 * QS * 2, TR_B = 128 * TP, OS_B = 32 * OSS * 4;
constexpr int L_QT = 0, L_KT = L_QT + 2 * QT_B, L_KH = L_KT + QT_B, L_VT = L_KH + 2 * TR_B, L_DEC = L_VT + 2 * TR_B, L_OSI = L_DEC + 2 * 512, L_OSS = L_OSI + 2 * OS_B, L_END = L_OSS + OS_B;
static_assert(L_END <= LDSCTL_OFF, "hgrn LDS map");
__device__ __forceinline__ int crow(int r, int hi) { return (r & 3) + 8 * (r >> 2) + 4 * hi; }
__device__ __forceinline__ int tchunk(int d, int sc) { return d * TP + ((sc ^ ((d >> 3) & 7)) << 4); }
struct Raw2 { v4u q[2], k[2], v[2]; f32x4 l[2][2]; };
__device__ __forceinline__ void load_raw2(Raw2& R, const bf16* Pq, const float* LF, const bf16* Pk, const bf16* Pv, size_t off) {
#pragma unroll
    for (int a = 0; a < 2; ++a) { const size_t o = off + (size_t)a * D; R.q[a] = *(const v4u*)(Pq + o); R.k[a] = *(const v4u*)(Pk + o); R.v[a] = *(const v4u*)(Pv + o); R.l[a][0] = *(const f32x4*)(LF + o); R.l[a][1] = *(const f32x4*)(LF + o + 4); } }
__device__ __forceinline__ float bflo(unsigned w) { return __uint_as_float(w << 16); }
__device__ __forceinline__ float bfhi(unsigned w) { return __uint_as_float(w & 0xffff0000u); }
}
__device__ __forceinline__ void phase_hgrn(const bf16* Pq, const float* LF, const bf16* Pk, const bf16* Pv, const bf16* Pg, bf16* AO, const float* gnorm,
                                           LAS unsigned char* lds, int tid, int lane, int wave, int bid, int G) {
    using namespace hg;
    const bool isS = wave >= 4; const int gw4 = wave & 3;
    constexpr int NCH = SEQ / 32;
    for (int bh = bid; bh < NB * 8; bh += G) {
        const int b = bh >> 3, h = bh & 7;
        const size_t hbase = (size_t)b * SEQ * D + h * 128;
        const size_t pbase = hbase + (size_t)(2 * (lane >> 2)) * D + 32 * gw4 + 8 * (lane & 3);
        const int gtid = gw4 * 64 + lane; const size_t ebase = hbase + (size_t)(gtid >> 3) * D + 16 * (gtid & 7);
#define HG_P(i, R) do { \
            int lane_ = lane; asm volatile("" : "+v"(lane_));     \
            const int r_ = lane_ & 31, hh_ = lane_ >> 5; const int bi = (i) & 1, bp = ((i) + 1) & 1;     \
            LBAR(); \
            if ((i) < NCH) { \
                  \
                const int tg_ = lane_ >> 2, c_ = lane_ & 3; const int d0 = 32 * gw4 + 8 * c_; \
                float ya[8], tot[8], pr[8]; \
                _Pragma("unroll") for (int e = 0; e < 8; ++e) { ya[e] = R.l[0][e >> 2][e & 3]; pr[e] = ya[e] + R.l[1][e >> 2][e & 3]; tot[e] = pr[e]; } \
                _Pragma("unroll") for (int sh = 4; sh < 64; sh <<= 1) { _Pragma("unroll") for (int e = 0; e < 8; ++e) { const float u = __shfl_up(tot[e], sh); if (lane_ >= sh) tot[e] += u; } } \
                float bend[8]; _Pragma("unroll") for (int e = 0; e < 8; ++e) bend[e] = __shfl(tot[e], 60 + c_); \
                unsigned qo[2][4], ko[2][4]; \
                const int tb_ = tchunk(d0, tg_ >> 2) + (tg_ & 3) * 4;     \
                _Pragma("unroll") for (int p = 0; p < 4; ++p) { \
                    const float ba0 = tot[2 * p] - pr[2 * p] + ya[2 * p], ba1 = tot[2 * p + 1] - pr[2 * p + 1] + ya[2 * p + 1], bb0 = tot[2 * p], bb1 = tot[2 * p + 1];     \
                    const unsigned qa = R.q[0][p], qb = R.q[1][p], ka = R.k[0][p], kb = R.k[1][p], va = R.v[0][p], vb = R.v[1][p]; \
                    const float ka0 = bflo(ka), ka1 = bfhi(ka), kb0 = bflo(kb), kb1 = bfhi(kb); \
                    qo[0][p] = pk2(bflo(qa) * __builtin_amdgcn_exp2f(ba0), bfhi(qa) * __builtin_amdgcn_exp2f(ba1)); qo[1][p] = pk2(bflo(qb) * __builtin_amdgcn_exp2f(bb0), bfhi(qb) * __builtin_amdgcn_exp2f(bb1)); \
                    ko[0][p] = pk2(ka0 * __builtin_amdgcn_exp2f(fminf(-ba0, 115.0f)), ka1 * __builtin_amdgcn_exp2f(fminf(-ba1, 115.0f))); ko[1][p] = pk2(kb0 * __builtin_amdgcn_exp2f(fminf(-bb0, 115.0f)), kb1 * __builtin_amdgcn_exp2f(fminf(-bb1, 115.0f))); \
                      \
                    const unsigned kh0 = pk2(ka0 * __builtin_amdgcn_exp2f(bend[2 * p] - ba0), kb0 * __builtin_amdgcn_exp2f(bend[2 * p] - bb0)), kh1 = pk2(ka1 * __builtin_amdgcn_exp2f(bend[2 * p + 1] - ba1), kb1 * __builtin_amdgcn_exp2f(bend[2 * p + 1] - bb1)); \
                    const unsigned vt0 = (va & 0xffffu) | (vb << 16), vt1 = (va >> 16) | (vb & 0xffff0000u); \
                    *(LAS unsigned*)(lds + L_KH + bi * TR_B + tb_ + 2 * TP * p) = kh0; *(LAS unsigned*)(lds + L_KH + bi * TR_B + tb_ + 2 * TP * p + TP) = kh1; \
                    *(LAS unsigned*)(lds + L_VT + bi * TR_B + tb_ + 2 * TP * p) = vt0; *(LAS unsigned*)(lds + L_VT + bi * TR_B + tb_ + 2 * TP * p + TP) = vt1; } \
                _Pragma("unroll") for (int a = 0; a < 2; ++a) { *(LAS v4u*)(lds + L_QT + bi * QT_B + ((2 * tg_ + a) * QS + d0) * 2) = (v4u){qo[a][0], qo[a][1], qo[a][2], qo[a][3]}; *(LAS v4u*)(lds + L_KT + ((2 * tg_ + a) * QS + d0) * 2) = (v4u){ko[a][0], ko[a][1], ko[a][2], ko[a][3]}; } \
                if (tg_ == 0) { *(LAS f32x4*)(lds + L_DEC + bi * 512 + d0 * 4) = (f32x4){__builtin_amdgcn_exp2f(bend[0]), __builtin_amdgcn_exp2f(bend[1]), __builtin_amdgcn_exp2f(bend[2]), __builtin_amdgcn_exp2f(bend[3])}; *(LAS f32x4*)(lds + L_DEC + bi * 512 + (d0 + 4) * 4) = (f32x4){__builtin_amdgcn_exp2f(bend[4]), __builtin_amdgcn_exp2f(bend[5]), __builtin_amdgcn_exp2f(bend[6]), __builtin_amdgcn_exp2f(bend[7])}; } \
                load_raw2(R, Pq, LF, Pk, Pv, pbase + (size_t)(((i) + 2 < NCH) ? (i) + 2 : NCH - 1) * 32 * D);     \
            } \
            LBAR(); \
            if ((i) < NCH) { \
                  \
                const int dvt = gw4; \
                f32x16 pt; _Pragma("unroll") for (int e = 0; e < 16; ++e) pt[e] = 0.f; \
                _Pragma("unroll") for (int ks = 0; ks < 8; ++ks) { const bf16x8 a = *(const LAS bf16x8*)(lds + L_KT + (r_ * QS + 16 * ks + 8 * hh_) * 2), bq = *(const LAS bf16x8*)(lds + L_QT + bi * QT_B + (r_ * QS + 16 * ks + 8 * hh_) * 2); pt = __builtin_amdgcn_mfma_f32_32x32x16_bf16(a, bq, pt, 0, 0, 0); } \
                f32x16 oi; _Pragma("unroll") for (int e = 0; e < 16; ++e) oi[e] = 0.f; \
                _Pragma("unroll") for (int ks2 = 0; ks2 < 2; ++ks2) { unsigned w[4]; \
                    _Pragma("unroll") for (int jp = 0; jp < 4; ++jp) { const int r0 = 8 * ks2 + 2 * jp, r1 = r0 + 1; const float x0 = (crow(r0, hh_) <= r_) ? pt[r0] : 0.f, x1 = (crow(r1, hh_) <= r_) ? pt[r1] : 0.f; w[jp] = pk2(x0, x1); } \
                    const bf16x8 pa = __builtin_bit_cast(bf16x8, (v4u){w[0], w[1], w[2], w[3]}); const int dv = 32 * dvt + r_; \
                    const s16x4 lo = *(const LAS s16x4*)(lds + L_VT + bi * TR_B + tchunk(dv, 2 * ks2) + 8 * hh_), hi4 = *(const LAS s16x4*)(lds + L_VT + bi * TR_B + tchunk(dv, 2 * ks2 + 1) + 8 * hh_); \
                    const bf16x8 vb = (bf16x8){lo[0], lo[1], lo[2], lo[3], hi4[0], hi4[1], hi4[2], hi4[3]}; oi = __builtin_amdgcn_mfma_f32_32x32x16_bf16(pa, vb, oi, 0, 0, 0); } \
                _Pragma("unroll") for (int e = 0; e < 16; ++e) ((LAS float*)(lds + L_OSI + bi * OS_B))[crow(e, hh_) * OSS + 32 * dvt + r_] = oi[e]; \
            } \
        } while (0)
#define HG_S(i, G0, G1) do { \
            int lane_ = lane; asm volatile("" : "+v"(lane_));     \
            const int r_ = lane_ & 31, hh_ = lane_ >> 5; const int bi = (i) & 1, bp = ((i) + 1) & 1;     \
            LBAR(); \
            if ((i) >= 1) { \
                  \
                const int dvt = gw4; \
                f32x16 ot; _Pragma("unroll") for (int e = 0; e < 16; ++e) ot[e] = 0.f; \
                _Pragma("unroll") for (int dkt = 0; dkt < 4; ++dkt) { \
                    _Pragma("unroll") for (int s2 = 0; s2 < 2; ++s2) { unsigned w[4]; \
                        _Pragma("unroll") for (int jp = 0; jp < 4; ++jp) w[jp] = pk2(st[dkt][8 * s2 + 2 * jp], st[dkt][8 * s2 + 2 * jp + 1]); \
                        const bf16x8 xb = __builtin_bit_cast(bf16x8, (v4u){w[0], w[1], w[2], w[3]}); \
                        const s16x4 lo = *(const LAS s16x4*)(lds + L_QT + bp * QT_B + (r_ * QS + 32 * dkt + 16 * s2 + 4 * hh_) * 2), hi4 = *(const LAS s16x4*)(lds + L_QT + bp * QT_B + (r_ * QS + 32 * dkt + 16 * s2 + 8 + 4 * hh_) * 2); \
                        const bf16x8 a = (bf16x8){lo[0], lo[1], lo[2], lo[3], hi4[0], hi4[1], hi4[2], hi4[3]}; ot = __builtin_amdgcn_mfma_f32_32x32x16_bf16(a, xb, ot, 0, 0, 0); } } \
                _Pragma("unroll") for (int e = 0; e < 16; ++e) ((LAS float*)(lds + L_OSS))[crow(e, hh_) * OSS + 32 * dvt + r_] = ot[e]; \
                bf16x8 vb2[2]; _Pragma("unroll") for (int ks2 = 0; ks2 < 2; ++ks2) vb2[ks2] = *(const LAS bf16x8*)(lds + L_VT + bp * TR_B + tchunk(32 * dvt + r_, 2 * ks2 + hh_)); \
                _Pragma("unroll") for (int dkt = 0; dkt < 4; ++dkt) { \
                    _Pragma("unroll") for (int g4 = 0; g4 < 4; ++g4) { const f32x4 dc = *(const LAS f32x4*)(lds + L_DEC + bp * 512 + (32 * dkt + 8 * g4 + 4 * hh_) * 4); \
                        _Pragma("unroll") for (int e = 0; e < 4; ++e) st[dkt][4 * g4 + e] *= dc[e]; } \
                    _Pragma("unroll") for (int ks2 = 0; ks2 < 2; ++ks2) { const bf16x8 a = *(const LAS bf16x8*)(lds + L_KH + bp * TR_B + tchunk(32 * dkt + r_, 2 * ks2 + hh_)); \
                        st[dkt] = __builtin_amdgcn_mfma_f32_32x32x16_bf16(a, vb2[ks2], st[dkt], 0, 0, 0); } } \
            } \
            LBAR(); \
            if ((i) >= 1) { \
                  \
                int gt_ = gtid; asm volatile("" : "+v"(gt_)); const int t_ = gt_ >> 3, c16_ = gt_ & 7; \
                float o[16]; float ss = 0.f; \
                _Pragma("unroll") for (int e = 0; e < 16; ++e) { o[e] = ((LAS float*)(lds + L_OSS))[t_ * OSS + 16 * c16_ + e] + ((LAS float*)(lds + L_OSI + bp * OS_B))[t_ * OSS + 16 * c16_ + e]; ss += o[e] * o[e]; } \
                ss += __shfl_xor(ss, 1); ss += __shfl_xor(ss, 2); ss += __shfl_xor(ss, 4); \
                const float rs = __builtin_amdgcn_rsqf(ss * (1.0f / 128.0f) + EPS); \
                const unsigned gw8[8] = {G0.x, G0.y, G0.z, G0.w, G1.x, G1.y, G1.z, G1.w}; float of[16]; \
                _Pragma("unroll") for (int p = 0; p < 8; ++p) { of[2 * p] = __builtin_amdgcn_fmed3f(o[2 * p] * rs * gnv[p >> 1][(2 * p) & 3] * bflo(gw8[p]) * AO_SCALE, -448.0f, 448.0f); of[2 * p + 1] = __builtin_amdgcn_fmed3f(o[2 * p + 1] * rs * gnv[p >> 1][(2 * p + 1) & 3] * bfhi(gw8[p]) * AO_SCALE, -448.0f, 448.0f); } \
                *(v4u*)((unsigned char*)AO + ebase + (size_t)((i) - 1) * 32 * D) = (v4u){pk_fp8x4m(of[0], of[1], of[2], of[3]), pk_fp8x4m(of[4], of[5], of[6], of[7]), pk_fp8x4m(of[8], of[9], of[10], of[11]), pk_fp8x4m(of[12], of[13], of[14], of[15])}; \
                if ((i) + 1 < NCH) { G0 = *(const v4u*)(Pg + ebase + (size_t)((i) + 1) * 32 * D); G1 = *(const v4u*)(Pg + ebase + (size_t)((i) + 1) * 32 * D + 8); } \
            } \
        } while (0)
        if (!isS) {
            Raw2 RA, RB; load_raw2(RA, Pq, LF, Pk, Pv, pbase); load_raw2(RB, Pq, LF, Pk, Pv, pbase + (size_t)32 * D);
#pragma unroll 1
            for (int i = 0; i < NCH; i += 2) { HG_P(i, RA); HG_P(i + 1, RB); }
            HG_P(NCH, RA);
        } else {
            f32x16 st[4];
#pragma unroll
            for (int q = 0; q < 4; ++q)
#pragma unroll
                for (int e = 0; e < 16; ++e) st[q][e] = 0.f;
            v4u ga0 = *(const v4u*)(Pg + ebase), ga1 = *(const v4u*)(Pg + ebase + 8), gb0 = *(const v4u*)(Pg + ebase + (size_t)32 * D), gb1 = *(const v4u*)(Pg + ebase + (size_t)32 * D + 8);
            f32x4 gnv[4];
#pragma unroll
            for (int q = 0; q < 4; ++q) gnv[q] = *(const f32x4*)(gnorm + 16 * (gtid & 7) + 4 * q);
#pragma unroll 1
            for (int i = 0; i < NCH; i += 2) { HG_S(i, gb0, gb1); HG_S(i + 1, ga0, ga1); }
            HG_S(NCH, gb0, gb1);
        }
#undef HG_P
#undef HG_S
        LBAR();
    }
}

struct Args { const float* in[21]; float* out; unsigned char* ws; int ph_lo, ph_hi; };
#ifndef MK_PER_PHASE
#define MK_PER_PHASE 0
#endif
constexpr int PH_PER_LAYER = 9;
constexpr int N_PHASES = 1 + DEPTH * PH_PER_LAYER + 1;

#ifndef PH_MASK
#define PH_MASK 0xFFF
#endif
#ifndef SUB_MASK
#define SUB_MASK 3
#endif
#define EN(b) ((PH_MASK >> (b)) & 1)
#ifndef REP_MASK
#define REP_MASK 0
#endif
#define NREP(b) (((REP_MASK >> (b)) & 1) ? 2 : 1)
#define SUBEN(b) ((SUB_MASK >> (b)) & 1)
#define IN(k) in_range(k)
#define SEAM(k) do { if (IN((k) + 1)) { if (MK_PER_PHASE) { } else { CArgs& a_ = kargs(); XcdBarrier bar_; bar_.bar = (unsigned*)(a_.ws + WS_CTL) + CW_BAR; bar_.x = xb_xcc_id(); bar_.st = (volatile LAS unsigned*)(ldsl + MISC_OFF) + 8; bar_.w = wave; xcd_barrier(bar_); } } } while (0)
typedef const __attribute__((address_space(4))) Args CArgs;
__device__ __forceinline__ CArgs& kargs() { CArgs* p = (CArgs*)__builtin_amdgcn_kernarg_segment_ptr(); asm volatile("" : "+s"(p)); return *p; }
__device__ __forceinline__ bool in_range(int k) { CArgs& a = kargs(); return a.ph_lo <= k && k < a.ph_hi; }
#define WSP(T_, off) ((T_*)(ws + (off)))
constexpr size_t PSTR = (size_t)T * D;

template <int L>
__device__ __forceinline__ void run_layer(unsigned char* lds, LAS unsigned char* ldsl, const int wave) {
    constexpr int pb = 1 + L * PH_PER_LAYER; constexpr int j = L >> 1; constexpr bool fox = (L & 1) == 0;
    const int G = gridDim.x, bid = blockIdx.x; const int gw = bid * NWAVES + wave, NGW = G * NWAVES;
    if (EN(1) && IN(pb + 0)) {
        CArgs& a = kargs(); unsigned char* ws = a.ws; const int lane = mk_lane();
        const float* modL = WSP(float, WS_MOD) + (size_t)L * NB * 6144;
        if constexpr (L == 0) phase_norm1<0, 0>(a.in[0], nullptr, WSP(unsigned char, WS_HN), WSP(float, WS_SA), a.in[13] + (size_t)L * D, modL, true, false, WSP(unsigned char, WS_R1), WSP(int, WS_POS), WSP(float, WS_TOPW), modL - (size_t)NB * 6144, gw, NGW, lane);
        else phase_norm1<1, 2>(WSP(bf16, WS_XB), WSP(bf16, WS_XB), WSP(unsigned char, WS_HN), WSP(float, WS_SA), a.in[13] + (size_t)L * D, modL, true, true, WSP(unsigned char, WS_R1), WSP(int, WS_POS), WSP(float, WS_TOPW), modL - (size_t)NB * 6144, gw, NGW, lane);
        if constexpr (L == 0) {
            for (int it = gw; it < 8 * 130; it += NGW) { int r = it; int m = 0;
                if (r >= 8 * 33) { r -= 8 * 33; m = 1; if (r >= 8 * 33) { r -= 8 * 33; m = 2; if (r >= 8 * 32) { r -= 8 * 32; m = 3; } } }
                if (m < 2) convert_mat_i8(a.in[2] + (size_t)m * D * 4112, 4112, 4112, 33, WSP(float, WS_PARTM) + (size_t)m * 4 * 4352, WSP(unsigned char, WS_WFI) + (size_t)m * NFOXP * D, WSP(float, WS_SWM) + m * 4352, OrFoxIn(), ldsl + RING_OFF + wave * 16384, r, lane);
                else convert_mat_i8(a.in[7] + (size_t)(m - 2) * D * 4096, 4096, 4096, 32, WSP(float, WS_PARTM) + (size_t)m * 4 * 4352, WSP(unsigned char, WS_WHI) + (size_t)(m - 2) * 4096 * D, WSP(float, WS_SWM) + m * 4352, OrIdent(), ldsl + RING_OFF + wave * 16384, r, lane); }
        }
        for (int rp_ = 0; rp_ < NREP(1); ++rp_)
        { convert_down_f8(a.in[19] + (size_t)L * NE * D * D, WSP(unsigned char, WS_WDN), ldsl + RING_OFF + wave * 16384, gw, NGW, lane);
 }
        __syncthreads();
        if constexpr (!fox) {
            for (int it = bid; it < NE * 16; it += G) { const int e = it >> 4, ct = it & 15;
                convert_strip_i8(a.in[17] + ((size_t)L * NE + e) * D * 2048, 2048, WSP(unsigned char, WS_WGU) + (size_t)e * 2048 * D, WSP(float, WS_SW) + (size_t)e * 2048, OrGu(), 128 * ct, (LAS float*)(ldsl + LSCR_OFF), ldsl + RING_OFF + wave * 16384, wave, lane); }
            __syncthreads();
        }
        SEAM(pb + 0);
    }
    if (EN(2) && IN(pb + 1)) {
        CArgs& a = kargs(); unsigned char* ws = a.ws;
        for (int rp_ = 0; rp_ < NREP(2); ++rp_) { if (rp_) __syncthreads();
        if constexpr (fox) { if (SUBEN(0)) {
            pg8::Gemm g{WSP(bf16, WS_HN), WSP(bf16, WS_WFI) + (size_t)j * NFOXP * (D / 2), T, NFOXP, D / 2}; pg8::StaticOrder S; S.init(T, NFOXP, G, bid);
            pg8::EpiFoxT<true> E{WSP(bf16, WS_R1), PSTR, WSP(float, WS_FL), a.in[4] + j * 64, a.in[5] + j * 64, a.in[3] + j * 16, attn_body::C2, WSP(float, WS_SA), WSP(float, WS_SWM) + j * 4352};
            pg8::gemm_phase<pg8::EpiFoxT<true>, pg8::StaticOrder, true, true, true>(ldsl + RING_OFF, g, S, E, wave);
        } } else { if (SUBEN(1)) {
            pg8::Gemm g{WSP(bf16, WS_HN), WSP(bf16, WS_WHI) + (size_t)j * 4096 * (D / 2), T, 4096, D / 2}; pg8::StaticOrder S; S.init(T, 4096, G, bid);
            pg8::EpiHgrnT<true> E{WSP(bf16, WS_R1), PSTR, WSP(float, WS_ACT), a.in[8], a.in[8] + D, j, WSP(float, WS_SA), WSP(float, WS_SWM) + (2 + j) * 4352};
            pg8::gemm_phase<pg8::EpiHgrnT<true>, pg8::StaticOrder, true, true, true>(ldsl + RING_OFF, g, S, E, wave);
        } } }
        SEAM(pb + 1);
    }
    if constexpr (fox) if (EN(3) && IN(pb + 2)) {
        CArgs& a = kargs(); unsigned char* ws = a.ws; const int lane = mk_lane();
        phase_cumsum(WSP(float, WS_FL), WSP(float, WS_BIAS), (LAS float*)(ldsl + LSCR_OFF), bid, G, wave, lane);
        __syncthreads();
        SEAM(pb + 2);
    }
    if (EN(4) && IN(pb + 3)) {
        CArgs& a = kargs(); unsigned char* ws = a.ws; bf16* P0 = WSP(bf16, WS_R1); bf16* AO = WSP(bf16, WS_R1 + 512 * MiB);
        for (int rp_ = 0; rp_ < NREP(4); ++rp_) { if (rp_) __syncthreads();
        if constexpr (fox) { if (SUBEN(0)) {
            float skipthr; { const int l_ = mk_lane(); const float mq = wave_max(fabsf(a.in[4][j * 64 + l_])), mk = wave_max(fabsf(a.in[5][j * 64 + l_])); skipthr = 64.0f + 2.0f * 64.0f * attn_body::C2 * mq * mk * 1.01f; }
            const attn_body::AttnTensors AT{(const attn_body::bf16*)P0, (const attn_body::bf16*)(P0 + PSTR), (const attn_body::bf16*)(P0 + 2 * PSTR), (attn_body::bf16*)AO, (const attn_body::bf16*)(P0 + 3 * PSTR), WSP(float, WS_BIAS), skipthr};
            const attn_body::StaticOrder S(G, bid);
            auto conv_item = [&](int it) { if (it < NE * 16) { const int e = it >> 4, ct = it & 15; const int lane_ = mk_lane();
                convert_strip_i8(a.in[17] + ((size_t)L * NE + e) * D * 2048, 2048, WSP(unsigned char, WS_WGU) + (size_t)e * 2048 * D, WSP(float, WS_SW) + (size_t)e * 2048, OrGu(), 128 * ct, (LAS float*)(ldsl + LSCR_OFF), ldsl + RING_OFF + wave * 16384, wave, lane_); } };
            const int slot0 = (bid >> 3) & 7, slot1 = 8 + (((bid >> 3) + 3) & 7);
            auto hook = [&](int i) -> bool { if (i != slot0 && i != slot1) return false; conv_item(bid + (i >> 3) * G); return true; };
            attn_body::attn_phase<attn_body::StaticOrder>((char*)lds + RING_OFF, AT, S, wave, hook);
            { const int nheads = (NB * 16 - bid + G - 1) / G; __syncthreads(); for (int it = bid + (nheads < 2 ? nheads : 2) * G; it < NE * 16; it += G) conv_item(it); }
        } } else { if (SUBEN(1)) {
            const int lane = mk_lane();
            phase_hgrn(P0, WSP(float, WS_ACT), P0 + PSTR, P0 + 2 * PSTR, P0 + 3 * PSTR, AO, a.in[9] + j * 128, ldsl + RING_OFF, wave * 64 + lane, lane, wave, bid, G);
        } } }
        SEAM(pb + 3);
    }
    if (EN(5) && IN(pb + 4)) {
        CArgs& a = kargs(); unsigned char* ws = a.ws;
        pg8::Gemm g{WSP(bf16, WS_R1 + 512 * MiB), WSP(bf16, (fox ? WS_WFO : WS_WHO) + (size_t)j * D * D), T, D, D / 2}; pg8::StaticOrder S; S.init(T, D, G, bid);
        pg8::EpiResidT<L == 0> E{a.in[0], WSP(bf16, WS_XB), WSP(bf16, WS_XB), WSP(float, WS_MOD) + (size_t)L * NB * 6144 + 2048, 1.0f / (AO_SCALE * F8_WSCALE)};
        pg8::gemm_phase<pg8::EpiResidT<L == 0>, pg8::StaticOrder, true, true, false, true>(ldsl + RING_OFF, g, S, E, wave);
        SEAM(pb + 4);
    }
    if (EN(6) && IN(pb + 5)) {
        CArgs& a = kargs(); unsigned char* ws = a.ws; const int lane = mk_lane();
        for (int rp_ = 0; rp_ < NREP(6); ++rp_)
        phase_norm2_route(WSP(bf16, WS_XB), WSP(unsigned char, WS_HN), WSP(float, WS_SA), a.in[14] + (size_t)L * D, WSP(float, WS_MOD) + (size_t)L * NB * 6144, a.in[15] + (size_t)L * D * NE, a.in[16] + (size_t)L * NE,
                          WSP(int, WS_TOPI), WSP(float, WS_TOPW), WSP(int, WS_ROUTE) + RT_HIST, lds, wave * 64 + lane, lane, wave, bid, G);
        SEAM(pb + 5);
    }
    if (EN(7) && IN(pb + 6)) {
        CArgs& a = kargs(); unsigned char* ws = a.ws; const int lane = mk_lane();
        for (int rp_ = 0; rp_ < NREP(7); ++rp_)
        phase_scatter(WSP(int, WS_TOPI), WSP(int, WS_POS), WSP(int, WS_ROWTOK), WSP(float, WS_SAROW), WSP(float, WS_SA), WSP(int, WS_ROUTE) + RT_HIST, WSP(int, WS_ROUTE), lds, wave * 64 + lane, lane, wave, bid, G);
        SEAM(pb + 6);
    }
    if (EN(8) && IN(pb + 7)) {
        CArgs& a = kargs(); unsigned char* ws = a.ws;
        pg8::Gemm g{WSP(bf16, WS_HN), WSP(bf16, WS_WGU), TPAD, NE * 2048, D / 2}; pg8::GroupedOrderT<true> S; S.init(WSP(int, WS_ROUTE) + RT_NTILES, WSP(int, WS_ROUTE) + RT_TEXP, 8, G, bid, WSP(int, WS_ROWTOK));
        pg8::EpiSwigluI8 E{WSP(unsigned char, WS_ACT), a.in[18] + (size_t)L * NE * 2048, WSP(float, WS_SW), WSP(float, WS_SAROW)};
        for (int rp_ = 0; rp_ < NREP(8); ++rp_) { if (rp_) __syncthreads(); pg8::gemm_phase<pg8::EpiSwigluI8, pg8::GroupedOrderT<true>, true, true, true>(ldsl + RING_OFF, g, S, E, wave); }
        SEAM(pb + 7);
    }
    if (EN(9) && IN(pb + 8)) {
        CArgs& a = kargs(); unsigned char* ws = a.ws;
        pg8::Gemm g{WSP(bf16, WS_ACT), WSP(bf16, WS_WDN), TPAD, NE * D, D / 2}; pg8::GroupedOrderT<false> S; S.init(WSP(int, WS_ROUTE) + RT_NTILES, WSP(int, WS_ROUTE) + RT_TEXP, 4, G, bid);
        pg8::EpiDown E{WSP(unsigned char, WS_R1), a.in[20] + (size_t)L * NE * D, 1.0f / F8_WSCALE};
        for (int rp_ = 0; rp_ < NREP(9); ++rp_) { if (rp_) __syncthreads(); pg8::gemm_phase<pg8::EpiDown, pg8::GroupedOrderT<false>, true, true, false, true>(ldsl + RING_OFF, g, S, E, wave); }
        SEAM(pb + 8);
    }
}

__global__ void __launch_bounds__(NWAVES * 64, 2) mega_fwd(Args args_unused) {
    extern __shared__ __attribute__((aligned(16))) unsigned char lds[];
    LAS unsigned char* ldsl = (LAS unsigned char*)lds;
    volatile LAS unsigned* MISC = (volatile LAS unsigned*)(ldsl + MISC_OFF);
    const int wave = __builtin_amdgcn_readfirstlane((int)threadIdx.x >> 6);
    const int G = gridDim.x, bid = blockIdx.x;
    for (int u = wave * 64 + mk_lane(); u < (LDS_BYTES - LDSCTL_OFF) / 4; u += NWAVES * 64) ((LAS unsigned*)(ldsl + LDSCTL_OFF))[u] = 0u;
    __syncthreads();
    if (!MK_PER_PHASE) { CArgs& a = kargs(); (void)xcd_barrier_post((unsigned*)(a.ws + WS_CTL) + CW_BAR, MISC + 8, wave); }

    if (EN(0) && IN(0)) {
        CArgs& a = kargs(); unsigned char* ws = a.ws; const int lane = mk_lane(); const int gw = bid * NWAVES + wave, NGW = G * NWAVES;
        phase_mod(a.in[1], a.in[11], a.in[12], WSP(float, WS_MOD), (float*)(lds + RING_OFF), wave * 64 + lane, bid, G);
        LAS float* scr = (LAS float*)(ldsl + RING_OFF + wave * 16384);
        (void)scr;
        convert_down_f8(a.in[6], WSP(unsigned char, WS_WFO), ldsl + RING_OFF + wave * 16384, gw, NGW, lane, 128);
        convert_down_f8(a.in[10], WSP(unsigned char, WS_WHO), ldsl + RING_OFF + wave * 16384, gw, NGW, lane, 128);
        for (int it = gw; it < 4 * 130; it += NGW) { int r = it; int m = 0;
            if (r >= 4 * 33) { r -= 4 * 33; m = 1; if (r >= 4 * 33) { r -= 4 * 33; m = 2; if (r >= 4 * 32) { r -= 4 * 32; m = 3; } } }
            if (m < 2) absmax_mat(a.in[2] + (size_t)m * D * 4112, 4112, 4112, 33, WSP(float, WS_PARTM) + (size_t)m * 4 * 4352, r, lane);
            else absmax_mat(a.in[7] + (size_t)(m - 2) * D * 4096, 4096, 4096, 32, WSP(float, WS_PARTM) + (size_t)m * 4 * 4352, r, lane); }
        for (int idx = gw * 64 + lane; idx < 2 * 240 * 64; idx += NGW * 64) { const int m = idx / (240 * 64), r = idx - m * 240 * 64; *(v4u*)(WSP(unsigned char, WS_WFI) + (size_t)m * NFOXP * D + (size_t)4112 * D + (size_t)r * 16) = (v4u){0u, 0u, 0u, 0u}; }
        __syncthreads();
        SEAM(0);
    }
    run_layer<0>(lds, ldsl, wave);
    run_layer<1>(lds, ldsl, wave);
    run_layer<2>(lds, ldsl, wave);
    run_layer<3>(lds, ldsl, wave);
    if (EN(10) && IN(N_PHASES - 1)) {
        CArgs& a = kargs(); unsigned char* ws = a.ws; const int gw = bid * NWAVES + wave, NGW = G * NWAVES;
        phase_norm1<1, 1>(WSP(bf16, WS_XB), a.out, WSP(unsigned char, WS_HN), WSP(float, WS_SA), a.in[13], WSP(float, WS_MOD), false, true, WSP(unsigned char, WS_R1), WSP(int, WS_POS), WSP(float, WS_TOPW), WSP(float, WS_MOD) + (size_t)(DEPTH - 1) * NB * 6144, gw, NGW, mk_lane());
    }
}

extern "C" void kernel_launch(void* const* d_in, const int* in_sizes, int n_in, void* d_out, int out_size, void* d_ws, size_t ws_size, hipStream_t stream) {
    static int grid = 0;
    if (grid == 0) {
        if (n_in != 21 || in_sizes[0] != T * D || out_size != T * D || ws_size < WS_END) { fprintf(stderr, "kernel_launch: unexpected shapes (n_in %d, in0 %d, out %d, ws %zu < %zu); nothing launched\n", n_in, n_in > 0 ? in_sizes[0] : -1, out_size, ws_size, (size_t)WS_END); grid = -1; return; }
        int dev = 0, cus = 0, per_cu = 0;
        if (hipGetDevice(&dev) != hipSuccess || hipDeviceGetAttribute(&cus, hipDeviceAttributeMultiprocessorCount, dev) != hipSuccess) { grid = -1; return; }
        if (hipFuncSetAttribute((const void*)mega_fwd, hipFuncAttributeMaxDynamicSharedMemorySize, LDS_BYTES) != hipSuccess) { fprintf(stderr, "kernel_launch: hipFuncSetAttribute failed\n"); grid = -1; return; }
        if (hipOccupancyMaxActiveBlocksPerMultiprocessor(&per_cu, (const void*)mega_fwd, NWAVES * 64, LDS_BYTES) != hipSuccess || per_cu < 1) { fprintf(stderr, "kernel_launch: occupancy query says %d blocks per CU\n", per_cu); }
        (void)hipGetLastError();
        grid = cus;
    }
    if (grid < 0) return;
    if (hipMemsetAsync((char*)d_ws + WS_CTL, 0, CTL_ZERO_BYTES, stream) != hipSuccess) return;
    Args a{};
    for (int i = 0; i < 21; ++i) a.in[i] = (const float*)d_in[i];
    a.out = (float*)d_out; a.ws = (unsigned char*)d_ws;
#if MK_PER_PHASE
    for (int p = 0; p < N_PHASES; ++p) { a.ph_lo = p; a.ph_hi = p + 1; hipLaunchKernelGGL(mega_fwd, dim3(grid), dim3(NWAVES * 64), LDS_BYTES, stream, a); }
#else
    a.ph_lo = 0; a.ph_hi = N_PHASES;
    hipLaunchKernelGGL(mega_fwd, dim3(grid), dim3(NWAVES * 64), LDS_BYTES, stream, a);
#endif
}
```

```cpp
#include <hip/hip_runtime.h>
#include <cstdio>
#include <cstdint>
__device__ __forceinline__ int mk_lane() { int l = (int)__builtin_amdgcn_mbcnt_hi(~0u, __builtin_amdgcn_mbcnt_lo(~0u, 0u)); asm volatile("" : "+v"(l)); return l; }
namespace pg8 {
#define PG8_LAS __attribute__((address_space(3)))
typedef unsigned short bf16_t;
typedef short bf16x8 __attribute__((ext_vector_type(8)));
typedef float f32x4 __attribute__((ext_vector_type(4)));
typedef unsigned u32x4 __attribute__((ext_vector_type(4)));
constexpr int BM = 256, BK = 64, HALF = 128, HTB = HALF * BK * 2  , STAGE_BYTES = 8 * HTB, NXCD = 8, WGM = 8;

__host__ __device__ __forceinline__ int lds_byte(int r, int c) { const int st = (r >> 4) * 2 + (c >> 5), rr = r & 15, cc = c & 31, ob = rr * 64 + cc * 2; return st * 1024 + (ob ^ (((ob >> 9) & 1) << 5)); }
__host__ __device__ __forceinline__ void stage_rc(int b, int& R, int& C) { const int st = b / 1024, sb = b % 1024, swz = sb ^ (((sb >> 9) & 1) << 5); R = (st >> 1) * 16 + swz / 64; C = (st & 1) * 32 + (swz % 64) / 2; }
__host__ __device__ __forceinline__ int perm32(int rho) { const int n = rho >> 4, i = rho & 15; return 8 * (i >> 2) + 4 * n + (i & 3); }

struct Unit { int pm, pn, pb, e; };
struct Gemm { const bf16_t* A; const bf16_t* Bt; int M, N, K; };

struct StaticOrder {
    static constexpr bool GATHER = false; const int* rowtok = nullptr;
    int nM, nN, nwg, G, c;
    __host__ __device__ void init(int M, int N, int G_, int c_) { nM = M / BM; nN = N / BM; nwg = nM * nN; G = G_; c = c_; }
    __host__ __device__ bool next(int i, Unit& u) const {
        const long L = (long)i * G + c; if (L >= nwg) return false;
        int wgid = (int)L; { const int q = nwg / NXCD, r = nwg % NXCD, xcd = wgid % NXCD, off = wgid / NXCD; wgid = (xcd < r ? xcd * (q + 1) : r * (q + 1) + (xcd - r) * q) + off; }
        const int nig = WGM * nN, gid = wgid / nig, fm = gid * WGM, gsz = (nM - fm) < WGM ? (nM - fm) : WGM;
        u.pm = fm + ((wgid % nig) % gsz); u.pn = (wgid % nig) / gsz; u.pb = u.pn; u.e = 0; return true;
    }
    struct Raw {};
    __device__ __forceinline__ void prefetch(int, Raw&) const {}
    __device__ __forceinline__ bool finish(int i, const Raw&, Unit& u) const { return next(i, u); }
    __device__ __forceinline__ int tile_of(int) const { return -1; }
    __device__ __forceinline__ void a_ready(const Unit&) const {}
    __device__ __forceinline__ void done(const Unit&) const {}
};

__device__ __forceinline__ unsigned cvt_pk_bf16(float lo, float hi) { unsigned r; asm volatile("v_cvt_pk_bf16_f32 %0, %1, %2" : "=v"(r) : "v"(lo), "v"(hi)); return r; }
typedef int i32x4 __attribute__((ext_vector_type(4)));
typedef int i32x8 __attribute__((ext_vector_type(8)));
typedef unsigned u32x2 __attribute__((ext_vector_type(2)));
__device__ __forceinline__ unsigned pk_fp8x4(float a, float b, float c, float d) { int w = 0; w = __builtin_amdgcn_cvt_pk_fp8_f32(a, b, w, false); w = __builtin_amdgcn_cvt_pk_fp8_f32(c, d, w, true); return (unsigned)w; }
template <bool I8> struct AccSel { typedef f32x4 type; }; template <> struct AccSel<true> { typedef i32x4 type; };
template <bool I8, class AccV> __device__ __forceinline__ f32x4 acc_val(const AccV& a, const f32x4& cs, float rs) { if constexpr (I8) return (f32x4){(float)a[0], (float)a[1], (float)a[2], (float)a[3]} * (cs * rs); else return a; }
__device__ __forceinline__ float sigm(float x) { return __builtin_amdgcn_rcpf(1.0f + __expf(-x)); }
__device__ __forceinline__ f32x4 exp2_4(const f32x4 v) { return (f32x4){__builtin_amdgcn_exp2f(v[0]), __builtin_amdgcn_exp2f(v[1]), __builtin_amdgcn_exp2f(v[2]), __builtin_amdgcn_exp2f(v[3])}; }
__device__ __forceinline__ f32x4 rcp_4(const f32x4 v) { return (f32x4){__builtin_amdgcn_rcpf(v[0]), __builtin_amdgcn_rcpf(v[1]), __builtin_amdgcn_rcpf(v[2]), __builtin_amdgcn_rcpf(v[3])}; }
__device__ __forceinline__ f32x4 log2_4(const f32x4 v) { return (f32x4){__builtin_amdgcn_logf(v[0]), __builtin_amdgcn_logf(v[1]), __builtin_amdgcn_logf(v[2]), __builtin_amdgcn_logf(v[3])}; }
__device__ __forceinline__ f32x4 sigm4(const f32x4 v) { return rcp_4(exp2_4(v * -1.4426950408889634f) + 1.0f); }
__device__ __forceinline__ u32x4 pack8(const f32x4 v0, const f32x4 v1) { u32x4 w; w.x = cvt_pk_bf16(v0[0], v0[1]); w.y = cvt_pk_bf16(v0[2], v0[3]); w.z = cvt_pk_bf16(v1[0], v1[1]); w.w = cvt_pk_bf16(v1[2], v1[3]); return w; }

template <bool I8> struct EpiFoxT {
    static constexpr bool PERM = true, AFTER_DRAIN = false, DRAIN_AFTER = true;        typedef typename AccSel<I8>::type AccV;
    bf16_t* P; size_t pstride; float* FL; const float* qw; const float* kw; const float* bfv; float qscale; const float* sa; const float* sw;
    __device__ __forceinline__ void operator()(const AccV (&acc)[2][2][4][2], const Unit& u, int wr, int wc, int fr_in, int fq_in) const {
        int fr = fr_in, fq = fq_in; asm volatile("" : "+v"(fr), "+v"(fq));
        typedef const __attribute__((address_space(1))) float GF; typedef const __attribute__((address_space(1))) f32x4 GF4;
        GF* sa = (GF*)this->sa; GF* sw = (GF*)this->sw; GF* qw = (GF*)this->qw; GF* kw = (GF*)this->kw; GF* bfv = (GF*)this->bfv; asm volatile("" : "+s"(sa), "+s"(sw), "+s"(qw), "+s"(kw), "+s"(bfv));
        const int type = u.pn >> 2; const int row0 = u.pm * BM + wr * 64 + fr;
        float srow[2][4]; f32x4 swv[2][2];
        if (type == 4) {
            if (wc == 0) {
                const int fqc = fq & 1;
#pragma unroll
                for (int ai = 0; ai < 2; ++ai)
#pragma unroll
                    for (int m = 0; m < 4; ++m) srow[ai][m] = I8 ? sa[row0 + ai * HALF + m * 16] : 1.0f;
                const f32x4 one4 = (f32x4){1.f, 1.f, 1.f, 1.f};
                const f32x4 s0 = I8 ? *(GF4*)(sw + 4096 + 8 * fqc) : one4, s1 = I8 ? *(GF4*)(sw + 4096 + 8 * fqc + 4) : one4;
                const f32x4 b0 = *(GF4*)(bfv + 8 * fqc), b1 = *(GF4*)(bfv + 8 * fqc + 4);
#pragma unroll
                for (int ai = 0; ai < 2; ++ai)
#pragma unroll
                    for (int m = 0; m < 4; ++m) { const size_t row = (size_t)(row0 + ai * HALF + m * 16);
                        f32x4 v0 = acc_val<I8>(acc[ai][0][m][0], s0, srow[ai][m]) + b0, v1 = acc_val<I8>(acc[ai][0][m][1], s1, srow[ai][m]) + b1;
#pragma unroll
                        for (int i = 0; i < 4; ++i) { { const float z = v0[i]; v0[i] = (fminf(z, 0.f) - __logf(1.0f + __expf(-fabsf(z)))) * 1.4426950408889634f; }
                                                      { const float z = v1[i]; v1[i] = (fminf(z, 0.f) - __logf(1.0f + __expf(-fabsf(z)))) * 1.4426950408889634f; } }
                        if (fq < 2) { *(f32x4*)(FL + row * 16 + 8 * fq) = v0; *(f32x4*)(FL + row * 16 + 8 * fq + 4) = v1; } }
            }
            return;
        }
#pragma unroll
        for (int ai = 0; ai < 2; ++ai)
#pragma unroll
            for (int m = 0; m < 4; ++m) srow[ai][m] = I8 ? sa[row0 + ai * HALF + m * 16] : 1.0f;
        { const int sc0 = 256 * u.pn + 64 * wc + 8 * fq;
#pragma unroll
          for (int bj = 0; bj < 2; ++bj)
#pragma unroll
              for (int n = 0; n < 2; ++n) swv[bj][n] = I8 ? *(GF4*)(sw + sc0 + 32 * bj + 4 * n) : (f32x4){1.f, 1.f, 1.f, 1.f}; }
#define PG8_V(ai, bj, m, n) acc_val<I8>(acc[ai][bj][m][n], swv[bj][n], srow[ai][m])
        bf16_t* base = P + (size_t)type * pstride;
        const int colh = (u.pn & 3) * 256 + 64 * wc + 8 * fq;
        if (type < 2) {
            GF* w = (type == 0) ? qw : kw; const float sc = (type == 0) ? qscale : 1.0f;
            f32x4 wv[2][2];
#pragma unroll
            for (int bj = 0; bj < 2; ++bj)
#pragma unroll
                for (int n = 0; n < 2; ++n) wv[bj][n] = *(GF4*)(w + 32 * bj + 8 * fq + 4 * n) * sc;
#pragma unroll
            for (int ai = 0; ai < 2; ++ai)
#pragma unroll
                for (int m = 0; m < 4; ++m) {
                    float ss = 0.f;
#pragma unroll
                    for (int bj = 0; bj < 2; ++bj)
#pragma unroll
                        for (int n = 0; n < 2; ++n) { const f32x4 x = PG8_V(ai, bj, m, n); ss += (x[0] * x[0] + x[1] * x[1]) + (x[2] * x[2] + x[3] * x[3]); }
                    ss += __shfl_xor(ss, 16); ss += __shfl_xor(ss, 32);
                    const float rs = __builtin_amdgcn_rsqf(ss * (1.0f / 64.0f) + 1e-6f);
                    bf16_t* rowp = base + (size_t)(row0 + ai * HALF + m * 16) * 1024 + colh;
#pragma unroll
                    for (int bj = 0; bj < 2; ++bj) { const f32x4 v0 = PG8_V(ai, bj, m, 0) * rs * wv[bj][0], v1 = PG8_V(ai, bj, m, 1) * rs * wv[bj][1]; *(u32x4*)(rowp + 32 * bj) = pack8(v0, v1); }
                    __builtin_amdgcn_sched_barrier(0);
                }
        } else {
#pragma unroll
            for (int ai = 0; ai < 2; ++ai)
#pragma unroll
                for (int m = 0; m < 4; ++m) { bf16_t* rowp = base + (size_t)(row0 + ai * HALF + m * 16) * 1024 + colh;
#pragma unroll
                    for (int bj = 0; bj < 2; ++bj) { f32x4 v0 = PG8_V(ai, bj, m, 0), v1 = PG8_V(ai, bj, m, 1);
                        if (type == 3) { v0 = sigm4(v0); v1 = sigm4(v1); }
                        *(u32x4*)(rowp + 32 * bj) = pack8(v0, v1); } __builtin_amdgcn_sched_barrier(0); }
        }
    }
};
#undef PG8_V

template <bool I8> struct EpiHgrnT {
    static constexpr bool PERM = true, AFTER_DRAIN = false, DRAIN_AFTER = true; typedef typename AccSel<I8>::type AccV;
    bf16_t* P; size_t pstride; float* LF; const float* lb0; const float* lb1; int jh; const float* sa; const float* sw;
    __device__ __forceinline__ void operator()(const AccV (&acc)[2][2][4][2], const Unit& u, int wr, int wc, int fr_in, int fq_in) const {
        int fr = fr_in, fq = fq_in; asm volatile("" : "+v"(fr), "+v"(fq));
        typedef const __attribute__((address_space(1))) float GF; typedef const __attribute__((address_space(1))) f32x4 GF4;
        GF* sa = (GF*)this->sa; GF* sw = (GF*)this->sw; GF* lb0 = (GF*)this->lb0; GF* lb1 = (GF*)this->lb1; asm volatile("" : "+s"(sa), "+s"(sw), "+s"(lb0), "+s"(lb1));
        const int type = u.pn >> 2; const int row0 = u.pm * BM + wr * 64 + fr;
        const int col0 = (u.pn & 3) * 256 + wc * 32 + 8 * fq;
        float srow[2][4]; f32x4 swv[2][2];
#pragma unroll
        for (int ai = 0; ai < 2; ++ai)
#pragma unroll
            for (int m = 0; m < 4; ++m) srow[ai][m] = I8 ? sa[row0 + ai * HALF + m * 16] : 1.0f;
#pragma unroll
        for (int bj = 0; bj < 2; ++bj)
#pragma unroll
            for (int n = 0; n < 2; ++n) swv[bj][n] = I8 ? *(GF4*)(sw + u.pn * 256 + wc * 32 + 8 * fq + bj * HALF + 4 * n) : (f32x4){1.f, 1.f, 1.f, 1.f};
#define PG8_V(ai, bj, m, n) acc_val<I8>(acc[ai][bj][m][n], swv[bj][n], srow[ai][m])
        bf16_t* base = P + (size_t)type * pstride;
        if (type == 1) {
            f32x4 lbv[2][2];
#pragma unroll
            for (int bj = 0; bj < 2; ++bj)
#pragma unroll
                for (int n = 0; n < 2; ++n) { f32x4 l = (f32x4){0.f, 0.f, 0.f, 0.f};
                    if (jh != 0) { const f32x4 a = *(GF4*)(lb0 + col0 + bj * HALF + 4 * n), b = *(GF4*)(lb1 + col0 + bj * HALF + 4 * n);
#pragma unroll
                        for (int i = 0; i < 4; ++i) l[i] = __builtin_amdgcn_rcpf(1.0f + __expf(a[i] - b[i])); }
                    lbv[bj][n] = l; }
#pragma unroll
            for (int ai = 0; ai < 2; ++ai)
#pragma unroll
                for (int m = 0; m < 4; ++m) { const size_t off = (size_t)(row0 + ai * HALF + m * 16) * 1024 + col0;
#pragma unroll
                    for (int bj = 0; bj < 2; ++bj) { f32x4 lf[2], kk[2];
#pragma unroll
                        for (int n = 0; n < 2; ++n) { f32x4 x = PG8_V(ai, bj, m, n);
#pragma unroll
                            for (int i = 0; i < 4; ++i) x[i] = __builtin_amdgcn_fmed3f(x[i], -80.0f, 80.0f);
                            const f32x4 lb = lbv[bj][n], om = 1.0f - lb, ex = exp2_4(x * -1.4426950408889634f), sg = rcp_4(ex + 1.0f);
                            lf[n] = log2_4(om * sg + lb); kk[n] = om * (ex * sg); }
                        *(f32x4*)(LF + off + bj * HALF) = lf[0]; *(f32x4*)(LF + off + bj * HALF + 4) = lf[1];
                        *(u32x4*)(base + off + bj * HALF) = pack8(kk[0], kk[1]); } }
        } else {
#pragma unroll
            for (int ai = 0; ai < 2; ++ai)
#pragma unroll
                for (int m = 0; m < 4; ++m) { bf16_t* rowp = base + (size_t)(row0 + ai * HALF + m * 16) * 1024 + col0;
#pragma unroll
                    for (int bj = 0; bj < 2; ++bj) { f32x4 v0 = PG8_V(ai, bj, m, 0), v1 = PG8_V(ai, bj, m, 1);
                        if (type != 2) { v0 = v0 * sigm4(v0); v1 = v1 * sigm4(v1); }
                        *(u32x4*)(rowp + bj * HALF) = pack8(v0, v1); } }
        }
    }
};
#undef PG8_V

__device__ __forceinline__ f32x4 bf4_lo(const u32x4 w) { return (f32x4){__builtin_bit_cast(float, w.x << 16), __builtin_bit_cast(float, w.x & 0xffff0000u), __builtin_bit_cast(float, w.y << 16), __builtin_bit_cast(float, w.y & 0xffff0000u)}; }
__device__ __forceinline__ f32x4 bf4_hi(const u32x4 w) { return (f32x4){__builtin_bit_cast(float, w.z << 16), __builtin_bit_cast(float, w.z & 0xffff0000u), __builtin_bit_cast(float, w.w << 16), __builtin_bit_cast(float, w.w & 0xffff0000u)}; }
template <bool BASEF32> struct EpiResidT {
    static constexpr bool PERM = true, AFTER_DRAIN = false, DRAIN_AFTER = true;
    const float* basef; const bf16_t* baseh; bf16_t* out; const float* gate; float osc;
    __device__ __forceinline__ void operator()(const f32x4 (&acc)[2][2][4][2], const Unit& u, int wr, int wc, int fr, int fq) const {
        const int row0 = u.pm * BM + wr * 64 + fr; const int col0 = u.pn * BM + wc * 32 + 8 * fq;
        const float* gp = gate + (size_t)(u.pm >> 3) * 6144 + col0;
        f32x4 gv[2][2];
#pragma unroll
        for (int bj = 0; bj < 2; ++bj)
#pragma unroll
            for (int n = 0; n < 2; ++n) gv[bj][n] = *(const f32x4*)(gp + bj * HALF + 4 * n) * osc;
#pragma unroll
        for (int ai = 0; ai < 2; ++ai)
#pragma unroll
            for (int m = 0; m < 4; ++m) { const size_t off = (size_t)(row0 + ai * HALF + m * 16) * 1024 + col0;
#pragma unroll
                for (int bj = 0; bj < 2; ++bj) { f32x4 b0, b1;
                    if constexpr (BASEF32) { b0 = *(const f32x4*)(basef + off + bj * HALF); b1 = *(const f32x4*)(basef + off + bj * HALF + 4); }
                    else { const u32x4 w = *(const u32x4*)(baseh + off + bj * HALF); b0 = bf4_lo(w); b1 = bf4_hi(w); }
                    *(u32x4*)(out + off + bj * HALF) = pack8(b0 + gv[bj][0] * acc[ai][bj][m][0], b1 + gv[bj][1] * acc[ai][bj][m][1]); } }
    }
};

struct EpiSwiglu {
    static constexpr bool PERM = true, AFTER_DRAIN = false, DRAIN_AFTER = true;
    bf16_t* ACT; const float* bgu;
    __device__ __forceinline__ void operator()(const f32x4 (&acc)[2][2][4][2], const Unit& u, int wr, int wc, int fr, int fq) const {
        const int row0 = u.pm * BM + wr * 64 + fr; const int a0 = u.pn * 128 + wc * 32 + 8 * fq;
        const float* bp = bgu + (size_t)u.e * 2048 + 2 * a0;
        f32x4 bv[4];
#pragma unroll
        for (int q = 0; q < 4; ++q) bv[q] = *(const f32x4*)(bp + 4 * q);
#pragma unroll
        for (int ai = 0; ai < 2; ++ai)
#pragma unroll
            for (int m = 0; m < 4; ++m) { f32x4 o[2];
#pragma unroll
                for (int n = 0; n < 2; ++n)
#pragma unroll
                    for (int i = 0; i < 4; ++i) { const int ip = 4 * n + i; float g = acc[ai][0][m][n][i] + bv[ip >> 1][(ip & 1) * 2], up = acc[ai][1][m][n][i] + bv[ip >> 1][(ip & 1) * 2 + 1];
                        g = fminf(g, 7.0f); up = fminf(fmaxf(up, -7.0f), 7.0f); o[n][i] = (up + 1.0f) * g * sigm(1.702f * g); }
                *(u32x4*)(ACT + (size_t)(row0 + ai * HALF + m * 16) * 1024 + a0) = pack8(o[0], o[1]); }
    }
};

struct EpiSwigluI8 {
    static constexpr bool PERM = true, AFTER_DRAIN = false, DRAIN_AFTER = false;
    unsigned char* ACT; const float* bgu; const float* swgu; const float* sarow;
    typedef float f32x2 __attribute__((ext_vector_type(2)));
    __device__ __forceinline__ void operator()(const i32x4 (&acc)[2][2][4][2], const Unit& u, int wr, int wc, int fr, int fq) const {
        const int row0 = u.pm * BM + wr * 64 + fr; const int a0 = u.pn * 128 + wc * 32 + 8 * fq;
        const float* bp = bgu + (size_t)u.e * 2048 + 2 * a0; const float* sp = swgu + (size_t)u.e * 2048 + 2 * a0;
        f32x4 bv[4], sv[4];
#pragma unroll
        for (int q = 0; q < 4; ++q) { bv[q] = *(const f32x4*)(bp + 4 * q); sv[q] = *(const f32x4*)(sp + 4 * q); }
        const f32x2 one2 = (f32x2){1.0f, 1.0f}, kz2 = (f32x2){-1.702f * 1.4426950408889634f, -1.702f * 1.4426950408889634f};
#pragma unroll
        for (int ai = 0; ai < 2; ++ai)
#pragma unroll
            for (int m = 0; m < 4; ++m) { const int row = row0 + ai * HALF + m * 16; const float sr = sarow[row]; const f32x2 sr2 = (f32x2){sr, sr}; float o[8];
#pragma unroll
                for (int pp = 0; pp < 4; ++pp) {
                    const int n = pp >> 1, i0 = (2 * pp) & 3;
                    const f32x2 gu0 = (f32x2){(float)acc[ai][0][m][n][i0], (float)acc[ai][1][m][n][i0]} * ((f32x2){sv[pp][0], sv[pp][1]} * sr2) + (f32x2){bv[pp][0], bv[pp][1]};
                    const f32x2 gu1 = (f32x2){(float)acc[ai][0][m][n][i0 + 1], (float)acc[ai][1][m][n][i0 + 1]} * ((f32x2){sv[pp][2], sv[pp][3]} * sr2) + (f32x2){bv[pp][2], bv[pp][3]};
                    const f32x2 g2 = (f32x2){fminf(gu0[0], 7.0f), fminf(gu1[0], 7.0f)};
                    const f32x2 u2 = (f32x2){__builtin_amdgcn_fmed3f(gu0[1], -7.0f, 7.0f), __builtin_amdgcn_fmed3f(gu1[1], -7.0f, 7.0f)} + one2;
                    const f32x2 z2 = g2 * kz2;
                    const f32x2 d2 = (f32x2){__builtin_amdgcn_exp2f(z2[0]), __builtin_amdgcn_exp2f(z2[1])} + one2;
                    const f32x2 r2 = (u2 * g2) * (f32x2){__builtin_amdgcn_rcpf(d2[0]), __builtin_amdgcn_rcpf(d2[1])};
                    o[2 * pp] = r2[0]; o[2 * pp + 1] = r2[1]; }
                *(u32x2*)(ACT + (size_t)row * 1024 + a0) = (u32x2){pk_fp8x4(o[0], o[1], o[2], o[3]), pk_fp8x4(o[4], o[5], o[6], o[7])}; __builtin_amdgcn_sched_barrier(0); }
    }
};

struct EpiDown {
    static constexpr bool PERM = true, AFTER_DRAIN = false, DRAIN_AFTER = false;
    unsigned char* Y; const float* bd; float wsc;
    __device__ __forceinline__ void operator()(const f32x4 (&acc)[2][2][4][2], const Unit& u, int wr, int wc, int fr, int fq) const {
        const int row0 = u.pm * BM + wr * 64 + fr; const int col0 = u.pn * BM + wc * 32 + 8 * fq;
        const float* bp = bd + (size_t)u.e * 1024 + col0;
        f32x4 bv[2][2];
#pragma unroll
        for (int bj = 0; bj < 2; ++bj)
#pragma unroll
            for (int n = 0; n < 2; ++n) bv[bj][n] = *(const f32x4*)(bp + bj * HALF + 4 * n);
#pragma unroll
        for (int ai = 0; ai < 2; ++ai)
#pragma unroll
            for (int m = 0; m < 4; ++m) { unsigned char* rowp = Y + (size_t)(row0 + ai * HALF + m * 16) * 1024 + col0;
#pragma unroll
                for (int bj = 0; bj < 2; ++bj) { f32x4 y0 = acc[ai][bj][m][0] * wsc + bv[bj][0], y1 = acc[ai][bj][m][1] * wsc + bv[bj][1];
#pragma unroll
                    for (int i = 0; i < 4; ++i) { y0[i] = __builtin_amdgcn_fmed3f(y0[i], -448.0f, 448.0f); y1[i] = __builtin_amdgcn_fmed3f(y1[i], -448.0f, 448.0f); }
                    *(u32x2*)(rowp + bj * HALF) = (u32x2){pk_fp8x4(y0[0], y0[1], y0[2], y0[3]), pk_fp8x4(y1[0], y1[1], y1[2], y1[3])}; } }
    }
};

template <bool GATHER_> struct GroupedOrderT {
    static constexpr bool GATHER = GATHER_; const int* rowtok;
    const int* texp; int nunits, nn, G, v;
    __device__ void init(const int* ntiles_p, const int* texp_, int nn_, int G_, int c_, const int* rowtok_ = nullptr) { texp = texp_; rowtok = rowtok_; nn = nn_; G = G_; v = (G_ % 8 == 0) ? (c_ % 8) * (G_ / 8) + c_ / 8 : c_;
        nunits = __builtin_amdgcn_readfirstlane(*ntiles_p) * nn_; }
    __device__ bool next(int i, Unit& u) const {
        const int U = i * G + v; if (U >= nunits) return false;
        const int tile = U / nn, pn = U - tile * nn; const int e = __builtin_amdgcn_readfirstlane(texp[tile]);
        u.pm = tile; u.pn = pn; u.e = e; u.pb = e * nn + pn; return true;
    }
    struct Raw { int te; };
    __device__ __forceinline__ int tile_of(int i) const { const int U = i * G + v; return U < nunits ? U / nn : -1; }
    __device__ __forceinline__ void prefetch(int i, Raw& r) const { const int t = tile_of(i); r.te = texp[t < 0 ? 0 : t]; }
    __device__ __forceinline__ bool finish(int i, const Raw& r, Unit& u) const {
        const int U = i * G + v; if (U >= nunits) return false;
        const int tile = U / nn, pn = U - tile * nn; const int e = __builtin_amdgcn_readfirstlane(r.te);
        u.pm = tile; u.pn = pn; u.e = e; u.pb = e * nn + pn; return true;
    }
    __device__ __forceinline__ void a_ready(const Unit&) const {}
    __device__ __forceinline__ void done(const Unit&) const {}
};
template <class Epi, class Sched, bool ALIGN_EPI = false, bool SP2 = false, bool I8 = false, bool F8 = false>
__device__ __forceinline__ void gemm_phase(PG8_LAS unsigned char* lds, const Gemm g, const Sched& S, const Epi& E, const int mk_wave) {
    const int lane = mk_lane(), wid = mk_wave, tid = wid * 64 + lane, wr = wid >> 2, wc = wid & 3, fr = lane & 15, fq = lane >> 4;
    const int K = g.K, nt = K / BK;
    unsigned voffA[2], voffB[2]; int gR[2], gC[2];
#pragma unroll
    for (int i = 0; i < 2; ++i) { int R, C; stage_rc(tid * 16 + i * 8192, R, C); const int Rb = Epi::PERM ? ((R & ~31) + perm32(R & 31)) : R;
        voffA[i] = (unsigned)(R * K + C) * 2u; voffB[i] = (unsigned)(Rb * K + C) * 2u; gR[i] = R; gC[i] = C; }
    constexpr bool GATHER = Sched::GATHER;
    unsigned vgC[2][2], vgN[2][2];
#define PG8_GOFF(dst, u) do { if constexpr (GATHER) { _Pragma("unroll") for (int _h = 0; _h < 2; ++_h) _Pragma("unroll") for (int _i = 0; _i < 2; ++_i) \
        dst[_h][_i] = (unsigned)S.rowtok[(u).pm * BM + _h * HALF + gR[_i]] * (unsigned)(K * 2) + (unsigned)(gC[_i] * 2); } } while (0)
    const size_t kstep = (size_t)(BK * 2);
    const size_t hstep = (size_t)HALF * K * 2;
    const size_t tstep = 2 * hstep;
    const unsigned ldsw = (unsigned)wid * 1024u;
    const int aoff = lds_byte(wr * 64 + fr, fq * 8), boff = lds_byte(wc * 32 + fr, fq * 8);
#define PG8_SA(b, h) (((b) * 2 + (h)) * HTB)
#define PG8_SB(b, h) ((4 + (b) * 2 + (h)) * HTB)
#define PG8_STAGE(bufoff, gbase, voff) do { _Pragma("unroll") for (int _i = 0; _i < 2; ++_i) \
        __builtin_amdgcn_global_load_lds((const unsigned*)((const char*)(gbase) + (voff)[_i]), (PG8_LAS unsigned*)(lds + (bufoff) + ldsw + _i * 8192), 16, 0, 0); } while (0)
#define PG8_STAGEA(bufoff, ptr, h, sel) do { if constexpr (GATHER) { _Pragma("unroll") for (int _i = 0; _i < 2; ++_i) \
        __builtin_amdgcn_global_load_lds((const unsigned*)((const char*)(ptr) + ((sel) ? vgN[h][_i] : vgC[h][_i])), (PG8_LAS unsigned*)(lds + (bufoff) + ldsw + _i * 8192), 16, 0, 0); } \
    else { PG8_STAGE(bufoff, (ptr) + (h) * hstep, voffA); } } while (0)
#define PG8_LDF8(dst8, idx_, off) do { const bf16x8 l0_ = *(const PG8_LAS bf16x8*)(lds + (off)), l1_ = *(const PG8_LAS bf16x8*)(lds + (off) + 1024); \
        (dst8)[idx_] = __builtin_shufflevector(__builtin_bit_cast(i32x4, l0_), __builtin_bit_cast(i32x4, l1_), 0, 1, 2, 3, 4, 5, 6, 7); } while (0)
#define PG8_LDA(dst, b, h) do { if constexpr (F8) { _Pragma("unroll") for (int m = 0; m < 4; ++m) PG8_LDF8(dst##8, m, PG8_SA(b, h) + aoff + m * 2048); } \
        else { _Pragma("unroll") for (int m = 0; m < 4; ++m) _Pragma("unroll") for (int k = 0; k < 2; ++k) dst[m][k] = *(const PG8_LAS bf16x8*)(lds + PG8_SA(b, h) + aoff + m * 2048 + k * 1024); } } while (0)
#define PG8_LDB(dst, b, h) do { if constexpr (F8) { _Pragma("unroll") for (int n = 0; n < 2; ++n) PG8_LDF8(dst##8, n, PG8_SB(b, h) + boff + n * 2048); } \
        else { _Pragma("unroll") for (int n = 0; n < 2; ++n) _Pragma("unroll") for (int k = 0; k < 2; ++k) dst[n][k] = *(const PG8_LAS bf16x8*)(lds + PG8_SB(b, h) + boff + n * 2048 + k * 1024); } } while (0)
#define PG8_MMA(ai, bj, At, Bt) do { __builtin_amdgcn_s_setprio(1); \
        if constexpr (F8) { _Pragma("unroll") for (int m = 0; m < 4; ++m) _Pragma("unroll") for (int n = 0; n < 2; ++n) \
            asm("v_mfma_scale_f32_16x16x128_f8f6f4 %0, %1, %2, %0, %3, %3 op_sel_hi:[0,0,0]" : "+v"(acc[ai][bj][m][n]) : "v"(Bt##8[n]), "v"(At##8[m]), "v"(f8sc_)); } \
        else { _Pragma("unroll") for (int m = 0; m < 4; ++m) _Pragma("unroll") for (int n = 0; n < 2; ++n) _Pragma("unroll") for (int k = 0; k < 2; ++k) \
        { if constexpr (I8) acc[ai][bj][m][n] = __builtin_amdgcn_mfma_i32_16x16x64_i8(__builtin_bit_cast(i32x4, Bt[n][k]), __builtin_bit_cast(i32x4, At[m][k]), acc[ai][bj][m][n], 0, 0, 0); \
          else acc[ai][bj][m][n] = __builtin_amdgcn_mfma_f32_16x16x32_bf16(Bt[n][k], At[m][k], acc[ai][bj][m][n], 0, 0, 0); } } __builtin_amdgcn_s_setprio(0); } while (0)
#define PG8_WAIT_V(n) asm volatile("s_waitcnt vmcnt(" #n ")" ::: "memory")
#define PG8_WAIT_L(n) asm volatile("s_waitcnt lgkmcnt(" #n ")" ::: "memory")
#define PG8_BAR __builtin_amdgcn_s_barrier()
#define PG8_SCHED __builtin_amdgcn_sched_barrier(0)
    Unit cur, nxt; int ui = 0;
    if (!S.next(0, cur)) return;
    typedef typename AccSel<I8>::type AccV; AccV acc[2][2][4][2];
#pragma unroll
    for (int a = 0; a < 2; ++a)
#pragma unroll
        for (int b = 0; b < 2; ++b)
#pragma unroll
            for (int m = 0; m < 4; ++m)
#pragma unroll
                for (int n = 0; n < 2; ++n) acc[a][b][m][n] = (AccV){0, 0, 0, 0};
    bf16x8 At[4][2], B0[2][2], B1[2][2]; i32x8 At8[4], B08[2], B18[2];
    int f8sc_ = 127; asm volatile("" : "+v"(f8sc_));
    const char* cA = (const char*)g.A + (GATHER ? (size_t)0 : (size_t)cur.pm * tstep); PG8_GOFF(vgC, cur); const char* cB = (const char*)g.Bt + (size_t)cur.pb * tstep;
    typename Sched::Raw raw; unsigned rawrt[2][2];
#define PG8_GRAW(i_) do { S.prefetch((i_), raw); if constexpr (GATHER) { int tl_ = S.tile_of(i_); tl_ = tl_ < 0 ? 0 : tl_; _Pragma("unroll") for (int _h = 0; _h < 2; ++_h) _Pragma("unroll") for (int _i = 0; _i < 2; ++_i) \
        rawrt[_h][_i] = (unsigned)S.rowtok[tl_ * BM + _h * HALF + gR[_i]]; } } while (0)
    PG8_GRAW(1);
    S.a_ready(cur);
    if constexpr (SP2) {
        PG8_STAGE(PG8_SB(0, 0), cB, voffB); PG8_STAGE(PG8_SB(0, 1), cB + hstep, voffB); PG8_STAGEA(PG8_SA(0, 0), cA, 0, false); PG8_STAGEA(PG8_SA(0, 1), cA, 1, false);
        if (wr == 1) PG8_BAR;
        PG8_WAIT_V(2); PG8_BAR;
        PG8_STAGE(PG8_SB(1, 0), cB + kstep, voffB); PG8_STAGEA(PG8_SA(1, 0), cA + kstep, 0, false); PG8_STAGE(PG8_SB(1, 1), cB + hstep + kstep, voffB);
        PG8_WAIT_V(6); PG8_BAR;
    } else {
        PG8_STAGE(PG8_SB(0, 0), cB, voffB); PG8_STAGEA(PG8_SA(0, 0), cA, 0, false); PG8_STAGE(PG8_SB(0, 1), cB + hstep, voffB); PG8_STAGEA(PG8_SA(0, 1), cA, 1, false);
        if (wr == 1) PG8_BAR;
        PG8_WAIT_V(4); PG8_BAR;
        PG8_STAGE(PG8_SB(1, 0), cB + kstep, voffB); PG8_STAGEA(PG8_SA(1, 0), cA + kstep, 0, false); PG8_STAGE(PG8_SB(1, 1), cB + hstep + kstep, voffB);
        PG8_WAIT_V(6); PG8_BAR;
    }
    for (;;) {
        const bool has_next = S.finish(ui + 1, raw, nxt);
        const char* nA = has_next ? (const char*)g.A + (GATHER ? (size_t)0 : (size_t)nxt.pm * tstep) : cA;
        if constexpr (GATHER) { if (has_next) { _Pragma("unroll") for (int _h = 0; _h < 2; ++_h) _Pragma("unroll") for (int _i = 0; _i < 2; ++_i) vgN[_h][_i] = rawrt[_h][_i] * (unsigned)(K * 2) + (unsigned)(gC[_i] * 2); } else { _Pragma("unroll") for (int _h = 0; _h < 2; ++_h) _Pragma("unroll") for (int _i = 0; _i < 2; ++_i) vgN[_h][_i] = vgC[_h][_i]; } }
        const char* nB = has_next ? (const char*)g.Bt + (size_t)nxt.pb * tstep : cB;
        for (int t = 0; t < nt; t += 2) {
            const bool last = (t == nt - 2);
            const char* a1 = cA + (size_t)(t + 1) * kstep;
            const char* a2 = last ? nA : cA + (size_t)(t + 2) * kstep; const char* b2 = last ? nB : cB + (size_t)(t + 2) * kstep;
            const char* a3 = a2 + kstep; const char* b3 = b2 + kstep;
            if (last && has_next) S.a_ready(nxt);
            if constexpr (SP2) {
            PG8_LDB(B0, 0, 0); PG8_LDB(B1, 0, 1); PG8_SCHED; PG8_LDA(At, 0, 0); PG8_STAGEA(PG8_SA(1, 1), a1, 1, false);
            PG8_WAIT_V(8); PG8_WAIT_L(0); PG8_BAR; PG8_MMA(0, 0, At, B0); PG8_MMA(0, 1, At, B1); PG8_BAR; PG8_SCHED;
            PG8_LDA(At, 0, 1); PG8_STAGE(PG8_SB(0, 0), b2, voffB); PG8_STAGE(PG8_SB(0, 1), b2 + hstep, voffB); PG8_STAGEA(PG8_SA(0, 0), a2, 0, last);
            PG8_WAIT_V(8); PG8_WAIT_L(0); PG8_BAR; PG8_MMA(1, 0, At, B0); PG8_MMA(1, 1, At, B1); PG8_BAR; PG8_SCHED;
            PG8_LDB(B0, 1, 0); PG8_LDB(B1, 1, 1); PG8_SCHED; PG8_LDA(At, 1, 0); PG8_STAGEA(PG8_SA(0, 1), a2, 1, last);
            PG8_WAIT_V(8); PG8_WAIT_L(0); PG8_BAR; PG8_MMA(0, 0, At, B0); PG8_MMA(0, 1, At, B1); PG8_BAR; PG8_SCHED;
            PG8_LDA(At, 1, 1); PG8_STAGE(PG8_SB(1, 0), b3, voffB); PG8_STAGE(PG8_SB(1, 1), b3 + hstep, voffB); PG8_STAGEA(PG8_SA(1, 0), a3, 0, last);
            PG8_WAIT_V(8); PG8_WAIT_L(0); PG8_BAR; PG8_MMA(1, 0, At, B0); PG8_MMA(1, 1, At, B1); PG8_BAR; PG8_SCHED;
            } else {
            PG8_LDB(B0, 0, 0); PG8_SCHED; PG8_LDA(At, 0, 0); PG8_STAGEA(PG8_SA(1, 1), a1, 1, false);
            PG8_WAIT_L(8); PG8_BAR; PG8_WAIT_L(0); PG8_MMA(0, 0, At, B0); PG8_BAR; PG8_SCHED;
            PG8_LDB(B1, 0, 1); PG8_STAGE(PG8_SB(0, 0), b2, voffB);
            PG8_BAR; PG8_WAIT_L(0); PG8_MMA(0, 1, At, B1); PG8_BAR;
            PG8_LDA(At, 0, 1); PG8_STAGEA(PG8_SA(0, 0), a2, 0, last);
            PG8_BAR; PG8_WAIT_L(0); PG8_MMA(1, 0, At, B0); PG8_BAR; PG8_SCHED;
            PG8_STAGE(PG8_SB(0, 1), b2 + hstep, voffB);
            PG8_WAIT_V(6); PG8_BAR; PG8_MMA(1, 1, At, B1); PG8_BAR;
            PG8_LDB(B0, 1, 0); PG8_SCHED; PG8_LDA(At, 1, 0); PG8_STAGEA(PG8_SA(0, 1), a2, 1, last);
            PG8_WAIT_L(8); PG8_BAR; PG8_WAIT_L(0); PG8_MMA(0, 0, At, B0); PG8_BAR; PG8_SCHED;
            PG8_LDB(B1, 1, 1); PG8_STAGE(PG8_SB(1, 0), b3, voffB);
            PG8_BAR; PG8_WAIT_L(0); PG8_MMA(0, 1, At, B1); PG8_BAR;
            PG8_LDA(At, 1, 1); PG8_STAGEA(PG8_SA(1, 0), a3, 0, last);
            PG8_BAR; PG8_WAIT_L(0); PG8_MMA(1, 0, At, B0); PG8_BAR; PG8_SCHED;
            PG8_STAGE(PG8_SB(1, 1), b3 + hstep, voffB);
            PG8_WAIT_V(6); PG8_BAR; PG8_MMA(1, 1, At, B1); PG8_BAR;
            }
        }
        if constexpr (ALIGN_EPI) { if (wr == 0) PG8_BAR; }
        PG8_GRAW(ui + 2);
        if constexpr (F8) {
#pragma unroll
            for (int a_ = 0; a_ < 2; ++a_)
#pragma unroll
                for (int b_ = 0; b_ < 2; ++b_) asm volatile("s_nop 15\n\ts_nop 7" : "+v"(acc[a_][b_][0][0]), "+v"(acc[a_][b_][0][1]), "+v"(acc[a_][b_][1][0]), "+v"(acc[a_][b_][1][1]), "+v"(acc[a_][b_][2][0]), "+v"(acc[a_][b_][2][1]), "+v"(acc[a_][b_][3][0]), "+v"(acc[a_][b_][3][1]));
        }
        if constexpr (!Epi::AFTER_DRAIN) { E(acc, cur, wr, wc, fr, fq); S.done(cur); }
        if constexpr (Epi::DRAIN_AFTER) __builtin_amdgcn_s_waitcnt(0x0F70);
        if (!has_next) break;
#pragma unroll
        for (int a = 0; a < 2; ++a)
#pragma unroll
            for (int b = 0; b < 2; ++b)
#pragma unroll
                for (int m = 0; m < 4; ++m)
#pragma unroll
                    for (int n = 0; n < 2; ++n) acc[a][b][m][n] = (AccV){0, 0, 0, 0};
        cur = nxt; cA = nA; cB = nB; ++ui;
        if constexpr (GATHER) { _Pragma("unroll") for (int _h = 0; _h < 2; ++_h) _Pragma("unroll") for (int _i = 0; _i < 2; ++_i) vgC[_h][_i] = vgN[_h][_i]; }
        if constexpr (ALIGN_EPI) { if (wr == 1) PG8_BAR; }
    }
    PG8_WAIT_V(0);
    if constexpr (!ALIGN_EPI) { if (wr == 0) PG8_BAR; }
    PG8_BAR;
    if constexpr (Epi::AFTER_DRAIN) { E.fused(acc, cur, wr, wc, fr, fq, lds, wid, lane); S.done(cur); }
#undef PG8_SA
#undef PG8_SB
#undef PG8_STAGE
#undef PG8_STAGEA
#undef PG8_GOFF
#undef PG8_GRAW
#undef PG8_LDA
#undef PG8_LDF8
#undef PG8_LDB
#undef PG8_MMA
#undef PG8_WAIT_V
#undef PG8_WAIT_L
#undef PG8_BAR
#undef PG8_SCHED
}
}

#include <hip/hip_bf16.h>
#include <cmath>
namespace attn_body {
using bf16=__hip_bfloat16;
using bf16x8=__attribute__((ext_vector_type(8)))short;
using s16x4=__attribute__((ext_vector_type(4)))short;
using f32x16=__attribute__((ext_vector_type(16)))float;
using u32x4=__attribute__((ext_vector_type(4)))unsigned;
constexpr int BATCH=32,NHEAD=16,SEQ=2048,D=64,DM=NHEAD*D;
constexpr int NW=8,QBLK=32,QB=QBLK*NW,KVBLK=64,NQB=SEQ/QB;
constexpr int ATTN_PITCH=DM, ATTN_UNIT_ROWS=QB;
__device__ __forceinline__ int crow(int r,int hi){return (r&3)+8*(r>>2)+4*hi;}
#define SBAR() __builtin_amdgcn_sched_barrier(0)
__device__ __forceinline__ void cmask(f32x16&p0,f32x16&p1,int jb,int qrel,int hi){
  asm volatile("":"+v"(qrel));
  const float NEG=-INFINITY; int kb=64*jb+4*hi;
  #pragma unroll
  for(int r=0;r<16;++r){int kv=kb+(r&3)+8*(r>>2); if(kv>qrel)p0[r]=NEG; if(kv+32>qrel)p1[r]=NEG;}
}

constexpr int NSLOT=3, SLOTB=8192;
constexpr int LDS_K=0, LDS_V=NSLOT*SLOTB, LDS_WS=2*NSLOT*SLOTB, LDS_OST=LDS_WS+NW*64*4, LDS_BT=LDS_OST+NW*4096, LDS_BYTES=LDS_BT+SEQ*16;
constexpr float C2=0.125f*1.4426950408889634f;
__device__ __forceinline__ void glds16(const void*gsrc,unsigned lds_dst){unsigned keep;
  asm volatile("s_mov_b32 %0, m0\n\ts_mov_b32 m0, %2\n\ts_nop 0\n\tglobal_load_lds_dwordx4 %1, off\n\ts_mov_b32 m0, %0":"=&s"(keep):"v"(gsrc),"s"(lds_dst):"memory");}
__device__ __forceinline__ float max3f(float a,float b,float c){float r;asm("v_max3_f32 %0, %1, %2, %3":"=v"(r):"v"(a),"v"(b),"v"(c));return r;}
__device__ __forceinline__ float max2f(float a,float b){float r;asm("v_max_f32_e32 %0, %1, %2":"=v"(r):"v"(a),"v"(b));return r;}
__device__ __forceinline__ float fadd_s(float a,float b){float r;asm("v_add_f32_e32 %0, %1, %2":"=v"(r):"v"(a),"v"(b));return r;}
__device__ __forceinline__ float fsub_s(float a,float b){float r;asm("v_sub_f32_e32 %0, %1, %2":"=v"(r):"v"(a),"v"(b));return r;}
typedef float f32x2_t __attribute__((ext_vector_type(2))); typedef __bf16 bf16x2_t __attribute__((ext_vector_type(2)));
typedef unsigned u32x2 __attribute__((ext_vector_type(2))); constexpr float AO_SC=8.0f;
__device__ __forceinline__ unsigned pkf8x4(float a,float b,float c,float d){int w=0;w=__builtin_amdgcn_cvt_pk_fp8_f32(a,b,w,false);w=__builtin_amdgcn_cvt_pk_fp8_f32(c,d,w,true);return (unsigned)w;}
__device__ __forceinline__ unsigned cvtpk_s(float lo,float hi){f32x2_t v={lo,hi};bf16x2_t b=__builtin_convertvector(v,bf16x2_t);return __builtin_bit_cast(unsigned,b);}
#define WAIT_BAR(N) asm volatile("s_waitcnt vmcnt(" #N ") lgkmcnt(0)\n\ts_barrier":::"memory")

__device__ __forceinline__ void qkt(f32x16&p0,f32x16&p1,const char*Kslot,const bf16x8*qr,int r32,int hi,bf16x8 ba0,bf16x8 ba1,bf16x8 qaug){
  const char*kb=Kslot+hi*1024+r32*16;
  #pragma unroll
  for(int d0=0;d0<4;++d0){
    const bf16x8 b0=*reinterpret_cast<const bf16x8*>(kb+d0*2048);
    const bf16x8 b1=*reinterpret_cast<const bf16x8*>(kb+d0*2048+512);
    if(d0==0){p0=__builtin_amdgcn_mfma_f32_32x32x16_bf16(b0,qr[0],f32x16{},0,0,0);p1=__builtin_amdgcn_mfma_f32_32x32x16_bf16(b1,qr[0],f32x16{},0,0,0);}
    else{p0=__builtin_amdgcn_mfma_f32_32x32x16_bf16(b0,qr[d0],p0,0,0,0);p1=__builtin_amdgcn_mfma_f32_32x32x16_bf16(b1,qr[d0],p1,0,0,0);}}
  p0=__builtin_amdgcn_mfma_f32_32x32x16_bf16(ba0,qaug,p0,0,0,0);p1=__builtin_amdgcn_mfma_f32_32x32x16_bf16(ba1,qaug,p1,0,0,0);
}
typedef __attribute__((address_space(3))) const char* lds_cptr;
typedef short v4i16_t __attribute__((ext_vector_type(4)));
__device__ __forceinline__ void kload8(bf16x8*kf,lds_cptr kp){
  kf[0]=*(const __attribute__((address_space(3))) bf16x8*)(kp);      kf[1]=*(const __attribute__((address_space(3))) bf16x8*)(kp+512);
  kf[2]=*(const __attribute__((address_space(3))) bf16x8*)(kp+2048); kf[3]=*(const __attribute__((address_space(3))) bf16x8*)(kp+2560);
  kf[4]=*(const __attribute__((address_space(3))) bf16x8*)(kp+4096); kf[5]=*(const __attribute__((address_space(3))) bf16x8*)(kp+4608);
  kf[6]=*(const __attribute__((address_space(3))) bf16x8*)(kp+6144); kf[7]=*(const __attribute__((address_space(3))) bf16x8*)(kp+6656);
}
__device__ __forceinline__ void kload2(bf16x8*kf,lds_cptr kp,int j){ kf[2*j]=*(const __attribute__((address_space(3))) bf16x8*)(kp+j*2048); kf[2*j+1]=*(const __attribute__((address_space(3))) bf16x8*)(kp+j*2048+512); }
__device__ __forceinline__ s16x4 vtr(lds_cptr p){ return __builtin_bit_cast(s16x4,__builtin_amdgcn_ds_read_tr16_b64_v4i16((__attribute__((address_space(3))) v4i16_t*)p)); }
__device__ __forceinline__ float rowmax(const f32x16&p0,const f32x16&p1){
  float a=max3f(p0[0],p0[1],p1[0]),b=max3f(p0[2],p0[3],p1[1]);a=max3f(a,p1[2],p1[3]);
  #pragma unroll
  for(int r=4;r<16;r+=4){a=max3f(a,p0[r],p0[r+1]);b=max3f(b,p0[r+2],p0[r+3]);a=max3f(a,p1[r],p1[r+1]);b=max3f(b,p1[r+2],p1[r+3]);}
  const float m=max2f(a,b);
  auto rr=__builtin_amdgcn_permlane32_swap(__float_as_uint(m),__float_as_uint(m),false,false);
  return max2f(__uint_as_float(rr[0]),__uint_as_float(rr[1]));
}
__device__ __forceinline__ void pv(f32x16*o,int vb,bf16x8 pa0,bf16x8 pa1,bf16x8 pa2,bf16x8 pa3){
  #pragma unroll
  for(int d0=0;d0<2;++d0){s16x4 lo[4],hi[4];
    #pragma unroll
    for(int ks=0;ks<4;++ks){
      asm volatile("ds_read_b64_tr_b16 %0,%1 offset:%c2":"=&v"(lo[ks]):"v"(vb),"i"(d0*4096+ks*1024):"memory");
      asm volatile("ds_read_b64_tr_b16 %0,%1 offset:%c2":"=&v"(hi[ks]):"v"(vb),"i"(d0*4096+ks*1024+512):"memory");}
    asm volatile("s_waitcnt lgkmcnt(0)":::"memory");SBAR();
    #define PK(k) (bf16x8){lo[k][0],lo[k][1],lo[k][2],lo[k][3],hi[k][0],hi[k][1],hi[k][2],hi[k][3]}
    o[d0]=__builtin_amdgcn_mfma_f32_32x32x16_bf16(pa0,PK(0),o[d0],0,0,0);
    o[d0]=__builtin_amdgcn_mfma_f32_32x32x16_bf16(pa1,PK(1),o[d0],0,0,0);
    o[d0]=__builtin_amdgcn_mfma_f32_32x32x16_bf16(pa2,PK(2),o[d0],0,0,0);
    o[d0]=__builtin_amdgcn_mfma_f32_32x32x16_bf16(pa3,PK(3),o[d0],0,0,0);
    #undef PK
  }
}

#ifndef ATTN_STORE16
#define ATTN_STORE16(p,v) (*(u32x4*)(p)=(v))
#endif
template<int THRL> __device__ __forceinline__ void attn_unit(int b,int h,int qb,const bf16*Q,const bf16*__restrict__ K,const bf16*__restrict__ V,bf16*O,const bf16*__restrict__ SG,const float*__restrict__ brow,float skipthr,char*shm,const int mk_wave){
  const int lane=mk_lane(),r32=lane&31,hi=lane>>5; const int wid=mk_wave; const int tid=wid*64+lane; (void)tid;
  const long rowbase=(long)b*SEQ; const int q0=qb*QB;
  const bf16*Qw=Q+(rowbase+q0+wid*QBLK)*DM+h*D;
  int ts; { const int NT0=(q0+QB)/KVBLK; const float thr_=brow[q0]-skipthr; const float bl_=(lane<NT0-4)?brow[KVBLK*lane+KVBLK-1]:INFINITY; const unsigned long long m_=__ballot(bl_<thr_);
    ts=(int)__builtin_ctzll(~m_); ts=(ts>NT0-4?NT0-4:ts)&~1; ts=__builtin_amdgcn_readfirstlane(ts); }
  const bf16*Kh=K+(rowbase+(long)ts*KVBLK)*DM+h*D,*Vh=V+(rowbase+(long)ts*KVBLK)*DM+h*D;
  const unsigned lds0=(unsigned)(uintptr_t)shm;
  float*wsf=(float*)(shm+LDS_WS)+wid*64;
  const bf16*ksrc=Kh+(long)lane*DM+wid*8;
  const bf16*vsrc=Vh+(long)(16*(wid&3)+(lane>>2))*DM+(wid>>2)*32+(lane&3)*8;
  const unsigned kdst=lds0+LDS_K+wid*1024, vdst=lds0+LDS_V+wid*1024;
  #define DMA_K(t,slot) glds16(ksrc+(long)(t)*KVBLK*DM,(unsigned)__builtin_amdgcn_readfirstlane(kdst+(slot)))
  #define DMA_V(t,slot) glds16(vsrc+(long)(t)*KVBLK*DM,(unsigned)__builtin_amdgcn_readfirstlane(vdst+(slot)))
  const int vb0=(int)(lds0+LDS_V)+((lane>>4)&1)*32+(lane&3)*8+(4*hi+((lane&15)>>2))*64;
  const char*Kbase=shm+LDS_K; bf16x8 kf[8];
  const lds_cptr shm3=(lds_cptr)shm; const lds_cptr kp0=shm3+LDS_K+hi*1024+r32*16; const lds_cptr vp0=shm3+LDS_V+((lane>>4)&1)*32+(lane&3)*8+(4*hi+((lane&15)>>2))*64;
  const int NT=(q0+QB)/KVBLK-ts;
  const lds_cptr btp=shm3+LDS_BT+(ts*KVBLK+r32)*16;
  unsigned qref1=(hi==0)?0x00003F80u:0u, qref2=0u;
  #define SETREF() do{ const float x_=-mhat; const unsigned h0_=cvtpk_s(x_,0.f)&0xffffu; const float r1_=x_-__uint_as_float(h0_<<16); const unsigned h1_=cvtpk_s(r1_,0.f)&0xffffu; const float r2_=r1_-__uint_as_float(h1_<<16); const unsigned h2_=cvtpk_s(r2_,0.f)&0xffffu; \
      qref1=(hi==0)?(0x3F80u|(h0_<<16)):0u; qref2=(hi==0)?(h1_|(h2_<<16)):0u; }while(0)
  #define qaug __builtin_bit_cast(bf16x8,((u32x4){(hi==0)?0x3F803F80u:0u,qref1,qref2,0u}))
  #define BIASF(t,half) (*(const __attribute__((address_space(3))) bf16x8*)(btp+((t)*KVBLK+(half)*32)*16))
  DMA_K(0,0);DMA_V(0,0);DMA_K(1,SLOTB);
  bf16x8 qr[4];
  #pragma unroll
  for(int d0=0;d0<4;++d0)qr[d0]=*reinterpret_cast<const bf16x8*>(&Qw[(long)r32*DM+d0*16+hi*8]);
  float mhat=0.f,l_reg=0.f;f32x16 o[2];o[0]=f32x16{};o[1]=f32x16{};
  const int qrel=wid*QBLK+r32;
  #define CMASK(P0,P1,t) do{int jb_=(t)-(NT-4); if(jb_>=0)cmask(P0,P1,jb_,qrel,hi);}while(0)
  bool resc=false;
  const float refb_=brow[q0+wid*QBLK+r32]+0.5f*(skipthr-64.0f);
  #define START_NOTE
  #define START(P0,P1) do{ const float rm=refb_; resc=false; \
    { const float dl=rm; mhat=fadd_s(mhat,dl); \
      _Pragma("unroll") for(int r=0;r<16;++r){P0[r]=fsub_s(P0[r],dl);P1[r]=fsub_s(P1[r],dl);} \
      SETREF(); } \
    _Pragma("unroll") for(int r=0;r<16;++r)P0[r]=__builtin_amdgcn_exp2f(P0[r]); }while(0)
  #define RESC() do{ if(resc){ asm volatile("s_waitcnt lgkmcnt(0)":::"memory"); \
      _Pragma("unroll") for(int d_=0;d_<2;++d_) _Pragma("unroll") for(int r=0;r<16;++r)o[d_][r]*=wsf[crow(r,hi)]; } }while(0)
  f32x16 pA0,pA1,pB0,pB1;
  int sl_prev=0,sl_cur=0,sl_next=SLOTB;
  #define ROT() do{sl_prev=sl_cur;sl_cur=sl_next;sl_next=(sl_next==(NSLOT-1)*SLOTB)?0:sl_next+SLOTB;}while(0)
  DMA_K(2,2*SLOTB);
  WAIT_BAR(3);
  { const bf16x8 ba0_=BIASF(0,0),ba1_=BIASF(0,1); qkt(pA0,pA1,Kbase,qr,r32,hi,ba0_,ba1_,qaug); }asm volatile("s_nop 15\n\ts_nop 7":"+v"(pA0),"+v"(pA1));CMASK(pA0,pA1,0);
  START(pA0,pA1);
  _Pragma("unroll") for(int r=0;r<16;++r)pA1[r]=__builtin_amdgcn_exp2f(pA1[r]);
  WAIT_BAR(0);
  DMA_K(3,0);DMA_V(1,SLOTB);
  ROT();
  kload8(kf,kp0+sl_cur);
  WAIT_BAR(2);
  s16x4 vlo[8],vhi[8]; u32x4 pw0,pw1,pw2,pw3;
  #define PKW(P,B) cvtpk_s(P[B],P[B+1])
  #define PAF(k) __builtin_bit_cast(bf16x8,pw##k)
  #define VFR(i) (bf16x8){vlo[i][0],vlo[i][1],vlo[i][2],vlo[i][3],vhi[i][0],vhi[i][1],vhi[i][2],vhi[i][3]}
  #define PIN(x) asm volatile("":"+v"(x))
  #define MX3(a,b,c) __builtin_fmaxf(__builtin_fmaxf((a),(b)),(c))
  #define GAPA(MF,A0,A1,A2,A3,W0,W1,PW) do{ MF; sacc+=A0; sacc+=A1; sacc+=A2; sacc+=A3; PIN(sacc); W0; W1; PIN(PW); SBAR(); }while(0)
  #define EX(v) __builtin_amdgcn_exp2f(v)
  #define GAPB(MF,X,B) do{ MF; X[B]=EX(X[B]); X[B+1]=EX(X[B+1]); X[B+2]=EX(X[B+2]); X[B+3]=EX(X[B+3]); PIN(X); SBAR(); }while(0)
  #define VRD(i) do{ vlo[i]=vtr(vp_+(((i)>>2)*4096+((i)&3)*1024)); vhi[i]=vtr(vp_+(((i)>>2)*4096+((i)&3)*1024+512)); }while(0)
  #define KRD(G,j) do{ if(G){ kload2(kf,kp0+sl_next,j); SBAR(); } }while(0)
  #define STEP(C0,C1,P0,P1,t,GK,GV,GL) do{ SBAR(); \
    const lds_cptr vp_=vp0+sl_prev; \
    VRD(0); SBAR(); float sacc=(P0[0]+P0[1]); \
    GAPA(C0=__builtin_amdgcn_mfma_f32_32x32x16_bf16(kf[0],qr[0],f32x16{},0,0,0), P0[2],P0[3],P0[4],P0[5],     pw0[0]=PKW(P0,0), pw0[1]=PKW(P0,2), pw0); \
    VRD(4); SBAR(); GAPA(C1=__builtin_amdgcn_mfma_f32_32x32x16_bf16(kf[1],qr[0],f32x16{},0,0,0), P0[6],P0[7],P0[8],P0[9],     pw0[2]=PKW(P0,4), pw0[3]=PKW(P0,6), pw0); \
    VRD(1); SBAR(); GAPA(C0=__builtin_amdgcn_mfma_f32_32x32x16_bf16(kf[2],qr[1],C0,0,0,0),   P0[10],P0[11],P0[12],P0[13], pw1[0]=PKW(P0,8), pw1[1]=PKW(P0,10), pw1); \
    VRD(5); SBAR(); GAPA(C1=__builtin_amdgcn_mfma_f32_32x32x16_bf16(kf[3],qr[1],C1,0,0,0),   P0[14],P0[15],P1[0],P1[1],   pw1[2]=PKW(P0,12),pw1[3]=PKW(P0,14), pw1); \
    VRD(2); SBAR(); GAPA(C0=__builtin_amdgcn_mfma_f32_32x32x16_bf16(kf[4],qr[2],C0,0,0,0),   P1[2],P1[3],P1[4],P1[5],     pw2[0]=PKW(P1,0), pw2[1]=PKW(P1,2), pw2); \
    VRD(6); SBAR(); GAPA(C1=__builtin_amdgcn_mfma_f32_32x32x16_bf16(kf[5],qr[2],C1,0,0,0),   P1[6],P1[7],P1[8],P1[9],     pw2[2]=PKW(P1,4), pw2[3]=PKW(P1,6), pw2); \
    VRD(3); SBAR(); GAPA(C0=__builtin_amdgcn_mfma_f32_32x32x16_bf16(kf[6],qr[3],C0,0,0,0),   P1[10],P1[11],P1[12],P1[13], pw3[0]=PKW(P1,8), pw3[1]=PKW(P1,10), pw3); \
    VRD(7); SBAR(); GAPA(C1=__builtin_amdgcn_mfma_f32_32x32x16_bf16(kf[7],qr[3],C1,0,0,0),   P1[14],P1[15],0.f,0.f,       pw3[2]=PKW(P1,12),pw3[3]=PKW(P1,14), pw3); \
    { const bf16x8 ba0_=BIASF(t,0); C0=__builtin_amdgcn_mfma_f32_32x32x16_bf16(ba0_,qaug,C0,0,0,0); } { const bf16x8 ba1_=BIASF(t,1); C1=__builtin_amdgcn_mfma_f32_32x32x16_bf16(ba1_,qaug,C1,0,0,0); } SBAR(); \
    l_reg+=sacc; \
    if(GK){DMA_K((t)+3,sl_cur);} if(GV){DMA_V((t)+1,sl_next);} \
    CMASK(C0,C1,t); \
      \
    SBAR(); \
    GAPB(o[0]=__builtin_amdgcn_mfma_f32_32x32x16_bf16(PAF(0),VFR(0),o[0],0,0,0), C0,0); \
    GAPB(o[1]=__builtin_amdgcn_mfma_f32_32x32x16_bf16(PAF(0),VFR(4),o[1],0,0,0), C0,4); \
    KRD(GL,0); GAPB(o[0]=__builtin_amdgcn_mfma_f32_32x32x16_bf16(PAF(1),VFR(1),o[0],0,0,0), C0,8); \
    KRD(GL,1); GAPB(o[1]=__builtin_amdgcn_mfma_f32_32x32x16_bf16(PAF(1),VFR(5),o[1],0,0,0), C0,12); \
    KRD(GL,2); GAPB(o[0]=__builtin_amdgcn_mfma_f32_32x32x16_bf16(PAF(2),VFR(2),o[0],0,0,0), C1,0); \
    KRD(GL,3); GAPB(o[1]=__builtin_amdgcn_mfma_f32_32x32x16_bf16(PAF(2),VFR(6),o[1],0,0,0), C1,4); \
    GAPB(o[0]=__builtin_amdgcn_mfma_f32_32x32x16_bf16(PAF(3),VFR(3),o[0],0,0,0), C1,8); \
    GAPB(o[1]=__builtin_amdgcn_mfma_f32_32x32x16_bf16(PAF(3),VFR(7),o[1],0,0,0), C1,12); \
    }while(0)
  int t=1;
  #undef CMASK
  #define CMASK(P0,P1,t) do{}while(0)
  for(;t+5<NT;t+=2){
    STEP(pB0,pB1,pA0,pA1,t,true,true,true);     WAIT_BAR(2); RESC(); ROT();
    STEP(pA0,pA1,pB0,pB1,t+1,true,true,true);   WAIT_BAR(2); RESC(); ROT();
  }
  #undef CMASK
  #define CMASK(P0,P1,t) do{int jb_=(t)-(NT-4); if(jb_>=0)cmask(P0,P1,jb_,qrel,hi);}while(0)
  #define ENDW(tt) do{ if((tt)+3<NT){WAIT_BAR(2);} else if((tt)+2<NT){WAIT_BAR(1);} else {WAIT_BAR(0);} }while(0)
  for(;t+1<NT;t+=2){
    STEP(pB0,pB1,pA0,pA1,t,(t+3<NT),(t+1<NT),(t+1<NT));       ENDW(t);   RESC(); ROT();
    STEP(pA0,pA1,pB0,pB1,t+1,(t+4<NT),(t+2<NT),(t+2<NT));     ENDW(t+1); RESC(); ROT();
  }
  STEP(pB0,pB1,pA0,pA1,NT-1,false,false,false); RESC();
  { float sacc=pB0[0]+pB0[1]; _Pragma("unroll") for(int r=2;r<16;++r)sacc+=pB0[r]; _Pragma("unroll") for(int r=0;r<16;++r)sacc+=pB1[r]; l_reg+=sacc;
    pw0=(u32x4){PKW(pB0,0),PKW(pB0,2),PKW(pB0,4),PKW(pB0,6)};pw1=(u32x4){PKW(pB0,8),PKW(pB0,10),PKW(pB0,12),PKW(pB0,14)};pw2=(u32x4){PKW(pB1,0),PKW(pB1,2),PKW(pB1,4),PKW(pB1,6)};pw3=(u32x4){PKW(pB1,8),PKW(pB1,10),PKW(pB1,12),PKW(pB1,14)};
    SBAR(); pv(o,vb0+sl_cur,PAF(0),PAF(1),PAF(2),PAF(3)); }
  #undef PKW
  #undef PAF
  #undef VFR
  #undef PIN
  #undef MX3
  #undef GAPA
  #undef GAPB
  #undef EX
  #undef VRD
  #undef KRD
  #undef STEP
  #undef ENDW
  {auto rr=__builtin_amdgcn_permlane32_swap(__float_as_uint(l_reg),__float_as_uint(l_reg),false,false);l_reg=__uint_as_float(rr[0])+__uint_as_float(rr[1]);}
  if(hi==0)wsf[32+r32]=l_reg;asm volatile("s_waitcnt lgkmcnt(0)":::"memory");
  float rli[16];
  #pragma unroll
  for(int r=0;r<16;++r)rli[r]=__builtin_amdgcn_rcpf(wsf[32+crow(r,hi)]);
  unsigned char*Ow=(unsigned char*)O+(rowbase+q0+wid*QBLK)*DM+h*D; const bf16*SGw=SG+(rowbase+q0+wid*QBLK)*DM+h*D;
  { bf16*stg=(bf16*)(shm+LDS_OST)+wid*2048;
    #pragma unroll
    for(int r=0;r<16;++r){const int orow=crow(r,hi);
      #pragma unroll
      for(int d0=0;d0<2;++d0)stg[orow*64+d0*32+r32]=__float2bfloat16(o[d0][r]*rli[r]);}
    asm volatile("s_waitcnt lgkmcnt(0)":::"memory");
    #pragma unroll
    for(int i=0;i<4;++i){const int row=i*8+(lane>>3),ch=lane&7; u32x4 v=*(const u32x4*)(stg+row*64+ch*8); const u32x4 g=*(const u32x4*)(SGw+(long)row*DM+ch*8);
      float af[8]; _Pragma("unroll") for(int e_=0;e_<4;++e_){ af[2*e_]=__builtin_amdgcn_fmed3f(__uint_as_float(v[e_]<<16)*__uint_as_float(g[e_]<<16)*AO_SC,-448.0f,448.0f); af[2*e_+1]=__builtin_amdgcn_fmed3f(__uint_as_float(v[e_]&0xffff0000u)*__uint_as_float(g[e_]&0xffff0000u)*AO_SC,-448.0f,448.0f); }
      *(u32x2*)(Ow+(long)row*DM+ch*8)=(u32x2){pkf8x4(af[0],af[1],af[2],af[3]),pkf8x4(af[4],af[5],af[6],af[7])};} }
  asm volatile("s_waitcnt lgkmcnt(0)\n\ts_barrier":::"memory");
  #undef DMA_K
  #undef DMA_V
  #undef CMASK
  #undef START
  #undef RESC
  #undef ROT
  #undef BIASF
  #undef SETREF
  #undef qaug
}
constexpr int ATTN_LDS_BYTES=LDS_BYTES;
struct AttnTensors { const bf16* Q; const bf16* K; const bf16* V; bf16* O; const bf16* SG; const float* BIAS; float skipthr; };
struct AttnUnit { int bh; int qb; };
struct StaticOrder {
  int vcu,G;
  __device__ __forceinline__ explicit StaticOrder(int grid,int block):vcu(block),G(grid){}
  __device__ __forceinline__ bool next(int i,AttnUnit&u)const{ int bh=vcu+(i>>3)*G; if(bh>=BATCH*NHEAD)return false; if((i>>3)&1)bh^=8; u.bh=bh; u.qb=i&7; return true; }
  __device__ __forceinline__ void a_ready(const AttnUnit&)const{}
  __device__ __forceinline__ void done(const AttnUnit&)const{}
};
__device__ __forceinline__ void fill_bias(const float*brow,char*shm,const int mk_wave){
  int kv0=mk_wave*64+mk_lane(); asm volatile("":"+v"(kv0));
  for(int kv=kv0;kv<SEQ;kv+=NW*64){ const float x=brow[kv];
    const unsigned h0=cvtpk_s(x,0.f)&0xffffu; const float r1=x-__uint_as_float(h0<<16);
    const unsigned h1=cvtpk_s(r1,0.f)&0xffffu; const float r2=r1-__uint_as_float(h1<<16);
    const unsigned h2=cvtpk_s(r2,0.f)&0xffffu;
    *(u32x4*)(shm+LDS_BT+kv*16)=(u32x4){h0|(h1<<16),h2|0x3F800000u,0x3F803F80u,0u}; }
}
template<class Sched,class Hook,int THRL=8> __device__ __forceinline__ void attn_phase(char*lds,const AttnTensors&T,const Sched&S,const int mk_wave,const Hook&hook){
  AttnUnit u;
  for(int i=0;S.next(i,u);++i){ S.a_ready(u); if((i&7)==0){ hook(i>>3); } if((i&7)==0) fill_bias(T.BIAS+(long)u.bh*SEQ,lds,mk_wave); attn_unit<THRL>(u.bh/NHEAD,u.bh%NHEAD,u.qb,T.Q,T.K,T.V,T.O,T.SG,T.BIAS+(long)u.bh*SEQ,T.skipthr,lds,mk_wave); S.done(u); }
}
#undef SBAR
#undef WAIT_BAR
}

#define GAS __attribute__((address_space(1)))
#define LAS __attribute__((address_space(3)))
typedef unsigned short bf16;
typedef unsigned v4u __attribute__((ext_vector_type(4)));
typedef float f32x4 __attribute__((ext_vector_type(4)));
typedef short bf16x8 __attribute__((ext_vector_type(8)));
typedef GAS unsigned gu32;
typedef GAS unsigned long long gu64;
#define RLX_AGENT __ATOMIC_RELAXED, __HIP_MEMORY_SCOPE_AGENT
#define LDS_WAIT() asm volatile("s_waitcnt lgkmcnt(0)" ::: "memory")
#define VM_WAIT() asm volatile("s_waitcnt vmcnt(0)" ::: "memory")
__device__ __forceinline__ unsigned long long rt() { return __builtin_amdgcn_s_memrealtime(); }
__device__ __forceinline__ unsigned f2bf(float f) { unsigned u = __builtin_bit_cast(unsigned, f); return (u + 0x7fffu + ((u >> 16) & 1u)) >> 16; }
typedef float f32x2_t_ __attribute__((ext_vector_type(2))); typedef __bf16 bf16x2_t_ __attribute__((ext_vector_type(2)));
__device__ __forceinline__ unsigned pk2(float lo, float hi) { f32x2_t_ v = {lo, hi}; bf16x2_t_ b = __builtin_convertvector(v, bf16x2_t_); return __builtin_bit_cast(unsigned, b); }

#define XB_TMO      128
#define XB_XCNT(j)  (256  + 64 * (j))
#define XB_XSUB(j)  (1280 + 64 * (j))
#define XB_XGEN(j)  (2304 + 64 * (j))
#define XB_TOP      3328
#define XB_TOPGEN   3392
#define XCD_BAR_WORDS 3456
#define XB_SPIN_CAP (1u << 18)

__device__ __forceinline__ unsigned xb_ld(unsigned* p)              { return __hip_atomic_load(p, __ATOMIC_RELAXED, __HIP_MEMORY_SCOPE_AGENT); }
__device__ __forceinline__ unsigned xb_add(unsigned* p, unsigned v) { return __hip_atomic_fetch_add(p, v, __ATOMIC_RELAXED, __HIP_MEMORY_SCOPE_AGENT); }
__device__ __forceinline__ unsigned xb_xcc_id() { return (unsigned)__builtin_amdgcn_s_getreg((3 << 11) | 20) & 0xFu; }
#define XB_SPIN(cond, bar) do { unsigned _sp = 0; while (cond) { __builtin_amdgcn_s_sleep(1); \
    if ((++_sp & 255u) == 0u) { if (xb_ld(&(bar)[XB_TMO])) break; if (_sp > XB_SPIN_CAP) { atomicAdd(&(bar)[XB_TMO], 1u); break; } } } } while (0)

struct XcdBarrier {
    unsigned* bar; unsigned x; int w;
    volatile LAS unsigned* st;
};

__device__ __forceinline__ XcdBarrier xcd_barrier_post(unsigned* bar, volatile LAS unsigned* st, int wave) {
    XcdBarrier b; b.bar = bar; b.x = xb_xcc_id(); b.st = st; b.w = wave;
    if (b.w == 0 && mk_lane() == 0) (void)xb_add(&bar[XB_XCNT(b.x)], 1u);
    return b;
}
__device__ __forceinline__ void xcd_barrier_complete(unsigned* bar, unsigned x, unsigned& nloc, unsigned& nx) {
    const unsigned G = gridDim.x * gridDim.y * gridDim.z;
    unsigned sum, cnt, mine, sp = 0u;
    for (;;) {
        sum = 0u; cnt = 0u; mine = 0u;
#pragma unroll
        for (unsigned j = 0; j < 16; ++j) { const unsigned c = xb_ld(&bar[XB_XCNT(j)]); sum += c; cnt += (c > 0u) ? 1u : 0u; mine = (j == x) ? c : mine; }
        if (sum == G) break;
        __builtin_amdgcn_s_sleep(1);
        if ((++sp & 255u) == 0u) { if (xb_ld(&bar[XB_TMO])) break; if (sp > XB_SPIN_CAP) { atomicAdd(&bar[XB_TMO], 1u); break; } }
    }
    nloc = mine > 0u ? mine : 1u; nx = cnt > 0u ? cnt : 1u;
}

__device__ __forceinline__ void xcd_barrier(const XcdBarrier& b) {
    asm volatile("s_waitcnt vmcnt(0)" ::: "memory");
    __syncthreads();
    if (b.w == 0 && mk_lane() == 0) {
        unsigned* bar = b.bar;
        __builtin_amdgcn_s_waitcnt(0);
        unsigned nloc = b.st[0], nx = b.st[1];
        if (nloc == 0u) { xcd_barrier_complete(bar, b.x, nloc, nx); b.st[0] = nloc; b.st[1] = nx; }
        const unsigned old = xb_add(&bar[XB_XSUB(b.x)], 1u);
        const unsigned gen = old / nloc;
        if (old + 1u == (gen + 1u) * nloc) {
            __builtin_amdgcn_fence(__ATOMIC_RELEASE, "agent");
            asm volatile("s_waitcnt vmcnt(0)" ::: "memory");
            const unsigned og = xb_add(&bar[XB_TOP], 1u);
            const unsigned tg = og / nx;
            if (og + 1u == (tg + 1u) * nx) xb_add(&bar[XB_TOPGEN], 1u);
            else XB_SPIN(xb_ld(&bar[XB_TOPGEN]) == tg, bar);
            __builtin_amdgcn_fence(__ATOMIC_ACQUIRE, "agent");
            xb_add(&bar[XB_XGEN(b.x)], 1u);
            asm volatile("s_waitcnt vmcnt(0)" ::: "memory");
        } else {
            XB_SPIN(xb_ld(&bar[XB_XGEN(b.x)]) == gen, bar);
            __builtin_amdgcn_fence(__ATOMIC_ACQUIRE, "agent");
            asm volatile("s_waitcnt vmcnt(0)" ::: "memory");
        }
    }
    __syncthreads();
}

constexpr int NWAVES = 8;
constexpr int NB = 32, SEQ = 2048, D = 1024, T = NB * SEQ, DEPTH = 4, NE = 32, TOPK = 4, NMOD = 6;
constexpr int NFOXP = 4352;
constexpr int TPAD = T * TOPK + NE * 256;
constexpr int NCHUNK = T / 256;
constexpr float EPS = 1e-6f;

constexpr size_t MiB = 1u << 20;
constexpr size_t WS_CTL = 0, CTL_ZERO_BYTES = 1 * MiB;
constexpr size_t WS_ROUTE = 1 * MiB;
constexpr size_t WS_MOD = 2 * MiB;
constexpr size_t WS_FL = 5 * MiB;
constexpr size_t WS_BIAS = 9 * MiB;
constexpr size_t WS_TOPI = 13 * MiB, WS_TOPW = 14 * MiB, WS_POS = 15 * MiB;
constexpr size_t WS_WFI = 16 * MiB, WS_WFO = 33 * MiB, WS_WHI = 37 * MiB, WS_WHO = 53 * MiB;
constexpr size_t WS_WGU = 64 * MiB, WS_WDN = 192 * MiB;
constexpr size_t WS_HN = 256 * MiB;
constexpr size_t WS_R1 = 384 * MiB;
constexpr size_t WS_ACT = 1024 * MiB;
constexpr size_t WS_XB = 1296 * MiB;
constexpr size_t WS_ROWTOK = 1552 * MiB;
constexpr size_t WS_SAROW = 1554 * MiB;
constexpr size_t WS_PART = 1554 * MiB + 0;
constexpr size_t WS_PARTM = 1556 * MiB;
constexpr size_t WS_END = 1558 * MiB;
constexpr size_t WS_SWM = WS_ROUTE + 768 * 1024;
constexpr size_t WS_SA = WS_ROUTE + 256 * 1024;
constexpr size_t WS_SW = WS_ROUTE + 512 * 1024;
constexpr int RT_NTILES = 0, RT_TEXP = 64, RT_HIST = 2048;
constexpr int CW_BAR = 4096;

constexpr int RING_OFF = 0, RING_BYTES = 131072;
constexpr int LSCR_OFF = RING_BYTES;
constexpr int LDSCTL_OFF = 163840 - 1024, MISC_OFF = LDSCTL_OFF + 320;
constexpr int LDS_BYTES = 163840;

__device__ __forceinline__ float wave_sum(float v) {
#pragma unroll
    for (int o = 1; o < 64; o <<= 1) v += __shfl_xor(v, o);
    return v;
}
__device__ __forceinline__ float wave_max(float v) {
#pragma unroll
    for (int o = 1; o < 64; o <<= 1) v = fmaxf(v, __shfl_xor(v, o));
    return v;
}
__device__ __forceinline__ float sigm_f(float x) { return __builtin_amdgcn_rcpf(1.0f + __expf(-x)); }
#define LBAR() do { asm volatile("s_waitcnt lgkmcnt(0)" ::: "memory"); __builtin_amdgcn_s_barrier(); asm volatile("" ::: "memory"); } while (0)

struct MapIdent { __device__ __forceinline__ int operator()(int n) const { return n; } };
struct MapFoxIn { __device__ __forceinline__ int operator()(int n) const { const int pn = n >> 8, s = n & 255, bj = s >> 7, wc = (s >> 5) & 3, j = s & 31, lc = 64 * wc + 32 * bj + j;
    return pn < 16 ? 256 * pn + lc : (lc < 16 ? 4096 + lc : -1); } };
struct MapGu { __device__ __forceinline__ int operator()(int n) const { const int pn = n >> 8, s = n & 255, bj = s >> 7, wc = (s >> 5) & 3, j = s & 31; return 2 * (128 * pn + 32 * wc + j) + bj; } };
template <class CM>
__device__ __forceinline__ void transpose_item(const float* W, int ldw, int K, bf16* WT, const CM& cm, LAS float* scr, int item, int nblk, int lane) {
    const int kb = item / nblk, nb = item - kb * nblk, k0 = 64 * kb, n0 = 32 * nb;
    const int col = cm(n0 + (lane & 31));
#pragma unroll 8
    for (int i = 0; i < 32; ++i) { const int kk = 2 * i + (lane >> 5); scr[kk * 33 + (lane & 31)] = (col >= 0) ? W[(size_t)(k0 + kk) * ldw + col] : 0.f; }
    LDS_WAIT(); asm volatile("" ::: "memory");
    const int c = lane & 7;
#pragma unroll
    for (int j = 0; j < 4; ++j) { const int n = (lane >> 3) + 8 * j; const LAS float* s = scr + (8 * c) * 33 + n;
        v4u o; o.x = pk2(s[0 * 33], s[1 * 33]); o.y = pk2(s[2 * 33], s[3 * 33]); o.z = pk2(s[4 * 33], s[5 * 33]); o.w = pk2(s[6 * 33], s[7 * 33]);
        *(GAS v4u*)(WT + (size_t)(n0 + n) * K + k0 + 8 * c) = o; }
    LDS_WAIT(); asm volatile("" ::: "memory");
}
template <class CM>
__device__ __forceinline__ void convert_matrix(const float* W, int ldw, int K, int Nd, bf16* WT, const CM& cm, LAS float* scr, int gw, int NGW, int lane) {
    const int nblk = Nd / 32, nitems = (K / 64) * nblk;
    for (int it = gw; it < nitems; it += NGW) transpose_item(W, ldw, K, WT, cm, scr, it, nblk, lane);
}

struct OrIdent { __device__ __forceinline__ int operator()(int c) const { return c; } };
struct OrGu { __device__ __forceinline__ int operator()(int c) const { const int a = c >> 1, bj = c & 1; return ((a >> 7) << 8) + (bj << 7) + (a & 127); } };
template <class OR>
__device__ __forceinline__ void convert_tile128(const float* W, int ldw, int K, bf16* WT, const OR& orow, LAS unsigned char* wl, int k0, int c0, int lane) {
    const int kk = lane >> 5, n4 = lane & 31;
#pragma unroll
    for (int bq = 0; bq < 2; ++bq) {
        f32x4 v[16];
#pragma unroll
        for (int it = 0; it < 16; ++it) v[it] = __builtin_nontemporal_load((const f32x4*)(W + (size_t)(k0 + 32 * bq + 16 * kk + it) * ldw + c0 + 4 * n4));
#pragma unroll
        for (int i = 0; i < 4; ++i) { const int c = 4 * n4 + i, sw = n4 & 7, ch = 4 * bq + 2 * kk;
            v4u w0, w1; w0.x = pk2(v[0][i], v[1][i]); w0.y = pk2(v[2][i], v[3][i]); w0.z = pk2(v[4][i], v[5][i]); w0.w = pk2(v[6][i], v[7][i]);
            w1.x = pk2(v[8][i], v[9][i]); w1.y = pk2(v[10][i], v[11][i]); w1.z = pk2(v[12][i], v[13][i]); w1.w = pk2(v[14][i], v[15][i]);
            *(LAS v4u*)(wl + c * 128 + ((ch ^ sw) << 4)) = w0; *(LAS v4u*)(wl + c * 128 + (((ch + 1) ^ sw) << 4)) = w1; }
    }
    LDS_WAIT(); asm volatile("" ::: "memory");
#pragma unroll
    for (int r = 0; r < 16; ++r) { const int c = 8 * r + (lane >> 3), ch = lane & 7; const v4u o = *(const LAS v4u*)(wl + c * 128 + ((ch ^ ((c >> 2) & 7)) << 4));
        *(GAS v4u*)(WT + (size_t)orow(c0 + c) * K + k0 + 8 * ch) = o; }
    LDS_WAIT(); asm volatile("" ::: "memory");
}
__device__ __forceinline__ void convert_experts_down(const float* wdn, bf16* WDN, LAS unsigned char* wl, int gw, int NGW, int lane) {
    for (int it = gw; it < 4096; it += NGW) { const int e = it >> 7, r = it & 127, kt = r >> 3, ct = r & 7;
        convert_tile128(wdn + (size_t)e * D * D, D, D, WDN + (size_t)e * D * D, OrIdent(), wl, 64 * kt, 128 * ct, lane); }
}
__device__ __forceinline__ void absmax_gu(const float* wgu, float* PART, int gw, int NGW, int lane) {
    const int kk = lane >> 5, n4 = lane & 31;
    for (int it = gw; it < 2048; it += NGW) {
        const int kq = it >> 9, e = (it >> 4) & 31, ct = it & 15;
        const float* src = wgu + ((size_t)e * D + 256 * kq + kk) * 2048 + 128 * ct + 4 * n4;
        f32x4 mx = (f32x4){0.f, 0.f, 0.f, 0.f};
#pragma unroll 16
        for (int i = 0; i < 128; ++i) { const f32x4 v = *(const f32x4*)(src + (size_t)(2 * i) * 2048);
            mx[0] = fmaxf(mx[0], fabsf(v[0])); mx[1] = fmaxf(mx[1], fabsf(v[1])); mx[2] = fmaxf(mx[2], fabsf(v[2])); mx[3] = fmaxf(mx[3], fabsf(v[3])); }
#pragma unroll
        for (int i = 0; i < 4; ++i) mx[i] = fmaxf(mx[i], __shfl_xor(mx[i], 32));
        if (kk == 0) *(f32x4*)(PART + ((size_t)kq * NE + e) * 2048 + 128 * ct + 4 * n4) = mx;
    }
}
__device__ __forceinline__ unsigned pack_i8x4(float a, float b, float c, float d) {
    const int qa = (int)__builtin_rintf(a), qb = (int)__builtin_rintf(b), qc = (int)__builtin_rintf(c), qd = (int)__builtin_rintf(d);
    return ((unsigned)qa & 0xffu) | (((unsigned)qb & 0xffu) << 8) | (((unsigned)qc & 0xffu) << 16) | ((unsigned)qd << 24);
}
__device__ __forceinline__ void convert_gu_i8(const float* wgu, const float* PART, unsigned char* WQ, float* SW, LAS unsigned char* wl, int gw, int NGW, int lane) {
    const int kk = lane >> 5, n4 = lane & 31;
    for (int it = gw; it < 4096; it += NGW) {
        const int e = it >> 7, r = it & 127, kt = r >> 4, ct = r & 15; const int k0 = 128 * kt, c0 = 128 * ct;
        f32x4 am = *(const f32x4*)(PART + ((size_t)0 * NE + e) * 2048 + c0 + 4 * n4);
#pragma unroll
        for (int kq = 1; kq < 4; ++kq) { const f32x4 t = *(const f32x4*)(PART + ((size_t)kq * NE + e) * 2048 + c0 + 4 * n4); am[0] = fmaxf(am[0], t[0]); am[1] = fmaxf(am[1], t[1]); am[2] = fmaxf(am[2], t[2]); am[3] = fmaxf(am[3], t[3]); }
        f32x4 inv;
#pragma unroll
        for (int i = 0; i < 4; ++i) inv[i] = am[i] > 0.f ? 127.0f / am[i] : 0.f;
        if (kt == 0 && kk == 0) *(f32x4*)(SW + (size_t)e * 2048 + c0 + 4 * n4) = am * (1.0f / 127.0f);
        const float* W = wgu + (size_t)e * D * 2048;
#pragma unroll 1
        for (int bq = 0; bq < 4; ++bq) {
            f32x4 v[16];
#pragma unroll
            for (int t = 0; t < 16; ++t) v[t] = *(const f32x4*)(W + (size_t)(k0 + 32 * bq + 16 * kk + t) * 2048 + c0 + 4 * n4);
#pragma unroll
            for (int i = 0; i < 4; ++i) { const int c = 4 * n4 + i, sw = n4 & 7, ch = 2 * bq + kk; const float s = inv[i];
                v4u w; w.x = pack_i8x4(v[0][i] * s, v[1][i] * s, v[2][i] * s, v[3][i] * s); w.y = pack_i8x4(v[4][i] * s, v[5][i] * s, v[6][i] * s, v[7][i] * s);
                w.z = pack_i8x4(v[8][i] * s, v[9][i] * s, v[10][i] * s, v[11][i] * s); w.w = pack_i8x4(v[12][i] * s, v[13][i] * s, v[14][i] * s, v[15][i] * s);
                *(LAS v4u*)(wl + c * 128 + ((ch ^ sw) << 4)) = w; }
        }
        LDS_WAIT(); asm volatile("" ::: "memory");
#pragma unroll
        for (int r2 = 0; r2 < 16; ++r2) { const int c = 8 * r2 + (lane >> 3), ch = lane & 7; const v4u o = *(const LAS v4u*)(wl + c * 128 + ((ch ^ ((c >> 2) & 7)) << 4));
            *(GAS v4u*)(WQ + ((size_t)e * 2048 + OrGu()(c0 + c)) * 1024 + k0 + 16 * ch) = o; }
        LDS_WAIT(); asm volatile("" ::: "memory");
    }
}

template <class OR>
__device__ __forceinline__ void convert_strip_i8(const float* W, int ldw, unsigned char* WQ, float* SW, const OR& orow, int c0, LAS float* cmax, LAS unsigned char* wl, int wave, int lane) {
    const int kk = lane >> 5, n4 = lane & 31; const int k0 = 128 * wave;
    f32x4 mx = (f32x4){0.f, 0.f, 0.f, 0.f};
#pragma unroll 1
    for (int bq = 0; bq < 4; ++bq) {
        f32x4 v[16];
#pragma unroll
        for (int t = 0; t < 16; ++t) v[t] = *(const f32x4*)(W + (size_t)(k0 + 32 * bq + 16 * kk + t) * ldw + c0 + 4 * n4);
#pragma unroll
        for (int t = 0; t < 16; ++t) { mx[0] = fmaxf(mx[0], fabsf(v[t][0])); mx[1] = fmaxf(mx[1], fabsf(v[t][1])); mx[2] = fmaxf(mx[2], fabsf(v[t][2])); mx[3] = fmaxf(mx[3], fabsf(v[t][3])); }
    }
#pragma unroll
    for (int i = 0; i < 4; ++i) mx[i] = fmaxf(mx[i], __shfl_xor(mx[i], 32));
    if (kk == 0) *(LAS f32x4*)(cmax + wave * 128 + 4 * n4) = mx;
    LBAR();
    f32x4 am = *(const LAS f32x4*)(cmax + 4 * n4);
#pragma unroll
    for (int w2 = 1; w2 < 8; ++w2) { const f32x4 t = *(const LAS f32x4*)(cmax + w2 * 128 + 4 * n4); am[0] = fmaxf(am[0], t[0]); am[1] = fmaxf(am[1], t[1]); am[2] = fmaxf(am[2], t[2]); am[3] = fmaxf(am[3], t[3]); }
    f32x4 inv;
#pragma unroll
    for (int i = 0; i < 4; ++i) inv[i] = am[i] > 0.f ? 127.0f / am[i] : 0.f;
    if (wave == 0 && kk == 0) *(f32x4*)(SW + c0 + 4 * n4) = am * (1.0f / 127.0f);
#pragma unroll 1
    for (int bq = 0; bq < 4; ++bq) {
        f32x4 v[16];
#pragma unroll
        for (int t = 0; t < 16; ++t) v[t] = __builtin_nontemporal_load((const f32x4*)(W + (size_t)(k0 + 32 * bq + 16 * kk + t) * ldw + c0 + 4 * n4));
#pragma unroll
        for (int i = 0; i < 4; ++i) { const int c = 4 * n4 + i, sw = n4 & 7, ch = 2 * bq + kk; const float sc = inv[i];
            v4u w; w.x = pack_i8x4(v[0][i] * sc, v[1][i] * sc, v[2][i] * sc, v[3][i] * sc); w.y = pack_i8x4(v[4][i] * sc, v[5][i] * sc, v[6][i] * sc, v[7][i] * sc);
            w.z = pack_i8x4(v[8][i] * sc, v[9][i] * sc, v[10][i] * sc, v[11][i] * sc); w.w = pack_i8x4(v[12][i] * sc, v[13][i] * sc, v[14][i] * sc, v[15][i] * sc);
            *(LAS v4u*)(wl + c * 128 + ((ch ^ sw) << 4)) = w; }
    }
    LDS_WAIT(); asm volatile("" ::: "memory");
#pragma unroll
    for (int r2 = 0; r2 < 16; ++r2) { const int c = 8 * r2 + (lane >> 3), ch = lane & 7; const v4u o = *(const LAS v4u*)(wl + c * 128 + ((ch ^ ((c >> 2) & 7)) << 4));
        *(GAS v4u*)(WQ + (size_t)orow(c0 + c) * 1024 + k0 + 16 * ch) = o; }
    LBAR();
}

__device__ __forceinline__ unsigned pk_fp8x4m(float a, float b, float c, float d) { int w = 0; w = __builtin_amdgcn_cvt_pk_fp8_f32(a, b, w, false); w = __builtin_amdgcn_cvt_pk_fp8_f32(c, d, w, true); return (unsigned)w; }
constexpr float F8_WSCALE = 32.0f;
constexpr float AO_SCALE = 8.0f;
__device__ __forceinline__ void convert_down_f8(const float* wdn, unsigned char* WQ, LAS unsigned char* wl, int gw, int NGW, int lane, int nitems = 2048) {
    const int kk = lane >> 5, n4 = lane & 31;
    for (int it = gw; it < nitems; it += NGW) {
        const int e = it >> 6, r = it & 63, kt = r >> 3, ct = r & 7; const int k0 = 128 * kt, c0 = 128 * ct;
        const float* W = wdn + (size_t)e * D * D;
#pragma unroll 1
        for (int bq = 0; bq < 4; ++bq) {
            f32x4 v[16];
#pragma unroll
            for (int t = 0; t < 16; ++t) v[t] = __builtin_nontemporal_load((const f32x4*)(W + (size_t)(k0 + 32 * bq + 16 * kk + t) * D + c0 + 4 * n4));
#pragma unroll
            for (int t = 0; t < 16; ++t) { v[t] = v[t] * F8_WSCALE;
#pragma unroll
                for (int i = 0; i < 4; ++i) v[t][i] = fminf(fmaxf(v[t][i], -448.0f), 448.0f); }
#pragma unroll
            for (int i = 0; i < 4; ++i) { const int c = 4 * n4 + i, sw = n4 & 7, ch = 2 * bq + kk; const float sc = 1.0f;
                v4u w; w.x = pk_fp8x4m(v[0][i] * sc, v[1][i] * sc, v[2][i] * sc, v[3][i] * sc); w.y = pk_fp8x4m(v[4][i] * sc, v[5][i] * sc, v[6][i] * sc, v[7][i] * sc);
                w.z = pk_fp8x4m(v[8][i] * sc, v[9][i] * sc, v[10][i] * sc, v[11][i] * sc); w.w = pk_fp8x4m(v[12][i] * sc, v[13][i] * sc, v[14][i] * sc, v[15][i] * sc);
                *(LAS v4u*)(wl + c * 128 + ((ch ^ sw) << 4)) = w; }
        }
        LDS_WAIT(); asm volatile("" ::: "memory");
#pragma unroll
        for (int r2 = 0; r2 < 16; ++r2) { const int c = 8 * r2 + (lane >> 3), ch = lane & 7; const v4u o = *(const LAS v4u*)(wl + c * 128 + ((ch ^ ((c >> 2) & 7)) << 4));
            *(GAS v4u*)(WQ + ((size_t)e * D + c0 + c) * D + k0 + 16 * ch) = o; }
        LDS_WAIT(); asm volatile("" ::: "memory");
    }
}

struct OrFoxIn { __device__ __forceinline__ int operator()(int c) const { if (c >= 4096) return c; const int pn = c >> 8, lc = c & 255, wc = lc >> 6, bj = (lc >> 5) & 1, j = lc & 31; return 256 * pn + 128 * bj + 32 * wc + j; } };
__device__ __forceinline__ void absmax_mat(const float* W, int ldw, int ncols, int nct, float* PART, int item, int lane) {
    const int kk = lane >> 5, n4 = lane & 31; const int kq = item / nct, ct = item - kq * nct; const int col = 128 * ct + 4 * n4;
    f32x4 mx = (f32x4){0.f, 0.f, 0.f, 0.f};
    if (col < ncols) {
        const float* src = W + (size_t)(256 * kq + kk) * ldw + col;
#pragma unroll 16
        for (int i = 0; i < 128; ++i) { const f32x4 v = *(const f32x4*)(src + (size_t)(2 * i) * ldw);
            mx[0] = fmaxf(mx[0], fabsf(v[0])); mx[1] = fmaxf(mx[1], fabsf(v[1])); mx[2] = fmaxf(mx[2], fabsf(v[2])); mx[3] = fmaxf(mx[3], fabsf(v[3])); }
    }
#pragma unroll
    for (int i = 0; i < 4; ++i) mx[i] = fmaxf(mx[i], __shfl_xor(mx[i], 32));
    if (kk == 0) *(f32x4*)(PART + (size_t)kq * (nct * 128) + col) = mx;
}
template <class OR>
__device__ __forceinline__ void convert_mat_i8(const float* W, int ldw, int ncols, int nct, const float* PART, unsigned char* WQ, float* SW, const OR& orow, LAS unsigned char* wl, int item, int lane) {
    const int kk = lane >> 5, n4 = lane & 31; const int kt = item / nct, ct = item - kt * nct; const int k0 = 128 * kt, c0 = 128 * ct; const bool live = (c0 + 4 * n4) < ncols;
    f32x4 am = *(const f32x4*)(PART + c0 + 4 * n4);
#pragma unroll
    for (int kq = 1; kq < 4; ++kq) { const f32x4 t = *(const f32x4*)(PART + (size_t)kq * (nct * 128) + c0 + 4 * n4); am[0] = fmaxf(am[0], t[0]); am[1] = fmaxf(am[1], t[1]); am[2] = fmaxf(am[2], t[2]); am[3] = fmaxf(am[3], t[3]); }
    f32x4 inv;
#pragma unroll
    for (int i = 0; i < 4; ++i) inv[i] = am[i] > 0.f ? 127.0f / am[i] : 0.f;
    if (kt == 0 && kk == 0 && live) *(f32x4*)(SW + c0 + 4 * n4) = am * (1.0f / 127.0f);
#pragma unroll 1
    for (int bq = 0; bq < 4; ++bq) {
        f32x4 v[16];
#pragma unroll
        for (int t = 0; t < 16; ++t) v[t] = live ? __builtin_nontemporal_load((const f32x4*)(W + (size_t)(k0 + 32 * bq + 16 * kk + t) * ldw + c0 + 4 * n4)) : (f32x4){0.f, 0.f, 0.f, 0.f};
#pragma unroll
        for (int i = 0; i < 4; ++i) { const int c = 4 * n4 + i, sw = n4 & 7, ch = 2 * bq + kk; const float sc = inv[i];
            v4u w; w.x = pack_i8x4(v[0][i] * sc, v[1][i] * sc, v[2][i] * sc, v[3][i] * sc); w.y = pack_i8x4(v[4][i] * sc, v[5][i] * sc, v[6][i] * sc, v[7][i] * sc);
            w.z = pack_i8x4(v[8][i] * sc, v[9][i] * sc, v[10][i] * sc, v[11][i] * sc); w.w = pack_i8x4(v[12][i] * sc, v[13][i] * sc, v[14][i] * sc, v[15][i] * sc);
            *(LAS v4u*)(wl + c * 128 + ((ch ^ sw) << 4)) = w; }
    }
    LDS_WAIT(); asm volatile("" ::: "memory");
#pragma unroll
    for (int r2 = 0; r2 < 16; ++r2) { const int c = 8 * r2 + (lane >> 3), ch = lane & 7; const v4u o = *(const LAS v4u*)(wl + c * 128 + ((ch ^ ((c >> 2) & 7)) << 4));
        if (c0 + c < ncols) *(GAS v4u*)(WQ + (size_t)orow(c0 + c) * 1024 + k0 + 16 * ch) = o; }
    LDS_WAIT(); asm volatile("" ::: "memory");
}

__device__ __forceinline__ void phase_mod(const float* c, const float* ada_w, const float* ada_b, float* MOD, float* ldsf, int tid, int bid, int G) {
    for (int idx = tid; idx < NB * D; idx += NWAVES * 64) { const int b = idx >> 10, k = idx & 1023; const float x = c[idx]; ldsf[k * 32 + b] = x * sigm_f(x); }
    __syncthreads();
    const int bq = tid >> 7, n = tid & 127;
    for (int grp = bid; grp < DEPTH * 48; grp += G) {
        const int L = grp / 48, n0 = (grp - L * 48) * 128;
        const float* wp = ada_w + (size_t)L * D * (NMOD * D) + n0 + n;
        float acc[8];
#pragma unroll
        for (int i = 0; i < 8; ++i) acc[i] = 0.f;
#pragma unroll 32
        for (int k = 0; k < D; ++k) { const float w = __builtin_nontemporal_load(wp + (size_t)k * (NMOD * D));   const f32x4 c0 = *(const f32x4*)(ldsf + k * 32 + 8 * bq), c1 = *(const f32x4*)(ldsf + k * 32 + 8 * bq + 4);
            acc[0] += w * c0[0]; acc[1] += w * c0[1]; acc[2] += w * c0[2]; acc[3] += w * c0[3]; acc[4] += w * c1[0]; acc[5] += w * c1[1]; acc[6] += w * c1[2]; acc[7] += w * c1[3]; }
        const float bb = ada_b[(size_t)L * (NMOD * D) + n0 + n];
#pragma unroll
        for (int i = 0; i < 8; ++i) MOD[((size_t)L * NB + 8 * bq + i) * (NMOD * D) + n0 + n] = acc[i] + bb;
    }
    __syncthreads();
}

typedef unsigned u32x2v_ __attribute__((ext_vector_type(2)));
__device__ __forceinline__ f32x4 bfx4(const u32x2v_ w) { return (f32x4){__builtin_bit_cast(float, w.x << 16), __builtin_bit_cast(float, w.x & 0xffff0000u), __builtin_bit_cast(float, w.y << 16), __builtin_bit_cast(float, w.y & 0xffff0000u)}; }
template <int XIN, int XOUT>
__device__ __forceinline__ void phase_norm1(const void* xin_, void* xout_, unsigned char* HQ, float* SA, const float* nw, const float* modL  , bool do_norm,
                                            bool combine, const unsigned char* Y, const int* POS, const float* TOPW, const float* modP  , int gw, int NGW, int lane) {
    const float* xin = (const float*)xin_; const bf16* xinh = (const bf16*)xin_; float* xout = (float*)xout_; bf16* xouth = (bf16*)xout_;
#define N1_LOADX(dst, row) do { _Pragma("unroll") for (int j = 0; j < 4; ++j) { if constexpr (XIN == 0) dst[j] = *(const f32x4*)(xin + (size_t)(row) * D + 4 * lane + 256 * j); \
        else dst[j] = bfx4(*(const u32x2v_*)(xinh + (size_t)(row) * D + 4 * lane + 256 * j)); } } while (0)
    for (int r0 = gw * 32; r0 < T; r0 += NGW * 32) {
        const int b = r0 >> 11;
        f32x4 A[4], Bv[4], G2[4];
#pragma unroll
        for (int j = 0; j < 4; ++j) { const int col = 4 * lane + 256 * j;
            if (do_norm) { const f32x4 w = *(const f32x4*)(nw + col), sc = *(const f32x4*)(modL + (size_t)b * 6144 + 1024 + col); A[j] = w * (sc + 1.0f); Bv[j] = *(const f32x4*)(modL + (size_t)b * 6144 + col); }
            else { A[j] = (f32x4){0.f, 0.f, 0.f, 0.f}; Bv[j] = A[j]; }
            G2[j] = combine ? *(const f32x4*)(modP + (size_t)b * 6144 + 5120 + col) : (f32x4){0.f, 0.f, 0.f, 0.f}; }
        int pz0 = 0, pz1 = 0; float wz0 = 0.f, wz1 = 0.f;
        if (combine) { pz0 = POS[r0 * 4 + lane]; pz1 = POS[r0 * 4 + 64 + lane]; wz0 = TOPW[r0 * 4 + lane]; wz1 = TOPW[r0 * 4 + 64 + lane]; }
        f32x4 vn[4]; unsigned yn[TOPK][4];
#pragma unroll
        for (int j = 0; j < 4; ++j) vn[j] = (f32x4){0.f, 0.f, 0.f, 0.f};
        N1_LOADX(vn, r0);
        if (combine) {
#pragma unroll
            for (int k = 0; k < TOPK; ++k) { const int pos = __builtin_amdgcn_readlane(pz0, k);
#pragma unroll
                for (int j = 0; j < 4; ++j) yn[k][j] = *(const unsigned*)(Y + (size_t)pos * D + 4 * lane + 256 * j); }
        }
        for (int r = r0; r < r0 + 32; ++r) {
            f32x4 v[4]; unsigned yc[TOPK][4]; float wk[TOPK];
#pragma unroll
            for (int j = 0; j < 4; ++j) v[j] = vn[j];
            if (combine) {
#pragma unroll
                for (int k = 0; k < TOPK; ++k) { const int q = (r - r0) * 4 + k; wk[k] = (q < 64) ? __builtin_bit_cast(float, __builtin_amdgcn_readlane(__builtin_bit_cast(int, wz0), q)) : __builtin_bit_cast(float, __builtin_amdgcn_readlane(__builtin_bit_cast(int, wz1), q - 64));
#pragma unroll
                    for (int j = 0; j < 4; ++j) yc[k][j] = yn[k][j]; }
            }
            if (r + 1 < r0 + 32) {
                N1_LOADX(vn, r + 1);
                if (combine) {
#pragma unroll
                    for (int k = 0; k < TOPK; ++k) { const int q = (r + 1 - r0) * 4 + k; const int pos = (q < 64) ? __builtin_amdgcn_readlane(pz0, q) : __builtin_amdgcn_readlane(pz1, q - 64);
#pragma unroll
                        for (int j = 0; j < 4; ++j) yn[k][j] = *(const unsigned*)(Y + (size_t)pos * D + 4 * lane + 256 * j); }
                }
            }
            if (combine) {
                f32x4 acc[4];
#pragma unroll
                for (int j = 0; j < 4; ++j) acc[j] = (f32x4){0.f, 0.f, 0.f, 0.f};
#pragma unroll
                for (int k = 0; k < TOPK; ++k) { const float w = wk[k];
#pragma unroll
                    for (int j = 0; j < 4; ++j) { const int y = (int)yc[k][j]; const f32x2_t_ lo = __builtin_amdgcn_cvt_pk_f32_fp8(y, false), hi = __builtin_amdgcn_cvt_pk_f32_fp8(y, true);
                        acc[j][0] += w * lo[0]; acc[j][1] += w * lo[1]; acc[j][2] += w * hi[0]; acc[j][3] += w * hi[1]; } }
#pragma unroll
                for (int j = 0; j < 4; ++j) v[j] = v[j] + G2[j] * acc[j];
            }
            if constexpr (XOUT == 1) {
#pragma unroll
                for (int j = 0; j < 4; ++j) *(f32x4*)(xout + (size_t)r * D + 4 * lane + 256 * j) = v[j];
            } else if constexpr (XOUT == 2) {
#pragma unroll
                for (int j = 0; j < 4; ++j) *(u32x2v_*)(xouth + (size_t)r * D + 4 * lane + 256 * j) = (u32x2v_){pk2(v[j][0], v[j][1]), pk2(v[j][2], v[j][3])};
            }
            if (do_norm) {
                float ss = 0.f;
#pragma unroll
                for (int j = 0; j < 4; ++j) ss += (v[j][0] * v[j][0] + v[j][1] * v[j][1]) + (v[j][2] * v[j][2] + v[j][3] * v[j][3]);
                const float rs = __builtin_amdgcn_rsqf(wave_sum(ss) * (1.0f / D) + EPS);
#pragma unroll
                for (int j = 0; j < 4; ++j) v[j] = v[j] * rs * A[j] + Bv[j];
                float am = 0.f;
#pragma unroll
                for (int j = 0; j < 4; ++j) am = fmaxf(fmaxf(am, fmaxf(fabsf(v[j][0]), fabsf(v[j][1]))), fmaxf(fabsf(v[j][2]), fabsf(v[j][3])));
                am = wave_max(am); const float inv = am > 0.f ? 127.0f / am : 0.f;
#pragma unroll
                for (int j = 0; j < 4; ++j) *(unsigned*)(HQ + (size_t)r * D + 4 * lane + 256 * j) = pack_i8x4(v[j][0] * inv, v[j][1] * inv, v[j][2] * inv, v[j][3] * inv);
                if (lane == 0) SA[r] = am * (1.0f / 127.0f);
            }
        }
    }
}

#undef N1_LOADX

__device__ __forceinline__ void phase_cumsum(const float* FL, float* BIAS, LAS float* scr, int bid, int G, int wave, int lane) {
    for (int pair = bid; pair < NB * 8; pair += G) {
        const int seq = 2 * pair + (wave >> 2), q = wave & 3; const int b = seq >> 4, h = seq & 15;
        const float* src = FL + ((size_t)b * SEQ + 512 * q + 8 * lane) * 16 + h;
        float v[8]; float run = 0.f;
#pragma unroll
        for (int i = 0; i < 8; ++i) { run += src[(size_t)i * 16]; v[i] = run; }
        float inc = run;
#pragma unroll
        for (int d = 1; d < 64; d <<= 1) { const float t = __shfl_up(inc, d); if (lane >= d) inc += t; }
        const float excl = inc - run;
        if (lane == 63) scr[wave] = inc;
        __syncthreads();
        float base = excl;
#pragma unroll
        for (int qq = 0; qq < 3; ++qq) base += (qq < q) ? scr[(wave & 4) + qq] : 0.f;
        float* dst = BIAS + (size_t)seq * SEQ + 512 * q + 8 * lane;
        *(f32x4*)(dst) = (f32x4){-(v[0] + base), -(v[1] + base), -(v[2] + base), -(v[3] + base)}; *(f32x4*)(dst + 4) = (f32x4){-(v[4] + base), -(v[5] + base), -(v[6] + base), -(v[7] + base)};
        __syncthreads();
    }
}

__device__ __forceinline__ void phase_norm2_route(const bf16* X, unsigned char* HQ, float* SA, const float* nw, const float* modL, const float* rw, const float* rb,
                                                  int* TOPI, float* TOPW, int* HIST, unsigned char* lds, int tid, int lane, int wave, int bid, int G) {
    LAS unsigned char* Ll = (LAS unsigned char*)lds;
    LAS float* wl = (LAS float*)(Ll + LSCR_OFF) + wave * (16 * 33);
    LAS int* hist = (LAS int*)(Ll + LSCR_OFF + 8 * 16 * 33 * 4);
    LAS f32x4* ABl = (LAS f32x4*)(Ll + LSCR_OFF + 8 * 16 * 33 * 4 + 256);
    LAS float* cst = (LAS float*)(Ll + LSCR_OFF + 8 * 16 * 33 * 4 + 256 + 8192);
    static_assert(LSCR_OFF + 8 * 16 * 33 * 4 + 256 + 8192 + 128 <= LDSCTL_OFF, "phase F LDS map");
    for (int chunk = bid; chunk < NCHUNK; chunk += G) {
        if (tid < NE) hist[tid] = 0;
        const int b = chunk >> 3;
        if (tid < 256) { const int col = 4 * tid; const f32x4 w = *(const f32x4*)(nw + col), sc = *(const f32x4*)(modL + (size_t)b * 6144 + 4096 + col); ABl[tid] = w * (sc + 1.0f); ABl[256 + tid] = *(const f32x4*)(modL + (size_t)b * 6144 + 3072 + col); }
        __syncthreads();
        { const LAS float* Af = (const LAS float*)ABl; const LAS float* Bf = Af + 1024;
#pragma unroll 2
          for (int item = tid; item < 4096; item += NWAVES * 64) { const int s = item >> 7, mt = (item >> 6) & 1, ln = item & 63; const int e = 16 * mt + (ln & 15), c0 = 32 * s + 8 * (ln >> 4);
              v4u hi, lo;
#pragma unroll
              for (int i2 = 0; i2 < 4; ++i2) { const float w0 = Af[c0 + 2 * i2] * rw[(c0 + 2 * i2) * NE + e], w1 = Af[c0 + 2 * i2 + 1] * rw[(c0 + 2 * i2 + 1) * NE + e];
                  const unsigned h = pk2(w0, w1); hi[i2] = h; lo[i2] = pk2(w0 - __uint_as_float(h << 16), w1 - __uint_as_float(h & 0xffff0000u)); }
              *(LAS v4u*)(Ll + RING_OFF + ((s * 2 + mt) * 2 + 0) * 1024 + ln * 16) = hi; *(LAS v4u*)(Ll + RING_OFF + ((s * 2 + mt) * 2 + 1) * 1024 + ln * 16) = lo; }
          { float p = 0.f;
#pragma unroll 8
            for (int i = 0; i < 64; ++i) { const int c = 128 * wave + 2 * i + (lane >> 5); p += Bf[c] * rw[c * NE + (lane & 31)]; }
            p += __shfl_xor(p, 32);
            if (lane < 32) ((LAS float*)(Ll + LSCR_OFF))[wave * 32 + lane] = p; }
        }
        __syncthreads();
        if (tid < NE) { float p = rb[tid];
#pragma unroll
            for (int w2 = 0; w2 < 8; ++w2) p += ((LAS float*)(Ll + LSCR_OFF))[w2 * 32 + tid];
            cst[tid] = p; }
        __syncthreads();
        const int rbase = chunk * 256 + wave * 32;
        u32x2v_ vr[2][4];
#pragma unroll
        for (int rr = 0; rr < 2; ++rr)
#pragma unroll
            for (int j = 0; j < 4; ++j) vr[rr][j] = *(const u32x2v_*)(X + (size_t)(rbase + rr) * D + 4 * lane + 256 * j);
        float rsv = 0.f;
#pragma unroll 1
        for (int it = 0; it < 16; ++it) {
            const int r0 = rbase + it * 2;
            f32x4 vn[2][4];
#pragma unroll
            for (int rr = 0; rr < 2; ++rr)
#pragma unroll
                for (int j = 0; j < 4; ++j) vn[rr][j] = bfx4(vr[rr][j]);
            if (it < 15) {
#pragma unroll
                for (int rr = 0; rr < 2; ++rr)
#pragma unroll
                    for (int j = 0; j < 4; ++j) vr[rr][j] = *(const u32x2v_*)(X + (size_t)(r0 + 2 + rr) * D + 4 * lane + 256 * j);
            }
#pragma unroll
            for (int rr = 0; rr < 2; ++rr) {
                float ss = 0.f;
#pragma unroll
                for (int j = 0; j < 4; ++j) ss += (vn[rr][j][0] * vn[rr][j][0] + vn[rr][j][1] * vn[rr][j][1]) + (vn[rr][j][2] * vn[rr][j][2] + vn[rr][j][3] * vn[rr][j][3]);
                const float rs = __builtin_amdgcn_rsqf(wave_sum(ss) * (1.0f / D) + EPS);
                if (lane == (it & 7) * 2 + rr) rsv = rs;
                float am = 0.f; f32x4 h[4];
#pragma unroll
                for (int j = 0; j < 4; ++j) { h[j] = vn[rr][j] * rs * ABl[lane + 64 * j] + ABl[256 + lane + 64 * j]; am = fmaxf(fmaxf(am, fmaxf(fabsf(h[j][0]), fabsf(h[j][1]))), fmaxf(fabsf(h[j][2]), fabsf(h[j][3]))); }
                am = wave_max(am); const float inv = am > 0.f ? 127.0f / am : 0.f;
#pragma unroll
                for (int j = 0; j < 4; ++j) *(unsigned*)(HQ + (size_t)(r0 + rr) * D + 4 * lane + 256 * j) = pack_i8x4(h[j][0] * inv, h[j][1] * inv, h[j][2] * inv, h[j][3] * inv);
                if (lane == 0) SA[r0 + rr] = am * (1.0f / 127.0f);
            }
            if ((it & 7) == 7) {
                const int R0 = r0 - 14;
                const bf16* xr = X + (size_t)(R0 + (lane & 15)) * D + 8 * (lane >> 4);
                f32x4 acc[2][2];
#pragma unroll
                for (int mt = 0; mt < 2; ++mt)
#pragma unroll
                    for (int p = 0; p < 2; ++p) acc[mt][p] = (f32x4){0.f, 0.f, 0.f, 0.f};
#pragma unroll 8
                for (int s = 0; s < 32; ++s) { const bf16x8 xf = *(const bf16x8*)(xr + 32 * s);
#pragma unroll
                    for (int mt = 0; mt < 2; ++mt)
#pragma unroll
                        for (int p = 0; p < 2; ++p) { const bf16x8 wf = *(const LAS bf16x8*)(Ll + RING_OFF + ((s * 2 + mt) * 2 + p) * 1024 + lane * 16); acc[mt][p] = __builtin_amdgcn_mfma_f32_16x16x32_bf16(wf, xf, acc[mt][p], 0, 0, 0); } }
                const float rst = __shfl(rsv, lane & 15);
                const f32x4 c0v = *(const LAS f32x4*)(cst + 4 * (lane >> 4)), c1v = *(const LAS f32x4*)(cst + 16 + 4 * (lane >> 4));
                const f32x4 l0 = (acc[0][0] + acc[0][1]) * rst + c0v, l1 = (acc[1][0] + acc[1][1]) * rst + c1v;
#pragma unroll
                for (int r = 0; r < 4; ++r) { wl[(lane & 15) * 33 + 4 * (lane >> 4) + r] = l0[r]; wl[(lane & 15) * 33 + 16 + 4 * (lane >> 4) + r] = l1[r]; }
                asm volatile("s_waitcnt lgkmcnt(0)" ::: "memory");
                if (lane < 16) {
                    float l[32];
#pragma unroll
                    for (int e = 0; e < 32; ++e) l[e] = wl[lane * 33 + e];
                    int sel[4]; float val[4];
#pragma unroll
                    for (int k = 0; k < 4; ++k) { float best = l[0]; int bi = 0;
#pragma unroll
                        for (int e = 1; e < 32; ++e) { if (l[e] > best) { best = l[e]; bi = e; } }
                        sel[k] = bi; val[k] = best;
#pragma unroll
                        for (int e = 0; e < 32; ++e) l[e] = (e == bi) ? -INFINITY : l[e]; }
                    const float e1 = __expf(val[1] - val[0]), e2 = __expf(val[2] - val[0]), e3 = __expf(val[3] - val[0]); const float inv = 1.0f / (1.0f + e1 + e2 + e3);
                    const int r = R0 + lane;
                    *(int4*)(TOPI + (size_t)r * 4) = make_int4(sel[0], sel[1], sel[2], sel[3]); *(float4*)(TOPW + (size_t)r * 4) = make_float4(inv, e1 * inv, e2 * inv, e3 * inv);
                    atomicAdd((int*)&hist[sel[0]], 1); atomicAdd((int*)&hist[sel[1]], 1); atomicAdd((int*)&hist[sel[2]], 1); atomicAdd((int*)&hist[sel[3]], 1);
                }
                asm volatile("s_waitcnt lgkmcnt(0)" ::: "memory");
            }
        }
        __syncthreads();
        if (tid < NE) HIST[chunk * NE + tid] = hist[tid];
        __syncthreads();
    }
}

__device__ __forceinline__ void phase_scatter(const int* TOPI, int* POS, int* ROWTOK, float* SAROW, const float* SA, const int* HIST, int* ROUTE, unsigned char* lds, int tid, int lane, int wave, int bid, int G) {
    int* part = (int*)(lds + RING_OFF);
    int* tot_s = part + 1024; int* bef_s = tot_s + 32; int* pst_s = bef_s + 32; int* base_s = pst_s + 32; int* wcnt = base_s + 32;
    for (int chunk = bid; chunk < NCHUNK; chunk += G) {
        { const int e = tid & 31, p = tid >> 5; int t = 0, bf = 0;
          for (int c2 = p * 16; c2 < p * 16 + 16; ++c2) { const int hv = HIST[c2 * NE + e]; t += hv; bf += (c2 < chunk) ? hv : 0; }
          part[p * 32 + e] = t; part[512 + p * 32 + e] = bf; }
        const int a0 = wave * 128 + lane, a1 = a0 + 64;
        const int e0 = TOPI[(size_t)chunk * 1024 + a0], e1 = TOPI[(size_t)chunk * 1024 + a1];
        int r0 = 0, r1 = 0, cnt_me = 0;
        const unsigned long long lt = (1ull << lane) - 1ull;
#pragma unroll 4
        for (int e = 0; e < NE; ++e) { const unsigned long long m0 = __ballot(e0 == e), m1 = __ballot(e1 == e); const int c0 = __popcll(m0), c1 = __popcll(m1);
            if (e0 == e) r0 = __popcll(m0 & lt); if (e1 == e) r1 = c0 + __popcll(m1 & lt); if (lane == e) cnt_me = c0 + c1; }
        if (lane < NE) wcnt[wave * 32 + lane] = cnt_me;
        __syncthreads();
        if (tid < NE) { int t = 0, bf = 0; for (int p = 0; p < 16; ++p) { t += part[p * 32 + tid]; bf += part[512 + p * 32 + tid]; } tot_s[tid] = t; bef_s[tid] = bf; }
        __syncthreads();
        if (tid == 0) { int run = 0; for (int e = 0; e < NE; ++e) { const int padded = (tot_s[e] + 255) & ~255; pst_s[e] = run; base_s[e] = run + bef_s[e]; run += padded; }
            if (chunk == 0) ROUTE[RT_NTILES] = run >> 8; }
        __syncthreads();
        if (chunk == 0) {
            if (tid < NE) { const int t0 = pst_s[tid] >> 8, t1 = (pst_s[tid] + ((tot_s[tid] + 255) & ~255)) >> 8; for (int t = t0; t < t1; ++t) ROUTE[RT_TEXP + t] = tid; }
            if (tid < 256) for (int e = 0; e < NE; ++e) { const int p = pst_s[e] + tot_s[e] + tid; if (p < pst_s[e] + ((tot_s[e] + 255) & ~255)) { ROWTOK[p] = 0; SAROW[p] = 0.f; } }
        }
        int wp0 = 0, wp1 = 0;
        for (int w2 = 0; w2 < wave; ++w2) { wp0 += wcnt[w2 * 32 + e0]; wp1 += wcnt[w2 * 32 + e1]; }
        const int p0 = base_s[e0] + wp0 + r0, p1 = base_s[e1] + wp1 + r1;
        POS[(size_t)chunk * 1024 + a0] = p0; POS[(size_t)chunk * 1024 + a1] = p1;
        { const int tk0 = chunk * 256 + (a0 >> 2), tk1 = chunk * 256 + (a1 >> 2); ROWTOK[p0] = tk0; ROWTOK[p1] = tk1; SAROW[p0] = SA[tk0]; SAROW[p1] = SA[tk1]; }
        __syncthreads();
    }
}

namespace hg {
typedef short s16x4 __attribute__((ext_vector_type(4)));
typedef float f32x16 __attribute__((ext_vector_type(16)));
constexpr int QS = 136, OSS = 129, TP = 144;
constexpr int QT_B = 32 * QS * 2, TR_B = 128 * TP, OS_B = 32 * OSS * 4;
constexpr int L_QT = 0, L_KT = L_QT + 2 * QT_B, L_KH = L_KT + QT_B, L_VT = L_KH + 2 * TR_B, L_DEC = L_VT + 2 * TR_B, L_OSI = L_DEC + 2 * 512, L_OSS = L_OSI + 2 * OS_B, L_END = L_OSS + OS_B;
static_assert(L_END <= LDSCTL_OFF, "hgrn LDS map");
__device__ __forceinline__ int crow(int r, int hi) { return (r & 3) + 8 * (r >> 2) + 4 * hi; }
__device__ __forceinline__ int tchunk(int d, int sc) { return d * TP + ((sc ^ ((d >> 3) & 7)) << 4); }
struct Raw2 { v4u q[2], k[2], v[2]; f32x4 l[2][2]; };
__device__ __forceinline__ void load_raw2(Raw2& R, const bf16* Pq, const float* LF, const bf16* Pk, const bf16* Pv, size_t off) {
#pragma unroll
    for (int a = 0; a < 2; ++a) { const size_t o = off + (size_t)a * D; R.q[a] = *(const v4u*)(Pq + o); R.k[a] = *(const v4u*)(Pk + o); R.v[a] = *(const v4u*)(Pv + o); R.l[a][0] = *(const f32x4*)(LF + o); R.l[a][1] = *(const f32x4*)(LF + o + 4); } }
__device__ __forceinline__ float bflo(unsigned w) { return __uint_as_float(w << 16); }
__device__ __forceinline__ float bfhi(unsigned w) { return __uint_as_float(w & 0xffff0000u); }
}
__device__ __forceinline__ void phase_hgrn(const bf16* Pq, const float* LF, const bf16* Pk, const bf16* Pv, const bf16* Pg, bf16* AO, const float* gnorm,
                                           LAS unsigned char* lds, int tid, int lane, int wave, int bid, int G) {
    using namespace hg;
    const bool isS = wave >= 4; const int gw4 = wave & 3;
    constexpr int NCH = SEQ / 32;
    for (int bh = bid; bh < NB * 8; bh += G) {
        const int b = bh >> 3, h = bh & 7;
        const size_t hbase = (size_t)b * SEQ * D + h * 128;
        const size_t pbase = hbase + (size_t)(2 * (lane >> 2)) * D + 32 * gw4 + 8 * (lane & 3);
        const int gtid = gw4 * 64 + lane; const size_t ebase = hbase + (size_t)(gtid >> 3) * D + 16 * (gtid & 7);
#define HG_P(i, R) do { \
            int lane_ = lane; asm volatile("" : "+v"(lane_));     \
            const int r_ = lane_ & 31, hh_ = lane_ >> 5; const int bi = (i) & 1, bp = ((i) + 1) & 1;     \
            LBAR(); \
            if ((i) < NCH) { \
                  \
                const int tg_ = lane_ >> 2, c_ = lane_ & 3; const int d0 = 32 * gw4 + 8 * c_; \
                float ya[8], tot[8], pr[8]; \
                _Pragma("unroll") for (int e = 0; e < 8; ++e) { ya[e] = R.l[0][e >> 2][e & 3]; pr[e] = ya[e] + R.l[1][e >> 2][e & 3]; tot[e] = pr[e]; } \
                _Pragma("unroll") for (int sh = 4; sh < 64; sh <<= 1) { _Pragma("unroll") for (int e = 0; e < 8; ++e) { const float u = __shfl_up(tot[e], sh); if (lane_ >= sh) tot[e] += u; } } \
                float bend[8]; _Pragma("unroll") for (int e = 0; e < 8; ++e) bend[e] = __shfl(tot[e], 60 + c_); \
                unsigned qo[2][4], ko[2][4]; \
                const int tb_ = tchunk(d0, tg_ >> 2) + (tg_ & 3) * 4;     \
                _Pragma("unroll") for (int p = 0; p < 4; ++p) { \
                    const float ba0 = tot[2 * p] - pr[2 * p] + ya[2 * p], ba1 = tot[2 * p + 1] - pr[2 * p + 1] + ya[2 * p + 1], bb0 = tot[2 * p], bb1 = tot[2 * p + 1];     \
                    const unsigned qa = R.q[0][p], qb = R.q[1][p], ka = R.k[0][p], kb = R.k[1][p], va = R.v[0][p], vb = R.v[1][p]; \
                    const float ka0 = bflo(ka), ka1 = bfhi(ka), kb0 = bflo(kb), kb1 = bfhi(kb); \
                    qo[0][p] = pk2(bflo(qa) * __builtin_amdgcn_exp2f(ba0), bfhi(qa) * __builtin_amdgcn_exp2f(ba1)); qo[1][p] = pk2(bflo(qb) * __builtin_amdgcn_exp2f(bb0), bfhi(qb) * __builtin_amdgcn_exp2f(bb1)); \
                    ko[0][p] = pk2(ka0 * __builtin_amdgcn_exp2f(fminf(-ba0, 115.0f)), ka1 * __builtin_amdgcn_exp2f(fminf(-ba1, 115.0f))); ko[1][p] = pk2(kb0 * __builtin_amdgcn_exp2f(fminf(-bb0, 115.0f)), kb1 * __builtin_amdgcn_exp2f(fminf(-bb1, 115.0f))); \
                      \
                    const unsigned kh0 = pk2(ka0 * __builtin_amdgcn_exp2f(bend[2 * p] - ba0), kb0 * __builtin_amdgcn_exp2f(bend[2 * p] - bb0)), kh1 = pk2(ka1 * __builtin_amdgcn_exp2f(bend[2 * p + 1] - ba1), kb1 * __builtin_amdgcn_exp2f(bend[2 * p + 1] - bb1)); \
                    const unsigned vt0 = (va & 0xffffu) | (vb << 16), vt1 = (va >> 16) | (vb & 0xffff0000u); \
                    *(LAS unsigned*)(lds + L_KH + bi * TR_B + tb_ + 2 * TP * p) = kh0; *(LAS unsigned*)(lds + L_KH + bi * TR_B + tb_ + 2 * TP * p + TP) = kh1; \
                    *(LAS unsigned*)(lds + L_VT + bi * TR_B + tb_ + 2 * TP * p) = vt0; *(LAS unsigned*)(lds + L_VT + bi * TR_B + tb_ + 2 * TP * p + TP) = vt1; } \
                _Pragma("unroll") for (int a = 0; a < 2; ++a) { *(LAS v4u*)(lds + L_QT + bi * QT_B + ((2 * tg_ + a) * QS + d0) * 2) = (v4u){qo[a][0], qo[a][1], qo[a][2], qo[a][3]}; *(LAS v4u*)(lds + L_KT + ((2 * tg_ + a) * QS + d0) * 2) = (v4u){ko[a][0], ko[a][1], ko[a][2], ko[a][3]}; } \
                if (tg_ == 0) { *(LAS f32x4*)(lds + L_DEC + bi * 512 + d0 * 4) = (f32x4){__builtin_amdgcn_exp2f(bend[0]), __builtin_amdgcn_exp2f(bend[1]), __builtin_amdgcn_exp2f(bend[2]), __builtin_amdgcn_exp2f(bend[3])}; *(LAS f32x4*)(lds + L_DEC + bi * 512 + (d0 + 4) * 4) = (f32x4){__builtin_amdgcn_exp2f(bend[4]), __builtin_amdgcn_exp2f(bend[5]), __builtin_amdgcn_exp2f(bend[6]), __builtin_amdgcn_exp2f(bend[7])}; } \
                load_raw2(R, Pq, LF, Pk, Pv, pbase + (size_t)(((i) + 2 < NCH) ? (i) + 2 : NCH - 1) * 32 * D);     \
            } \
            LBAR(); \
            if ((i) < NCH) { \
                  \
                const int dvt = gw4; \
                f32x16 pt; _Pragma("unroll") for (int e = 0; e < 16; ++e) pt[e] = 0.f; \
                _Pragma("unroll") for (int ks = 0; ks < 8; ++ks) { const bf16x8 a = *(const LAS bf16x8*)(lds + L_KT + (r_ * QS + 16 * ks + 8 * hh_) * 2), bq = *(const LAS bf16x8*)(lds + L_QT + bi * QT_B + (r_ * QS + 16 * ks + 8 * hh_) * 2); pt = __builtin_amdgcn_mfma_f32_32x32x16_bf16(a, bq, pt, 0, 0, 0); } \
                f32x16 oi; _Pragma("unroll") for (int e = 0; e < 16; ++e) oi[e] = 0.f; \
                _Pragma("unroll") for (int ks2 = 0; ks2 < 2; ++ks2) { unsigned w[4]; \
                    _Pragma("unroll") for (int jp = 0; jp < 4; ++jp) { const int r0 = 8 * ks2 + 2 * jp, r1 = r0 + 1; const float x0 = (crow(r0, hh_) <= r_) ? pt[r0] : 0.f, x1 = (crow(r1, hh_) <= r_) ? pt[r1] : 0.f; w[jp] = pk2(x0, x1); } \
                    const bf16x8 pa = __builtin_bit_cast(bf16x8, (v4u){w[0], w[1], w[2], w[3]}); const int dv = 32 * dvt + r_; \
                    const s16x4 lo = *(const LAS s16x4*)(lds + L_VT + bi * TR_B + tchunk(dv, 2 * ks2) + 8 * hh_), hi4 = *(const LAS s16x4*)(lds + L_VT + bi * TR_B + tchunk(dv, 2 * ks2 + 1) + 8 * hh_); \
                    const bf16x8 vb = (bf16x8){lo[0], lo[1], lo[2], lo[3], hi4[0], hi4[1], hi4[2], hi4[3]}; oi = __builtin_amdgcn_mfma_f32_32x32x16_bf16(pa, vb, oi, 0, 0, 0); } \
                _Pragma("unroll") for (int e = 0; e < 16; ++e) ((LAS float*)(lds + L_OSI + bi * OS_B))[crow(e, hh_) * OSS + 32 * dvt + r_] = oi[e]; \
            } \
        } while (0)
#define HG_S(i, G0, G1) do { \
            int lane_ = lane; asm volatile("" : "+v"(lane_));     \
            const int r_ = lane_ & 31, hh_ = lane_ >> 5; const int bi = (i) & 1, bp = ((i) + 1) & 1;     \
            LBAR(); \
            if ((i) >= 1) { \
                  \
                const int dvt = gw4; \
                f32x16 ot; _Pragma("unroll") for (int e = 0; e < 16; ++e) ot[e] = 0.f; \
                _Pragma("unroll") for (int dkt = 0; dkt < 4; ++dkt) { \
                    _Pragma("unroll") for (int s2 = 0; s2 < 2; ++s2) { unsigned w[4]; \
                        _Pragma("unroll") for (int jp = 0; jp < 4; ++jp) w[jp] = pk2(st[dkt][8 * s2 + 2 * jp], st[dkt][8 * s2 + 2 * jp + 1]); \
                        const bf16x8 xb = __builtin_bit_cast(bf16x8, (v4u){w[0], w[1], w[2], w[3]}); \
                        const s16x4 lo = *(const LAS s16x4*)(lds + L_QT + bp * QT_B + (r_ * QS + 32 * dkt + 16 * s2 + 4 * hh_) * 2), hi4 = *(const LAS s16x4*)(lds + L_QT + bp * QT_B + (r_ * QS + 32 * dkt + 16 * s2 + 8 + 4 * hh_) * 2); \
                        const bf16x8 a = (bf16x8){lo[0], lo[1], lo[2], lo[3], hi4[0], hi4[1], hi4[2], hi4[3]}; ot = __builtin_amdgcn_mfma_f32_32x32x16_bf16(a, xb, ot, 0, 0, 0); } } \
                _Pragma("unroll") for (int e = 0; e < 16; ++e) ((LAS float*)(lds + L_OSS))[crow(e, hh_) * OSS + 32 * dvt + r_] = ot[e]; \
                bf16x8 vb2[2]; _Pragma("unroll") for (int ks2 = 0; ks2 < 2; ++ks2) vb2[ks2] = *(const LAS bf16x8*)(lds + L_VT + bp * TR_B + tchunk(32 * dvt + r_, 2 * ks2 + hh_)); \
                _Pragma("unroll") for (int dkt = 0; dkt < 4; ++dkt) { \
                    _Pragma("unroll") for (int g4 = 0; g4 < 4; ++g4) { const f32x4 dc = *(const LAS f32x4*)(lds + L_DEC + bp * 512 + (32 * dkt + 8 * g4 + 4 * hh_) * 4); \
                        _Pragma("unroll") for (int e = 0; e < 4; ++e) st[dkt][4 * g4 + e] *= dc[e]; } \
                    _Pragma("unroll") for (int ks2 = 0; ks2 < 2; ++ks2) { const bf16x8 a = *(const LAS bf16x8*)(lds + L_KH + bp * TR_B + tchunk(32 * dkt + r_, 2 * ks2 + hh_)); \
                        st[dkt] = __builtin_amdgcn_mfma_f32_32x32x16_bf16(a, vb2[ks2], st[dkt], 0, 0, 0); } } \
            } \
            LBAR(); \
            if ((i) >= 1) { \
                  \
                int gt_ = gtid; asm volatile("" : "+v"(gt_)); const int t_ = gt_ >> 3, c16_ = gt_ & 7; \
                float o[16]; float ss = 0.f; \
                _Pragma("unroll") for (int e = 0; e < 16; ++e) { o[e] = ((LAS float*)(lds + L_OSS))[t_ * OSS + 16 * c16_ + e] + ((LAS float*)(lds + L_OSI + bp * OS_B))[t_ * OSS + 16 * c16_ + e]; ss += o[e] * o[e]; } \
                ss += __shfl_xor(ss, 1); ss += __shfl_xor(ss, 2); ss += __shfl_xor(ss, 4); \
                const float rs = __builtin_amdgcn_rsqf(ss * (1.0f / 128.0f) + EPS); \
                const unsigned gw8[8] = {G0.x, G0.y, G0.z, G0.w, G1.x, G1.y, G1.z, G1.w}; float of[16]; \
                _Pragma("unroll") for (int p = 0; p < 8; ++p) { of[2 * p] = __builtin_amdgcn_fmed3f(o[2 * p] * rs * gnv[p >> 1][(2 * p) & 3] * bflo(gw8[p]) * AO_SCALE, -448.0f, 448.0f); of[2 * p + 1] = __builtin_amdgcn_fmed3f(o[2 * p + 1] * rs * gnv[p >> 1][(2 * p + 1) & 3] * bfhi(gw8[p]) * AO_SCALE, -448.0f, 448.0f); } \
                *(v4u*)((unsigned char*)AO + ebase + (size_t)((i) - 1) * 32 * D) = (v4u){pk_fp8x4m(of[0], of[1], of[2], of[3]), pk_fp8x4m(of[4], of[5], of[6], of[7]), pk_fp8x4m(of[8], of[9], of[10], of[11]), pk_fp8x4m(of[12], of[13], of[14], of[15])}; \
                if ((i) + 1 < NCH) { G0 = *(const v4u*)(Pg + ebase + (size_t)((i) + 1) * 32 * D); G1 = *(const v4u*)(Pg + ebase + (size_t)((i) + 1) * 32 * D + 8); } \
            } \
        } while (0)
        if (!isS) __builtin_amdgcn_s_setprio(1);
        if (!isS) {
            Raw2 RA, RB; load_raw2(RA, Pq, LF, Pk, Pv, pbase); load_raw2(RB, Pq, LF, Pk, Pv, pbase + (size_t)32 * D);
#pragma unroll 1
            for (int i = 0; i < NCH; i += 2) { HG_P(i, RA); HG_P(i + 1, RB); }
            HG_P(NCH, RA);
        } else {
            f32x16 st[4];
#pragma unroll
            for (int q = 0; q < 4; ++q)
#pragma unroll
                for (int e = 0; e < 16; ++e) st[q][e] = 0.f;
            v4u ga0 = *(const v4u*)(Pg + ebase), ga1 = *(const v4u*)(Pg + ebase + 8), gb0 = *(const v4u*)(Pg + ebase + (size_t)32 * D), gb1 = *(const v4u*)(Pg + ebase + (size_t)32 * D + 8);
            f32x4 gnv[4];
#pragma unroll
            for (int q = 0; q < 4; ++q) gnv[q] = *(const f32x4*)(gnorm + 16 * (gtid & 7) + 4 * q);
#pragma unroll 1
            for (int i = 0; i < NCH; i += 2) { HG_S(i, gb0, gb1); HG_S(i + 1, ga0, ga1); }
            HG_S(NCH, gb0, gb1);
        }
#undef HG_P
#undef HG_S
        __builtin_amdgcn_s_setprio(0);
        LBAR();
    }
}

struct Args { const float* in[21]; float* out; unsigned char* ws; int ph_lo, ph_hi; };
#ifndef MK_PER_PHASE
#define MK_PER_PHASE 0
#endif
constexpr int PH_PER_LAYER = 9;
constexpr int N_PHASES = 1 + DEPTH * PH_PER_LAYER + 1;

#ifndef PH_MASK
#define PH_MASK 0xFFF
#endif
#ifndef SUB_MASK
#define SUB_MASK 3
#endif
#define EN(b) ((PH_MASK >> (b)) & 1)
#ifndef REP_MASK
#define REP_MASK 0
#endif
#define NREP(b) (((REP_MASK >> (b)) & 1) ? 2 : 1)
#define SUBEN(b) ((SUB_MASK >> (b)) & 1)
#define IN(k) in_range(k)
#define SEAM(k) do { if (IN((k) + 1)) { if (MK_PER_PHASE) { } else { CArgs& a_ = kargs(); XcdBarrier bar_; bar_.bar = (unsigned*)(a_.ws + WS_CTL) + CW_BAR; bar_.x = xb_xcc_id(); bar_.st = (volatile LAS unsigned*)(ldsl + MISC_OFF) + 8; bar_.w = wave; xcd_barrier(bar_); } } } while (0)
typedef const __attribute__((address_space(4))) Args CArgs;
__device__ __forceinline__ CArgs& kargs() { CArgs* p = (CArgs*)__builtin_amdgcn_kernarg_segment_ptr(); asm volatile("" : "+s"(p)); return *p; }
__device__ __forceinline__ bool in_range(int k) { CArgs& a = kargs(); return a.ph_lo <= k && k < a.ph_hi; }
#define WSP(T_, off) ((T_*)(ws + (off)))
constexpr size_t PSTR = (size_t)T * D;

template <int L>
__device__ __forceinline__ void run_layer(unsigned char* lds, LAS unsigned char* ldsl, const int wave) {
    constexpr int pb = 1 + L * PH_PER_LAYER; constexpr int j = L >> 1; constexpr bool fox = (L & 1) == 0;
    const int G = gridDim.x, bid = blockIdx.x; const int gw = bid * NWAVES + wave, NGW = G * NWAVES;
    if (EN(1) && IN(pb + 0)) {
        CArgs& a = kargs(); unsigned char* ws = a.ws; const int lane = mk_lane();
        const float* modL = WSP(float, WS_MOD) + (size_t)L * NB * 6144;
        if constexpr (L == 0) phase_norm1<0, 0>(a.in[0], nullptr, WSP(unsigned char, WS_HN), WSP(float, WS_SA), a.in[13] + (size_t)L * D, modL, true, false, WSP(unsigned char, WS_R1), WSP(int, WS_POS), WSP(float, WS_TOPW), modL - (size_t)NB * 6144, gw, NGW, lane);
        else phase_norm1<1, 2>(WSP(bf16, WS_XB), WSP(bf16, WS_XB), WSP(unsigned char, WS_HN), WSP(float, WS_SA), a.in[13] + (size_t)L * D, modL, true, true, WSP(unsigned char, WS_R1), WSP(int, WS_POS), WSP(float, WS_TOPW), modL - (size_t)NB * 6144, gw, NGW, lane);
        if constexpr (L == 0) {
            for (int it = gw; it < 8 * 130; it += NGW) { int r = it; int m = 0;
                if (r >= 8 * 33) { r -= 8 * 33; m = 1; if (r >= 8 * 33) { r -= 8 * 33; m = 2; if (r >= 8 * 32) { r -= 8 * 32; m = 3; } } }
                if (m < 2) convert_mat_i8(a.in[2] + (size_t)m * D * 4112, 4112, 4112, 33, WSP(float, WS_PARTM) + (size_t)m * 4 * 4352, WSP(unsigned char, WS_WFI) + (size_t)m * NFOXP * D, WSP(float, WS_SWM) + m * 4352, OrFoxIn(), ldsl + RING_OFF + wave * 16384, r, lane);
                else convert_mat_i8(a.in[7] + (size_t)(m - 2) * D * 4096, 4096, 4096, 32, WSP(float, WS_PARTM) + (size_t)m * 4 * 4352, WSP(unsigned char, WS_WHI) + (size_t)(m - 2) * 4096 * D, WSP(float, WS_SWM) + m * 4352, OrIdent(), ldsl + RING_OFF + wave * 16384, r, lane); }
        }
        for (int rp_ = 0; rp_ < NREP(1); ++rp_)
        { convert_down_f8(a.in[19] + (size_t)L * NE * D * D, WSP(unsigned char, WS_WDN), ldsl + RING_OFF + wave * 16384, gw, NGW, lane);
 }
        __syncthreads();
        if constexpr (!fox) {
            for (int it = bid; it < NE * 16; it += G) { const int e = it >> 4, ct = it & 15;
                convert_strip_i8(a.in[17] + ((size_t)L * NE + e) * D * 2048, 2048, WSP(unsigned char, WS_WGU) + (size_t)e * 2048 * D, WSP(float, WS_SW) + (size_t)e * 2048, OrGu(), 128 * ct, (LAS float*)(ldsl + LSCR_OFF), ldsl + RING_OFF + wave * 16384, wave, lane); }
            __syncthreads();
        }
        SEAM(pb + 0);
    }
    if (EN(2) && IN(pb + 1)) {
        CArgs& a = kargs(); unsigned char* ws = a.ws;
        for (int rp_ = 0; rp_ < NREP(2); ++rp_) { if (rp_) __syncthreads();
        if constexpr (fox) { if (SUBEN(0)) {
            pg8::Gemm g{WSP(bf16, WS_HN), WSP(bf16, WS_WFI) + (size_t)j * NFOXP * (D / 2), T, NFOXP, D / 2}; pg8::StaticOrder S; S.init(T, NFOXP, G, bid);
            pg8::EpiFoxT<true> E{WSP(bf16, WS_R1), PSTR, WSP(float, WS_FL), a.in[4] + j * 64, a.in[5] + j * 64, a.in[3] + j * 16, attn_body::C2, WSP(float, WS_SA), WSP(float, WS_SWM) + j * 4352};
            pg8::gemm_phase<pg8::EpiFoxT<true>, pg8::StaticOrder, true, true, true>(ldsl + RING_OFF, g, S, E, wave);
        } } else { if (SUBEN(1)) {
            pg8::Gemm g{WSP(bf16, WS_HN), WSP(bf16, WS_WHI) + (size_t)j * 4096 * (D / 2), T, 4096, D / 2}; pg8::StaticOrder S; S.init(T, 4096, G, bid);
            pg8::EpiHgrnT<true> E{WSP(bf16, WS_R1), PSTR, WSP(float, WS_ACT), a.in[8], a.in[8] + D, j, WSP(float, WS_SA), WSP(float, WS_SWM) + (2 + j) * 4352};
            pg8::gemm_phase<pg8::EpiHgrnT<true>, pg8::StaticOrder, true, true, true>(ldsl + RING_OFF, g, S, E, wave);
        } } }
        SEAM(pb + 1);
    }
    if constexpr (fox) if (EN(3) && IN(pb + 2)) {
        CArgs& a = kargs(); unsigned char* ws = a.ws; const int lane = mk_lane();
        phase_cumsum(WSP(float, WS_FL), WSP(float, WS_BIAS), (LAS float*)(ldsl + LSCR_OFF), bid, G, wave, lane);
        __syncthreads();
        SEAM(pb + 2);
    }
    if (EN(4) && IN(pb + 3)) {
        CArgs& a = kargs(); unsigned char* ws = a.ws; bf16* P0 = WSP(bf16, WS_R1); bf16* AO = WSP(bf16, WS_R1 + 512 * MiB);
        for (int rp_ = 0; rp_ < NREP(4); ++rp_) { if (rp_) __syncthreads();
        if constexpr (fox) { if (SUBEN(0)) {
            float skipthr; { const int l_ = mk_lane(); const float mq = wave_max(fabsf(a.in[4][j * 64 + l_])), mk = wave_max(fabsf(a.in[5][j * 64 + l_])); skipthr = 64.0f + 2.0f * 64.0f * attn_body::C2 * mq * mk * 1.01f; }
            const attn_body::AttnTensors AT{(const attn_body::bf16*)P0, (const attn_body::bf16*)(P0 + PSTR), (const attn_body::bf16*)(P0 + 2 * PSTR), (attn_body::bf16*)AO, (const attn_body::bf16*)(P0 + 3 * PSTR), WSP(float, WS_BIAS), skipthr};
            const attn_body::StaticOrder S(G, bid);
            auto conv_item = [&](int it) { if (it < NE * 16) { const int e = it >> 4, ct = it & 15; const int lane_ = mk_lane();
                convert_strip_i8(a.in[17] + ((size_t)L * NE + e) * D * 2048, 2048, WSP(unsigned char, WS_WGU) + (size_t)e * 2048 * D, WSP(float, WS_SW) + (size_t)e * 2048, OrGu(), 128 * ct, (LAS float*)(ldsl + LSCR_OFF), ldsl + RING_OFF + wave * 16384, wave, lane_); } };
            auto hook = [&](int n) { conv_item(bid + n * G); };
            attn_body::attn_phase<attn_body::StaticOrder>((char*)lds + RING_OFF, AT, S, wave, hook);
            { const int nheads = (NB * 16 - bid + G - 1) / G; __syncthreads(); for (int it = bid + nheads * G; it < NE * 16; it += G) conv_item(it); }
        } } else { if (SUBEN(1)) {
            const int lane = mk_lane();
            phase_hgrn(P0, WSP(float, WS_ACT), P0 + PSTR, P0 + 2 * PSTR, P0 + 3 * PSTR, AO, a.in[9] + j * 128, ldsl + RING_OFF, wave * 64 + lane, lane, wave, bid, G);
        } } }
        SEAM(pb + 3);
    }
    if (EN(5) && IN(pb + 4)) {
        CArgs& a = kargs(); unsigned char* ws = a.ws;
        pg8::Gemm g{WSP(bf16, WS_R1 + 512 * MiB), WSP(bf16, (fox ? WS_WFO : WS_WHO) + (size_t)j * D * D), T, D, D / 2}; pg8::StaticOrder S; S.init(T, D, G, bid);
        pg8::EpiResidT<L == 0> E{a.in[0], WSP(bf16, WS_XB), WSP(bf16, WS_XB), WSP(float, WS_MOD) + (size_t)L * NB * 6144 + 2048, 1.0f / (AO_SCALE * F8_WSCALE)};
        pg8::gemm_phase<pg8::EpiResidT<L == 0>, pg8::StaticOrder, true, true, false, true>(ldsl + RING_OFF, g, S, E, wave);
        SEAM(pb + 4);
    }
    if (EN(6) && IN(pb + 5)) {
        CArgs& a = kargs(); unsigned char* ws = a.ws; const int lane = mk_lane();
        for (int rp_ = 0; rp_ < NREP(6); ++rp_)
        phase_norm2_route(WSP(bf16, WS_XB), WSP(unsigned char, WS_HN), WSP(float, WS_SA), a.in[14] + (size_t)L * D, WSP(float, WS_MOD) + (size_t)L * NB * 6144, a.in[15] + (size_t)L * D * NE, a.in[16] + (size_t)L * NE,
                          WSP(int, WS_TOPI), WSP(float, WS_TOPW), WSP(int, WS_ROUTE) + RT_HIST, lds, wave * 64 + lane, lane, wave, bid, G);
        SEAM(pb + 5);
    }
    if (EN(7) && IN(pb + 6)) {
        CArgs& a = kargs(); unsigned char* ws = a.ws; const int lane = mk_lane();
        for (int rp_ = 0; rp_ < NREP(7); ++rp_)
        phase_scatter(WSP(int, WS_TOPI), WSP(int, WS_POS), WSP(int, WS_ROWTOK), WSP(float, WS_SAROW), WSP(float, WS_SA), WSP(int, WS_ROUTE) + RT_HIST, WSP(int, WS_ROUTE), lds, wave * 64 + lane, lane, wave, bid, G);
        SEAM(pb + 6);
    }
    if (EN(8) && IN(pb + 7)) {
        CArgs& a = kargs(); unsigned char* ws = a.ws;
        pg8::Gemm g{WSP(bf16, WS_HN), WSP(bf16, WS_WGU), TPAD, NE * 2048, D / 2}; pg8::GroupedOrderT<true> S; S.init(WSP(int, WS_ROUTE) + RT_NTILES, WSP(int, WS_ROUTE) + RT_TEXP, 8, G, bid, WSP(int, WS_ROWTOK));
        pg8::EpiSwigluI8 E{WSP(unsigned char, WS_ACT), a.in[18] + (size_t)L * NE * 2048, WSP(float, WS_SW), WSP(float, WS_SAROW)};
        for (int rp_ = 0; rp_ < NREP(8); ++rp_) { if (rp_) __syncthreads(); pg8::gemm_phase<pg8::EpiSwigluI8, pg8::GroupedOrderT<true>, true, true, true>(ldsl + RING_OFF, g, S, E, wave); }
        SEAM(pb + 7);
    }
    if (EN(9) && IN(pb + 8)) {
        CArgs& a = kargs(); unsigned char* ws = a.ws;
        pg8::Gemm g{WSP(bf16, WS_ACT), WSP(bf16, WS_WDN), TPAD, NE * D, D / 2}; pg8::GroupedOrderT<false> S; S.init(WSP(int, WS_ROUTE) + RT_NTILES, WSP(int, WS_ROUTE) + RT_TEXP, 4, G, bid);
        pg8::EpiDown E{WSP(unsigned char, WS_R1), a.in[20] + (size_t)L * NE * D, 1.0f / F8_WSCALE};
        for (int rp_ = 0; rp_ < NREP(9); ++rp_) { if (rp_) __syncthreads(); pg8::gemm_phase<pg8::EpiDown, pg8::GroupedOrderT<false>, true, true, false, true>(ldsl + RING_OFF, g, S, E, wave); }
        SEAM(pb + 8);
    }
}

__global__ void __launch_bounds__(NWAVES * 64, 2) mega_fwd(Args args_unused) {
    extern __shared__ __attribute__((aligned(16))) unsigned char lds[];
    LAS unsigned char* ldsl = (LAS unsigned char*)lds;
    volatile LAS unsigned* MISC = (volatile LAS unsigned*)(ldsl + MISC_OFF);
    const int wave = __builtin_amdgcn_readfirstlane((int)threadIdx.x >> 6);
    const int G = gridDim.x, bid = blockIdx.x;
    for (int u = wave * 64 + mk_lane(); u < (LDS_BYTES - LDSCTL_OFF) / 4; u += NWAVES * 64) ((LAS unsigned*)(ldsl + LDSCTL_OFF))[u] = 0u;
    __syncthreads();
    if (!MK_PER_PHASE) { CArgs& a = kargs(); (void)xcd_barrier_post((unsigned*)(a.ws + WS_CTL) + CW_BAR, MISC + 8, wave); }

    if (EN(0) && IN(0)) {
        CArgs& a = kargs(); unsigned char* ws = a.ws; const int lane = mk_lane(); const int gw = bid * NWAVES + wave, NGW = G * NWAVES;
        phase_mod(a.in[1], a.in[11], a.in[12], WSP(float, WS_MOD), (float*)(lds + RING_OFF), wave * 64 + lane, bid, G);
        LAS float* scr = (LAS float*)(ldsl + RING_OFF + wave * 16384);
        (void)scr;
        convert_down_f8(a.in[6], WSP(unsigned char, WS_WFO), ldsl + RING_OFF + wave * 16384, gw, NGW, lane, 128);
        convert_down_f8(a.in[10], WSP(unsigned char, WS_WHO), ldsl + RING_OFF + wave * 16384, gw, NGW, lane, 128);
        for (int it = gw; it < 4 * 130; it += NGW) { int r = it; int m = 0;
            if (r >= 4 * 33) { r -= 4 * 33; m = 1; if (r >= 4 * 33) { r -= 4 * 33; m = 2; if (r >= 4 * 32) { r -= 4 * 32; m = 3; } } }
            if (m < 2) absmax_mat(a.in[2] + (size_t)m * D * 4112, 4112, 4112, 33, WSP(float, WS_PARTM) + (size_t)m * 4 * 4352, r, lane);
            else absmax_mat(a.in[7] + (size_t)(m - 2) * D * 4096, 4096, 4096, 32, WSP(float, WS_PARTM) + (size_t)m * 4 * 4352, r, lane); }
        for (int idx = gw * 64 + lane; idx < 2 * 240 * 64; idx += NGW * 64) { const int m = idx / (240 * 64), r = idx - m * 240 * 64; *(v4u*)(WSP(unsigned char, WS_WFI) + (size_t)m * NFOXP * D + (size_t)4112 * D + (size_t)r * 16) = (v4u){0u, 0u, 0u, 0u}; }
        __syncthreads();
        SEAM(0);
    }
    run_layer<0>(lds, ldsl, wave);
    run_layer<1>(lds, ldsl, wave);
    run_layer<2>(lds, ldsl, wave);
    run_layer<3>(lds, ldsl, wave);
    if (EN(10) && IN(N_PHASES - 1)) {
        CArgs& a = kargs(); unsigned char* ws = a.ws; const int gw = bid * NWAVES + wave, NGW = G * NWAVES;
        phase_norm1<1, 1>(WSP(bf16, WS_XB), a.out, WSP(unsigned char, WS_HN), WSP(float, WS_SA), a.in[13], WSP(float, WS_MOD), false, true, WSP(unsigned char, WS_R1), WSP(int, WS_POS), WSP(float, WS_TOPW), WSP(float, WS_MOD) + (size_t)(DEPTH - 1) * NB * 6144, gw, NGW, mk_lane());
    }
}

extern "C" void kernel_launch(void* const* d_in, const int* in_sizes, int n_in, void* d_out, int out_size, void* d_ws, size_t ws_size, hipStream_t stream) {
    static int grid = 0;
    if (grid == 0) {
        if (n_in != 21 || in_sizes[0] != T * D || out_size != T * D || ws_size < WS_END) { fprintf(stderr, "kernel_launch: unexpected shapes (n_in %d, in0 %d, out %d, ws %zu < %zu); nothing launched\n", n_in, n_in > 0 ? in_sizes[0] : -1, out_size, ws_size, (size_t)WS_END); grid = -1; return; }
        int dev = 0, cus = 0, per_cu = 0;
        if (hipGetDevice(&dev) != hipSuccess || hipDeviceGetAttribute(&cus, hipDeviceAttributeMultiprocessorCount, dev) != hipSuccess) { grid = -1; return; }
        if (hipFuncSetAttribute((const void*)mega_fwd, hipFuncAttributeMaxDynamicSharedMemorySize, LDS_BYTES) != hipSuccess) { fprintf(stderr, "kernel_launch: hipFuncSetAttribute failed\n"); grid = -1; return; }
        if (hipOccupancyMaxActiveBlocksPerMultiprocessor(&per_cu, (const void*)mega_fwd, NWAVES * 64, LDS_BYTES) != hipSuccess || per_cu < 1) { fprintf(stderr, "kernel_launch: occupancy query says %d blocks per CU\n", per_cu); }
        (void)hipGetLastError();
        grid = cus;
    }
    if (grid < 0) return;
    if (hipMemsetAsync((char*)d_ws + WS_CTL, 0, CTL_ZERO_BYTES, stream) != hipSuccess) return;
    Args a{};
    for (int i = 0; i < 21; ++i) a.in[i] = (const float*)d_in[i];
    a.out = (float*)d_out; a.ws = (unsigned char*)d_ws;
#if MK_PER_PHASE
    for (int p = 0; p < N_PHASES; ++p) { a.ph_lo = p; a.ph_hi = p + 1; hipLaunchKernelGGL(mega_fwd, dim3(grid), dim3(NWAVES * 64), LDS_BYTES, stream, a); }
#else
    a.ph_lo = 0; a.ph_hi = N_PHASES;
    hipLaunchKernelGGL(mega_fwd, dim3(grid), dim3(NWAVES * 64), LDS_BYTES, stream, a);
#endif
}
```
